# Optimizing an MI355X kernel written in HIP

```python
import math
import jax, jax.numpy as jnp
from jax import lax
import numpy as np

D_MODEL = 2048
BATCH = 8
SEQ = 4096
DEPTH = 4

HEAD_DIM = 128
EPS = 1e-6
NEG = -1e30

NUM_BUCKETS = 32
MAX_DISTANCE = 2048

NSA_HEADS = 8
NSA_GROUPS = 2
NSA_HPG = NSA_HEADS // NSA_GROUPS
NSA_BLOCK = 64
NSA_TOPK = 16
NSA_WINDOW = 512
NSA_QCHUNK = 32

DIL_PAIRS = ((128, 1), (512, 4), (2048, 16))
DIL_GROUPS = 3
DIL_HPG = 4
DIL_HEADS = DIL_GROUPS * DIL_HPG
DIL_QCHUNK = 32

MLA_HEADS = 16
MLA_Q_RANK = 1536
MLA_KV_RANK = 512
MLA_NOPE = 128
MLA_ROPE = 64
MLA_V = 128
MLA_QBLOCK = 128
ROPE_THETA = 10000.0

A_Q = NSA_HEADS * HEAD_DIM
A_KV = 6 * NSA_GROUPS * HEAD_DIM
A_G3 = 3 * NSA_HEADS
A_GATE = NSA_HEADS * HEAD_DIM
B_QKV = 3 * DIL_HEADS * HEAD_DIM
B_GATE = DIL_HPG * HEAD_DIM
EVEN_IN = A_Q + A_KV + A_G3 + A_GATE + B_QKV + B_GATE
EVEN_MIX = A_GATE + B_GATE
ODD_MIX = MLA_HEADS * MLA_V
ODD_IN = MLA_Q_RANK + MLA_KV_RANK + MLA_ROPE + ODD_MIX

kernel_name = "hybrid_nsa_dilated_mla_trunk"


def _split_points(widths):
    pts, acc = [], 0
    for w in widths[:-1]:
        acc += w
        pts.append(acc)
    return pts


def rmsnorm(x, w):
    xf = x.astype(jnp.float32)
    y = xf * lax.rsqrt(jnp.mean(xf * xf, axis=-1, keepdims=True) + EPS)
    return (y * w.astype(jnp.float32)).astype(x.dtype)


def t5_bucket(dist):
    max_exact = NUM_BUCKETS // 2
    d = jnp.maximum(dist, 0)
    df = jnp.maximum(d, 1).astype(jnp.float32)
    large = max_exact + (jnp.log(df / max_exact) / math.log(MAX_DISTANCE / max_exact)
                         * (NUM_BUCKETS - max_exact)).astype(jnp.int32)
    large = jnp.minimum(large, NUM_BUCKETS - 1)
    return jnp.where(d < max_exact, d, large)


def masked_softmax(s, mask):
    p = jax.nn.softmax(jnp.where(mask, s, NEG), axis=-1)
    return jnp.where(mask, p, 0.0)


def rope(x, pos):
    half = x.shape[-1] // 2
    freqs = 1.0 / (ROPE_THETA ** (jnp.arange(half, dtype=jnp.float32) / half))
    ang = pos.astype(jnp.float32)[:, None] * freqs[None, :]
    cos = jnp.cos(ang)[:, None, :]
    sin = jnp.sin(ang)[:, None, :]
    xf = x.astype(jnp.float32)
    x1, x2 = xf[..., :half], xf[..., half:]
    return jnp.concatenate([x1 * cos - x2 * sin, x1 * sin + x2 * cos], axis=-1).astype(x.dtype)


def nsa_compress(kv, pos, w1, w2):
    b_, t_ = kv.shape[:2]
    nblk = t_ // NSA_BLOCK
    blk = kv.reshape(b_, nblk, NSA_BLOCK, NSA_GROUPS, HEAD_DIM) + pos[None, None, :, None, :]
    blk = blk.transpose(0, 1, 3, 2, 4).reshape(b_, nblk, NSA_GROUPS, NSA_BLOCK * HEAD_DIM)
    return jax.nn.silu(blk @ w1) @ w2


def nsa_attention(q, kv_all, gate_logits, cmp_pos, cmp_w1, cmp_w2, table):
    b_, t_ = q.shape[:2]
    L, W, QC, G, HPG = NSA_BLOCK, NSA_WINDOW, NSA_QCHUNK, NSA_GROUPS, NSA_HPG
    nblk = t_ // L
    nsel = min(NSA_TOPK, nblk)
    kc, vc, ks, vs, kw, vw = [a.reshape(b_, t_, G, HEAD_DIM) for a in jnp.split(kv_all, 6, axis=-1)]
    k_cmp = nsa_compress(kc, cmp_pos[0], cmp_w1[0], cmp_w2[0])
    v_cmp = nsa_compress(vc, cmp_pos[1], cmp_w1[1], cmp_w2[1])
    ks_blk = ks.reshape(b_, nblk, L, G, HEAD_DIM).transpose(0, 3, 1, 2, 4)
    vs_blk = vs.reshape(b_, nblk, L, G, HEAD_DIM).transpose(0, 3, 1, 2, 4)
    kw_pad = jnp.pad(kw, ((0, 0), (W, 0), (0, 0), (0, 0)))
    vw_pad = jnp.pad(vw, ((0, 0), (W, 0), (0, 0), (0, 0)))
    tab = table[:, :NSA_HEADS].reshape(NUM_BUCKETS, G, HPG)
    cmp_end = jnp.arange(nblk) * L + (L - 1)
    blk_ids = jnp.arange(nblk)
    scale = HEAD_DIM ** -0.5
    nc = t_ // QC
    q_chunks = q.reshape(b_, nc, QC, G, HPG, HEAD_DIM).transpose(1, 0, 2, 3, 4, 5)
    bidx = jnp.arange(b_)[:, None, None, None]
    gidx = jnp.arange(G)[None, :, None, None]

    def chunk(args):
        qb, c = args
        t = c * QC + jnp.arange(QC)
        s = jnp.einsum('bqghd,bngd->bghqn', qb, k_cmp).astype(jnp.float32) * scale
        dist = t[:, None] - cmp_end[None, :]
        s = s + tab[t5_bucket(dist)].transpose(2, 3, 0, 1)[None]
        p_cmp = masked_softmax(s, dist >= 0)
        o_cmp = jnp.einsum('bghqn,bngd->bqghd', p_cmp.astype(v_cmp.dtype), v_cmp)
        imp = p_cmp.sum(axis=2)
        cur = t // L
        forced = (blk_ids[None, :] == 0) | (blk_ids[None, :] == cur[:, None]) | (blk_ids[None, :] == cur[:, None] - 1)
        imp = jnp.where(forced, jnp.inf, jnp.where(blk_ids[None, :] > cur[:, None], -jnp.inf, imp))
        _, sel = lax.top_k(imp, nsel)
        k_sel = ks_blk[bidx, gidx, sel]
        v_sel = vs_blk[bidx, gidx, sel]
        s = jnp.einsum('bqghd,bgqskd->bghqsk', qb, k_sel).astype(jnp.float32) * scale
        kpos = sel[..., None] * L + jnp.arange(L)
        dist = t[None, None, :, None, None] - kpos
        bias = tab[t5_bucket(dist), jnp.arange(G)[None, :, None, None, None]]
        s = (s + bias.transpose(0, 1, 5, 2, 3, 4)).reshape(b_, G, HPG, QC, nsel * L)
        mask = (dist >= 0)[:, :, None].reshape(b_, G, 1, QC, nsel * L)
        p = masked_softmax(s, mask).reshape(b_, G, HPG, QC, nsel, L)
        o_slc = jnp.einsum('bghqsk,bgqskd->bqghd', p.astype(v_sel.dtype), v_sel)
        kwin = lax.dynamic_slice_in_dim(kw_pad, c * QC, W + QC, axis=1)
        vwin = lax.dynamic_slice_in_dim(vw_pad, c * QC, W + QC, axis=1)
        kp = c * QC - W + jnp.arange(W + QC)
        dist = t[:, None] - kp[None, :]
        mask = (dist >= 0) & (dist < W) & (kp[None, :] >= 0)
        s = jnp.einsum('bqghd,bkgd->bghqk', qb, kwin).astype(jnp.float32) * scale
        s = s + tab[t5_bucket(dist)].transpose(2, 3, 0, 1)[None]
        p = masked_softmax(s, mask)
        o_win = jnp.einsum('bghqk,bkgd->bqghd', p.astype(vwin.dtype), vwin)
        return o_cmp, o_slc, o_win

    o_cmp, o_slc, o_win = lax.map(chunk, (q_chunks, jnp.arange(nc)))

    def unchunk(a):
        return a.transpose(1, 0, 2, 3, 4, 5).reshape(b_, t_, NSA_HEADS, HEAD_DIM)

    g = jax.nn.sigmoid(gate_logits.astype(jnp.float32)).reshape(b_, t_, NSA_HEADS, 3, 1).astype(q.dtype)
    out = g[:, :, :, 0] * unchunk(o_cmp) + g[:, :, :, 1] * unchunk(o_slc) + g[:, :, :, 2] * unchunk(o_win)
    return out.reshape(b_, t_, NSA_HEADS * HEAD_DIM)


def dilated_attention(q, k, v, table):
    b_, t_ = q.shape[:2]
    QC = DIL_QCHUNK
    nc = t_ // QC
    scale = HEAD_DIM ** -0.5
    tab = table[:, NSA_HEADS:].reshape(NUM_BUCKETS, DIL_GROUPS, DIL_HPG)
    k_groups = [k[:, :, g] for g in range(DIL_GROUPS)]
    v_groups = [v[:, :, g] for g in range(DIL_GROUPS)]
    biases = []
    for g, (w, d) in enumerate(DIL_PAIRS):
        offs = jnp.arange(w // d + 1) * d
        biases.append(tab[t5_bucket(offs), g])
    q_chunks = q.reshape(b_, nc, QC, DIL_GROUPS, DIL_HPG, HEAD_DIM).transpose(1, 0, 2, 3, 4, 5)

    def chunk(args):
        qb, c = args
        t = c * QC + jnp.arange(QC)
        outs, lses = [], []
        for g, (w, d) in enumerate(DIL_PAIRS):
            m = w // d + 1
            idx = t[:, None] - jnp.arange(m)[None, :] * d
            valid = idx >= 0
            idxc = jnp.maximum(idx, 0)
            kg = k_groups[g][:, idxc]
            vg = v_groups[g][:, idxc]
            s = jnp.einsum('bqhd,bqmhd->bhqm', qb[:, :, g], kg).astype(jnp.float32) * scale
            s = jnp.where(valid[None, None], s + biases[g].T[None, :, None, :], NEG)
            lse = jax.nn.logsumexp(s, axis=-1)
            p = jnp.exp(s - lse[..., None])
            outs.append(jnp.einsum('bhqm,bqmhd->bqhd', p.astype(vg.dtype), vg))
            lses.append(lse)
        alpha = jax.nn.softmax(jnp.stack(lses, 0), axis=0)
        o = jnp.einsum('gbhq,gbqhd->bqhd', alpha, jnp.stack(outs, 0).astype(jnp.float32))
        return o.astype(q.dtype)

    o = lax.map(chunk, (q_chunks, jnp.arange(nc)))
    return o.transpose(1, 0, 2, 3, 4).reshape(b_, t_, DIL_HPG * HEAD_DIM)


def mla_attention(cq, ckv, kpe, q_norm, w_qb, kv_norm, w_kvb):
    b_, t_ = cq.shape[:2]
    H, QB = MLA_HEADS, MLA_QBLOCK
    pos = jnp.arange(t_)
    q = (rmsnorm(cq, q_norm) @ w_qb).reshape(b_, t_, H, MLA_NOPE + MLA_ROPE)
    q_nope, q_pe = q[..., :MLA_NOPE], rope(q[..., MLA_NOPE:], pos)
    kv = (rmsnorm(ckv, kv_norm) @ w_kvb).reshape(b_, t_, H, MLA_NOPE + MLA_V)
    k_nope, v = kv[..., :MLA_NOPE], kv[..., MLA_NOPE:]
    k_pe = rope(kpe[:, :, None, :], pos)[:, :, 0]
    scale = (MLA_NOPE + MLA_ROPE) ** -0.5
    nb = t_ // QB
    qn = q_nope.reshape(b_, nb, QB, H, MLA_NOPE).transpose(1, 0, 2, 3, 4)
    qp = q_pe.reshape(b_, nb, QB, H, MLA_ROPE).transpose(1, 0, 2, 3, 4)

    def block(args):
        qnb, qpb, c = args
        t = c * QB + jnp.arange(QB)
        s = (jnp.einsum('bqhd,bkhd->bhqk', qnb, k_nope)
             + jnp.einsum('bqhd,bkd->bhqk', qpb, k_pe)).astype(jnp.float32) * scale
        p = masked_softmax(s, pos[None, :] <= t[:, None])
        return jnp.einsum('bhqk,bkhd->bqhd', p.astype(v.dtype), v)

    o = lax.map(block, (qn, qp, jnp.arange(nb)))
    return o.transpose(1, 0, 2, 3, 4).reshape(b_, t_, H * MLA_V)


def setup_inputs(seed: int = 0) -> dict:
    key = jax.random.key(seed)
    ks = jax.random.split(key, 16)
    ne = (DEPTH + 1) // 2
    no = DEPTH // 2

    def nrm(k, shape, scale):
        return jax.random.normal(k, shape, jnp.float32) * scale

    return {
        "x": nrm(ks[0], (BATCH, SEQ, D_MODEL), 1.0),
        "rel_bias": nrm(ks[1], (NUM_BUCKETS, NSA_HEADS + DIL_HEADS), 0.2),
        "norm_w": 1.0 + nrm(ks[2], (DEPTH, D_MODEL), 0.02),
        "final_norm_w": 1.0 + nrm(ks[3], (D_MODEL,), 0.02),
        "ev_w_in": nrm(ks[4], (ne, D_MODEL, EVEN_IN), D_MODEL ** -0.5),
        "nsa_cmp_pos": nrm(ks[5], (ne, 2, NSA_BLOCK, HEAD_DIM), 0.1),
        "nsa_cmp_w1": nrm(ks[6], (ne, 2, NSA_BLOCK * HEAD_DIM, HEAD_DIM), (NSA_BLOCK * HEAD_DIM) ** -0.5),
        "nsa_cmp_w2": nrm(ks[7], (ne, 2, HEAD_DIM, HEAD_DIM), HEAD_DIM ** -0.5),
        "ev_w_out": nrm(ks[8], (ne, EVEN_MIX, D_MODEL), 0.5 * EVEN_MIX ** -0.5),
        "od_w_in": nrm(ks[9], (no, D_MODEL, ODD_IN), D_MODEL ** -0.5),
        "mla_q_norm": 1.0 + nrm(ks[10], (no, MLA_Q_RANK), 0.02),
        "mla_w_qb": nrm(ks[11], (no, MLA_Q_RANK, MLA_HEADS * (MLA_NOPE + MLA_ROPE)), MLA_Q_RANK ** -0.5),
        "mla_kv_norm": 1.0 + nrm(ks[12], (no, MLA_KV_RANK), 0.02),
        "mla_w_kvb": nrm(ks[13], (no, MLA_KV_RANK, MLA_HEADS * (MLA_NOPE + MLA_V)), MLA_KV_RANK ** -0.5),
        "od_w_out": nrm(ks[14], (no, ODD_MIX, D_MODEL), 0.5 * ODD_MIX ** -0.5),
    }


def reference(x, rel_bias, norm_w, final_norm_w, ev_w_in, nsa_cmp_pos, nsa_cmp_w1, nsa_cmp_w2,
              ev_w_out, od_w_in, mla_q_norm, mla_w_qb, mla_kv_norm, mla_w_kvb, od_w_out):
    b_, t_ = x.shape[:2]
    even_pts = _split_points([A_Q, A_KV, A_G3, A_GATE, B_QKV, B_GATE])
    odd_pts = _split_points([MLA_Q_RANK, MLA_KV_RANK, MLA_ROPE, ODD_MIX])
    for l in range(DEPTH):
        h = rmsnorm(x, norm_w[l])
        i = l // 2
        if l % 2 == 0:
            z = h @ ev_w_in[i]
            q_a, kv_a, g3_a, gate_a, qkv_b, gate_b = jnp.split(z, even_pts, axis=-1)
            o_a = nsa_attention(q_a.reshape(b_, t_, NSA_HEADS, HEAD_DIM), kv_a, g3_a,
                                nsa_cmp_pos[i], nsa_cmp_w1[i], nsa_cmp_w2[i], rel_bias)
            q_b, k_b, v_b = [a.reshape(b_, t_, DIL_GROUPS, DIL_HPG, HEAD_DIM)
                             for a in jnp.split(qkv_b, 3, axis=-1)]
            o_b = dilated_attention(q_b, k_b, v_b, rel_bias)
            mixed = jnp.concatenate([o_a * jax.nn.silu(gate_a), o_b * jax.nn.silu(gate_b)], axis=-1)
            x = x + mixed @ ev_w_out[i]
        else:
            z = h @ od_w_in[i]
            cq, ckv, kpe, gate_c = jnp.split(z, odd_pts, axis=-1)
            o_c = mla_attention(cq, ckv, kpe, mla_q_norm[i], mla_w_qb[i], mla_kv_norm[i], mla_w_kvb[i])
            x = x + (o_c * jax.nn.silu(gate_c)) @ od_w_out[i]
    return rmsnorm(x, final_norm_w)
```

```cpp
#include <hip/hip_runtime.h>
#include <hip/hip_cooperative_groups.h>
#include <cstdio>
#include <cstdint>
namespace cg = cooperative_groups;


#ifndef ONE_LAUNCH
#define ONE_LAUNCH 1
#endif

typedef unsigned short bf16_t;
typedef short bf16x8 __attribute__((ext_vector_type(8)));
typedef float f32x16 __attribute__((ext_vector_type(16)));
typedef float f32x4 __attribute__((ext_vector_type(4)));
typedef unsigned u32x4 __attribute__((ext_vector_type(4)));
typedef unsigned u32x2 __attribute__((ext_vector_type(2)));
typedef int v2i __attribute__((ext_vector_type(2)));
typedef int v4i __attribute__((ext_vector_type(4)));
#define LDSA __attribute__((address_space(3)))
#define DEVI __device__ __forceinline__

constexpr int D_MODEL = 2048, BATCH = 8, SEQ = 4096, MTOK = BATCH * SEQ;
constexpr int LDZE = 8960;
constexpr int LDZO = 4352;
constexpr int EC_QA = 0, EC_KC = 1024, EC_VC = 1280, EC_KS = 1536, EC_VS = 1792, EC_KW = 2048, EC_VW = 2304, EC_GATEA = 2560,
              EC_QB = 3584, EC_KB = 5120, EC_VB = 6656, EC_GATEB = 8192, EC_G3 = 8704;
constexpr int OC_CQ = 0, OC_CKV = 1536, OC_GATE = 2048, OC_KPE = 4096;
constexpr float LOG2E = 1.4426950408889634f;
constexpr float NSA_SCALE2 = 0.08838834764831845f * LOG2E;
constexpr float MLA_SCALE2 = 0.07216878364870323f * LOG2E;
constexpr int GRP_LDS = 73728, LDS_BYTES = 2 * GRP_LDS;
constexpr int NTHREADS = 512, GTHREADS = 256;

constexpr size_t MB = 1024 * 1024;
constexpr size_t WS_BIAST = 0;
constexpr size_t WS_BIASD = WS_BIAST + 20 * 4096 * 4;
constexpr size_t WS_COS = 512 * 1024;
constexpr size_t WS_SIN = WS_COS + 512 * 1024;
constexpr size_t WS_POSP = WS_SIN + 512 * 1024;
constexpr size_t WS_BAR = 1920 * 1024;
constexpr size_t WS_KCMP = 2 * MB;
constexpr size_t WS_VCMP = WS_KCMP + 256 * 1024;
constexpr size_t WS_SEL = 3 * MB;
constexpr size_t WS_LSE = 4 * MB;
constexpr size_t WS_CMPP = 6 * MB;
constexpr size_t WS_RSTD = 14 * MB;
constexpr size_t WS_W = 16 * MB;
constexpr size_t SZ_WEVIN = (size_t)LDZE * 2048 * 2, SZ_WEVOUT = (size_t)2048 * 1536 * 2, SZ_WODIN = (size_t)LDZO * 2048 * 2,
                 SZ_WQB = (size_t)3072 * 1536 * 2, SZ_WKVB = (size_t)4096 * 512 * 2, SZ_WODOUT = (size_t)2048 * 2048 * 2, SZ_W1 = (size_t)128 * 8192 * 2;
constexpr size_t WS_WEVIN = WS_W, WS_WEVOUT = WS_WEVIN + 2 * SZ_WEVIN, WS_WODIN = WS_WEVOUT + 2 * SZ_WEVOUT, WS_WQB = WS_WODIN + 2 * SZ_WODIN,
                 WS_WKVB = WS_WQB + 2 * SZ_WQB, WS_WODOUT = WS_WKVB + 2 * SZ_WKVB, WS_W1 = WS_WODOUT + 2 * SZ_WODOUT, WS_WEND = WS_W1 + 4 * SZ_W1;
constexpr size_t WS_R1 = (WS_WEND + 4095) & ~(size_t)4095;
constexpr size_t SZ_R1 = (size_t)MTOK * LDZE * 2;
constexpr size_t WS_KV = WS_R1 + (size_t)MTOK * LDZO * 2;
constexpr size_t WS_H = WS_R1 + SZ_R1;
constexpr size_t WS_DIL = WS_H + (size_t)MTOK * 2048 * 2;
constexpr size_t WS_SSP = WS_DIL + (size_t)3 * MTOK * 512 * 2;
constexpr size_t WS_END = WS_SSP + (size_t)MTOK * 32 * 4;

struct Params {
    const float* x; const float* rel_bias; const float* norm_w; const float* final_norm_w; const float* ev_w_in; const float* cmp_pos;
    const float* cmp_w1; const float* cmp_w2; const float* ev_w_out; const float* od_w_in; const float* q_norm; const float* w_qb;
    const float* kv_norm; const float* w_kvb; const float* od_w_out;
    float* out; unsigned char* ws; int ph_lo, ph_hi; int dry, pad_;
};

DEVI float bf2f(bf16_t h) { return __uint_as_float((unsigned)h << 16); }
typedef __bf16 bf16v2_ __attribute__((ext_vector_type(2)));
typedef float f32v2_ __attribute__((ext_vector_type(2)));
DEVI unsigned pk2(float lo, float hi) { const f32v2_ v = {lo, hi}; return __builtin_bit_cast(unsigned, __builtin_convertvector(v, bf16v2_)); }
DEVI unsigned bfr_(float f) { const unsigned u = __float_as_uint(f); return (u + 0x7fffu + ((u >> 16) & 1u)) >> 16; }
DEVI unsigned pk2s(float lo, float hi) { return pk2(lo, hi); }
DEVI float lo2f(unsigned u) { return __uint_as_float(u << 16); }
DEVI float hi2f(unsigned u) { return __uint_as_float(u & 0xffff0000u); }
DEVI float fexp2(float x) { return __builtin_amdgcn_exp2f(x); }
DEVI float sigmoidf_(float x) { return 1.0f / (1.0f + __expf(-x)); }
DEVI float siluf_(float x) { return x / (1.0f + __expf(-x)); }
DEVI float wave_sum(float v) {
#pragma unroll
    for (int o = 32; o >= 1; o >>= 1) v += __shfl_xor(v, o);
    return v;
}
DEVI int pblock() { const int G = gridDim.x, b = blockIdx.x; return (G % 8 == 0) ? (b % 8) * (G / 8) + b / 8 : b; }
DEVI int grp_() { return __builtin_amdgcn_readfirstlane((int)(threadIdx.x >> 8)); }
DEVI int vgrid() { return (int)gridDim.x * 2; }
DEVI int vblock() { return pblock() * 2 + grp_(); }
template <int OFF> DEVI v2i trr(unsigned a) { v2i r; asm volatile("ds_read_b64_tr_b16 %0, %1 offset:%2" : "=v"(r) : "v"(a), "n"(OFF)); return r; }
DEVI f32x16 mfma32(bf16x8 a, bf16x8 b, f32x16 c) { return __builtin_amdgcn_mfma_f32_32x32x16_bf16(a, b, c, 0, 0, 0); }
DEVI int opq(int t) { asm volatile("" : "+v"(t)); return t; }
DEVI int opqs(int t) { asm volatile("" : "+s"(t)); return t; }
DEVI f32x16 zero16() { f32x16 z; for (int i = 0; i < 16; ++i) z[i] = 0.f; return z; }

template <int DM = 0, class AF, class EF>
DEVI void gemm_tile4(LDSA char* lds, int tid, AF af, const bf16_t* __restrict__ Bt, int ldb, int kt0, int nk, int row0, int col0, EF ef) {
    const int lane = tid & 63, wave = __builtin_amdgcn_readfirstlane(tid >> 6), wm = wave >> 1, wn = wave & 1, n32 = lane & 31, h = lane >> 5;
    f32x16 acc[4][2];
#pragma unroll
    for (int i = 0; i < 4; ++i)
#pragma unroll
        for (int j = 0; j < 2; ++j) acc[i][j] = zero16();
    u32x4 ra[8], rb[4];
    const int cr = tid >> 3, ckc = tid & 7;
#define GLOAD(kt) do { int cr_ = cr; asm volatile("" : "+v"(cr_));   \
        _Pragma("unroll") for (int u = 0; u < 8; ++u) ra[u] = *(const u32x4*)af(row0 + cr_ + 32 * u, (kt) * 64, ckc * 8); \
        _Pragma("unroll") for (int u = 0; u < 4; ++u) rb[u] = *(const u32x4*)(Bt + (size_t)(col0 + cr_ + 32 * u) * ldb + (kt) * 64 + ckc * 8); } while (0)
#define SSTORE() do { LDSA char* sb_ = lds + cr * 144 + ckc * 16; _Pragma("unroll") for (int u = 0; u < 8; ++u) *(LDSA u32x4*)(sb_ + u * 32 * 144) = ra[u]; \
        _Pragma("unroll") for (int u = 0; u < 4; ++u) *(LDSA u32x4*)(sb_ + 36864 + u * 32 * 144) = rb[u]; } while (0)
    GLOAD(kt0);
    LDSA char* As = lds + (wm * 128 + n32) * 144 + h * 16;
    LDSA char* Bs = lds + 36864 + (wn * 64 + n32) * 144 + h * 16;
    for (int i = 0; i < nk; ++i) {
        if (DM != 2 || i == 0) SSTORE();
        __syncthreads();
        if (DM != 2 && i + 1 < nk) GLOAD(kt0 + i + 1);
        if (DM != 1) {
#pragma unroll
            for (int ks = 0; ks < 4; ++ks) {
                const bf16x8 b0 = *(LDSA bf16x8*)(Bs + ks * 32), b1 = *(LDSA bf16x8*)(Bs + 32 * 144 + ks * 32);
#pragma unroll
                for (int ii = 0; ii < 4; ++ii) { const bf16x8 a = *(LDSA bf16x8*)(As + ii * 32 * 144 + ks * 32);
                    acc[ii][0] = mfma32(b0, a, acc[ii][0]); acc[ii][1] = mfma32(b1, a, acc[ii][1]); }
            }
        }
        __syncthreads();
    }
#undef GLOAD
#undef SSTORE
    ef(row0 + wm * 128 + n32, col0 + wn * 64 + 4 * h, acc);
}

struct AFPlain { const bf16_t* A; int lda; DEVI const bf16_t* operator()(int row, int kb, int kin) const { return A + (size_t)row * lda + kb + kin; } };
struct AFEvOut { const bf16_t* z; DEVI const bf16_t* operator()(int row, int kb, int kin) const { const int cb = kb < 1024 ? EC_GATEA + kb : EC_GATEB + (kb - 1024); return z + (size_t)row * LDZE + cb + kin; } };
struct AFCmp { const bf16_t* z; int colbase;
    DEVI const bf16_t* operator()(int R, int kb, int kin) const { const int k = kb + kin; const int b = R >> 7, g = (R >> 6) & 1, n = R & 63, l = k >> 7, d = k & 127;
        return z + (size_t)(b * SEQ + n * 64 + l) * LDZE + colbase + g * 128 + d; } };

struct EpiBf16 { bf16_t* C; int ldc;
    template <int NI> DEVI void operator()(int rbase, int cbase, f32x16 (&acc)[NI][2]) const {
#pragma unroll
        for (int i = 0; i < NI; ++i)
#pragma unroll
            for (int j = 0; j < 2; ++j)
#pragma unroll
                for (int g = 0; g < 4; ++g) { u32x2 w; w.x = pk2s(acc[i][j][4 * g], acc[i][j][4 * g + 1]); w.y = pk2s(acc[i][j][4 * g + 2], acc[i][j][4 * g + 3]);
                    *(u32x2*)(C + (size_t)(rbase + 32 * i) * ldc + cbase + 32 * j + 8 * g) = w; }
    } };
struct EpiResid { const float* xin; float* xout;
    template <int NI> DEVI void operator()(int rbase, int cbase, f32x16 (&acc)[NI][2]) const {
#pragma unroll
        for (int i = 0; i < NI; ++i)
#pragma unroll
            for (int j = 0; j < 2; ++j)
#pragma unroll
                for (int g = 0; g < 4; ++g) { const size_t off = (size_t)(rbase + 32 * i) * D_MODEL + cbase + 32 * j + 8 * g;
                    f32x4 v = *(const f32x4*)(xin + off); v[0] += acc[i][j][4 * g]; v[1] += acc[i][j][4 * g + 1]; v[2] += acc[i][j][4 * g + 2]; v[3] += acc[i][j][4 * g + 3];
                    *(f32x4*)(xout + off) = v; if (g == 3) asm volatile("" ::: "memory"); }
    } };
struct EpiProbe { float* C;
    template <int NI> DEVI void operator()(int rbase, int cbase, f32x16 (&acc)[NI][2]) const { float t = 0.f; for (int i = 0; i < NI; ++i) for (int j = 0; j < 2; ++j) for (int r = 0; r < 16; ++r) t += acc[i][j][r]; if (t == 123456.789f) C[rbase + cbase] = t; } };
struct EpiF32 { float* C; int ldc;
    template <int NI> DEVI void operator()(int rbase, int cbase, f32x16 (&acc)[NI][2]) const {
#pragma unroll
        for (int i = 0; i < NI; ++i)
#pragma unroll
            for (int j = 0; j < 2; ++j)
#pragma unroll
                for (int g = 0; g < 4; ++g) { f32x4 v; v[0] = acc[i][j][4 * g]; v[1] = acc[i][j][4 * g + 1]; v[2] = acc[i][j][4 * g + 2]; v[3] = acc[i][j][4 * g + 3];
                    *(f32x4*)(C + (size_t)(rbase + 32 * i) * ldc + cbase + 32 * j + 8 * g) = v; }
    } };
struct EpiQ { bf16_t* C; const float* cosT; const float* sinT;
    template <int NI> DEVI void operator()(int rbase, int cbase, f32x16 (&acc)[NI][2]) const {
        const int sub = (cbase & ~63) % 192;
        if (sub == 128) {
            const int hoff = cbase & 63;
#pragma unroll
            for (int i = 0; i < NI; ++i) { const int t = (rbase + 32 * i) & (SEQ - 1);
#pragma unroll
                for (int g = 0; g < 4; ++g) { const f32x4 c = *(const f32x4*)(cosT + t * 32 + hoff + 8 * g), s = *(const f32x4*)(sinT + t * 32 + hoff + 8 * g);
#pragma unroll
                    for (int e = 0; e < 4; ++e) { const float x1 = acc[i][0][4 * g + e], x2 = acc[i][1][4 * g + e];
                        acc[i][0][4 * g + e] = x1 * c[e] - x2 * s[e]; acc[i][1][4 * g + e] = x1 * s[e] + x2 * c[e]; }
                    asm volatile("" ::: "memory"); } }
        }
#pragma unroll
        for (int i = 0; i < NI; ++i)
#pragma unroll
            for (int j = 0; j < 2; ++j)
#pragma unroll
                for (int g = 0; g < 4; ++g) { u32x2 w; w.x = pk2(acc[i][j][4 * g] * MLA_SCALE2, acc[i][j][4 * g + 1] * MLA_SCALE2); w.y = pk2(acc[i][j][4 * g + 2] * MLA_SCALE2, acc[i][j][4 * g + 3] * MLA_SCALE2);
                    *(u32x2*)(C + (size_t)(rbase + 32 * i) * 3072 + cbase + 32 * j + 8 * g) = w; }
    } };

DEVI void tile_of(int L, int nM, int nN, int& pm, int& pn) { const int GM = 8, nig = GM * nN, gid = L / nig, fm = gid * GM; const int gsz = (nM - fm) < GM ? (nM - fm) : GM; pm = fm + (L % nig) % gsz; pn = (L % nig) / gsz; }

template <class AF, class EF>
DEVI void gemm_tile8(LDSA char* lds, int tid, AF af, const bf16_t* __restrict__ Bt, int ldb, int nk, int row0, int col0, EF ef) {
    const int lane = tid & 63, wave = __builtin_amdgcn_readfirstlane(tid >> 6), wm = wave >> 2, wn = wave & 3, n32 = lane & 31, h = lane >> 5;
    f32x16 acc[4][2];
#pragma unroll
    for (int i = 0; i < 4; ++i)
#pragma unroll
        for (int j = 0; j < 2; ++j) acc[i][j] = zero16();
    u32x4 ra[4], rb[4];
    const int cr = tid >> 3, ckc = tid & 7;
#define GLOAD(kt) do { int cr_ = cr; asm volatile("" : "+v"(cr_)); \
        _Pragma("unroll") for (int u = 0; u < 4; ++u) { ra[u] = *(const u32x4*)af(row0 + cr_ + 64 * u, (kt) * 64, ckc * 8); \
            rb[u] = *(const u32x4*)(Bt + (size_t)(col0 + cr_ + 64 * u) * ldb + (kt) * 64 + ckc * 8); } } while (0)
#define SSTORE(s) do { LDSA char* sb_ = lds + (s) * GRP_LDS + cr * 144 + ckc * 16; _Pragma("unroll") for (int u = 0; u < 4; ++u) { \
        *(LDSA u32x4*)(sb_ + u * 64 * 144) = ra[u]; *(LDSA u32x4*)(sb_ + 36864 + u * 64 * 144) = rb[u]; } } while (0)
    GLOAD(0); SSTORE(0);
    if (nk > 1) GLOAD(1);
    __syncthreads();
    for (int i = 0; i < nk; ++i) {
        LDSA char* As = lds + (i & 1) * GRP_LDS + (wm * 128 + n32) * 144 + h * 16;
        LDSA char* Bs = lds + (i & 1) * GRP_LDS + 36864 + (wn * 64 + n32) * 144 + h * 16;
#pragma unroll
        for (int ks = 0; ks < 4; ++ks) {
            const bf16x8 b0 = *(LDSA bf16x8*)(Bs + ks * 32), b1 = *(LDSA bf16x8*)(Bs + 32 * 144 + ks * 32);
#pragma unroll
            for (int ii = 0; ii < 4; ++ii) { const bf16x8 a = *(LDSA bf16x8*)(As + ii * 32 * 144 + ks * 32);
                acc[ii][0] = mfma32(b0, a, acc[ii][0]); acc[ii][1] = mfma32(b1, a, acc[ii][1]); }
        }
        if (i + 1 < nk) SSTORE((i + 1) & 1);
        if (i + 2 < nk) GLOAD(i + 2);
        __syncthreads();
    }
#undef GLOAD
#undef SSTORE
    ef(row0 + wm * 128 + n32, col0 + wn * 64 + 4 * h, acc);
}

template <class AF, class EF>
DEVI void gemm_phase(LDSA char* lds_phys, int tid_phys, AF af, const bf16_t* Bt, int ldb, int K, int M, int N, EF ef) {
    const int nM = M / 256, nN = N / 256, nt = nM * nN, G = gridDim.x, v = pblock();
    for (int L = v; L < nt; L += G) { int pm, pn; tile_of(L, nM, nN, pm, pn); gemm_tile8(lds_phys, tid_phys, af, Bt, ldb, K / 64, pm * 256, pn * 256, ef); }
}

namespace pg8 {
#define PG8_LAS __attribute__((address_space(3)))
typedef unsigned short bf16_t;
typedef short bf16x8 __attribute__((ext_vector_type(8)));
typedef float f32x4 __attribute__((ext_vector_type(4)));
typedef unsigned u32x4 __attribute__((ext_vector_type(4)));
constexpr int BM = 256, BK = 64, HALF = 128, HTB = HALF * BK * 2  , STAGE_BYTES = 8 * HTB, NXCD = 8, WGM = 4;

__host__ __device__ __forceinline__ int lds_byte(int r, int c) { const int st = (r >> 4) * 2 + (c >> 5), rr = r & 15, cc = c & 31, ob = rr * 64 + cc * 2; return st * 1024 + (ob ^ (((ob >> 9) & 1) << 5)); }
__host__ __device__ __forceinline__ void stage_rc(int b, int& R, int& C) { const int st = b / 1024, sb = b % 1024, swz = sb ^ (((sb >> 9) & 1) << 5); R = (st >> 1) * 16 + swz / 64; C = (st & 1) * 32 + (swz % 64) / 2; }
__host__ __device__ __forceinline__ int perm32(int rho) { const int n = rho >> 4, i = rho & 15; return 8 * (i >> 2) + 4 * n + (i & 3); }

struct Unit { int pm, pn; };
struct Gemm { const bf16_t* A; const bf16_t* Bt; int M, N, K, lda; };

struct StaticOrder {
    int nM, nN, nwg, G, c;
    __host__ __device__ void init(int M, int N, int G_, int c_) { nM = M / BM; nN = N / BM; nwg = nM * nN; G = G_; c = c_; }
    __host__ __device__ bool next(int i, Unit& u) const {
        const long L = (long)i * G + c; if (L >= nwg) return false;
        int wgid = (int)L; { const int q = nwg / NXCD, r = nwg % NXCD, xcd = wgid % NXCD, off = wgid / NXCD; wgid = (xcd < r ? xcd * (q + 1) : r * (q + 1) + (xcd - r) * q) + off; }
        const int nig = WGM * nN, gid = wgid / nig, fm = gid * WGM, gsz = (nM - fm) < WGM ? (nM - fm) : WGM;
        u.pm = fm + ((wgid % nig) % gsz); u.pn = (wgid % nig) / gsz; return true;
    }
    __device__ __forceinline__ void a_ready(const Unit&) const {}
    __device__ __forceinline__ void done(const Unit&) const {}
};
typedef float f32x4_ __attribute__((ext_vector_type(4)));
template <class Epi, class Sched, bool ALIGN_EPI = false, bool SP2 = false>
__device__ __forceinline__ void gemm_phase(PG8_LAS unsigned char* lds, const Gemm g, const Sched& S, const Epi& E) {
    const int tid = ::opq((int)threadIdx.x), wid = __builtin_amdgcn_readfirstlane(tid >> 6), lane = tid & 63, wr = wid >> 2, wc = wid & 3, fr = lane & 15, fq = lane >> 4;
    const int K = g.K, nt = K / BK;
    unsigned voffA[2], voffB[2];
#pragma unroll
    for (int i = 0; i < 2; ++i) { int R, C; stage_rc(tid * 16 + i * 8192, R, C); const int Rb = Epi::PERM ? ((R & ~31) + perm32(R & 31)) : R;
        voffA[i] = (unsigned)(R * g.lda + C) * 2u; voffB[i] = (unsigned)(Rb * K + C) * 2u; }
    const size_t kstep = (size_t)(BK * 2);
    const size_t hstepB = (size_t)HALF * K * 2, hstepA = (size_t)HALF * g.lda * 2;
    const size_t tstepB = 2 * hstepB, tstepA = 2 * hstepA;
    const unsigned ldsw = (unsigned)wid * 1024u;
    const int aoff = lds_byte(wr * 64 + fr, fq * 8), boff = lds_byte(wc * 32 + fr, fq * 8);
#define PG8_SA(b, h) (((b) * 2 + (h)) * HTB)
#define PG8_SB(b, h) ((4 + (b) * 2 + (h)) * HTB)
#define PG8_STAGE(bufoff, gbase, voff) do { _Pragma("unroll") for (int _i = 0; _i < 2; ++_i) \
        __builtin_amdgcn_global_load_lds((const unsigned*)((const char*)(gbase) + (voff)[_i]), (PG8_LAS unsigned*)(lds + (bufoff) + ldsw + _i * 8192), 16, 0, 0); } while (0)
#define PG8_LDA(dst, b, h) do { _Pragma("unroll") for (int m = 0; m < 4; ++m) _Pragma("unroll") for (int k = 0; k < 2; ++k) dst[m][k] = *(const PG8_LAS bf16x8*)(lds + PG8_SA(b, h) + aoff + m * 2048 + k * 1024); } while (0)
#define PG8_LDB(dst, b, h) do { _Pragma("unroll") for (int n = 0; n < 2; ++n) _Pragma("unroll") for (int k = 0; k < 2; ++k) dst[n][k] = *(const PG8_LAS bf16x8*)(lds + PG8_SB(b, h) + boff + n * 2048 + k * 1024); } while (0)
#define PG8_MMA(ai, bj, At, Bt) do { __builtin_amdgcn_s_setprio(1); _Pragma("unroll") for (int m = 0; m < 4; ++m) _Pragma("unroll") for (int n = 0; n < 2; ++n) _Pragma("unroll") for (int k = 0; k < 2; ++k) \
        acc[ai][bj][m][n] = __builtin_amdgcn_mfma_f32_16x16x32_bf16(Bt[n][k], At[m][k], acc[ai][bj][m][n], 0, 0, 0); __builtin_amdgcn_s_setprio(0); } while (0)
#define PG8_WAIT_V(n) asm volatile("s_waitcnt vmcnt(" #n ")" ::: "memory")
#define PG8_WAIT_L(n) asm volatile("s_waitcnt lgkmcnt(" #n ")" ::: "memory")
#define PG8_BAR __builtin_amdgcn_s_barrier()
#define PG8_SCHED __builtin_amdgcn_sched_barrier(0)
    Unit cur, nxt; int ui = 0;
    if (!S.next(0, cur)) return;
    f32x4 acc[2][2][4][2];
#pragma unroll
    for (int a = 0; a < 2; ++a)
#pragma unroll
        for (int b = 0; b < 2; ++b)
#pragma unroll
            for (int m = 0; m < 4; ++m)
#pragma unroll
                for (int n = 0; n < 2; ++n) acc[a][b][m][n] = (f32x4){0.f, 0.f, 0.f, 0.f};
    bf16x8 At[4][2], B0[2][2], B1[2][2];
    const char* cA = (const char*)g.A + (size_t)cur.pm * tstepA; const char* cB = (const char*)g.Bt + (size_t)cur.pn * tstepB;
    S.a_ready(cur);
    if constexpr (SP2) {
        PG8_STAGE(PG8_SB(0, 0), cB, voffB); PG8_STAGE(PG8_SB(0, 1), cB + hstepB, voffB); PG8_STAGE(PG8_SA(0, 0), cA, voffA); PG8_STAGE(PG8_SA(0, 1), cA + hstepA, voffA);
        if (wr == 1) PG8_BAR;
        PG8_WAIT_V(2); PG8_BAR;
        PG8_STAGE(PG8_SB(1, 0), cB + kstep, voffB); PG8_STAGE(PG8_SA(1, 0), cA + kstep, voffA); PG8_STAGE(PG8_SB(1, 1), cB + hstepB + kstep, voffB);
        PG8_WAIT_V(6); PG8_BAR;
    } else {
        PG8_STAGE(PG8_SB(0, 0), cB, voffB); PG8_STAGE(PG8_SA(0, 0), cA, voffA); PG8_STAGE(PG8_SB(0, 1), cB + hstepB, voffB); PG8_STAGE(PG8_SA(0, 1), cA + hstepA, voffA);
        if (wr == 1) PG8_BAR;
        PG8_WAIT_V(4); PG8_BAR;
        PG8_STAGE(PG8_SB(1, 0), cB + kstep, voffB); PG8_STAGE(PG8_SA(1, 0), cA + kstep, voffA); PG8_STAGE(PG8_SB(1, 1), cB + hstepB + kstep, voffB);
        PG8_WAIT_V(6); PG8_BAR;
    }
    for (;;) {
        const bool has_next = S.next(ui + 1, nxt);
        const char* nA = has_next ? (const char*)g.A + (size_t)nxt.pm * tstepA : cA; const char* nB = has_next ? (const char*)g.Bt + (size_t)nxt.pn * tstepB : cB;
        for (int t = 0; t < nt; t += 2) {
            const bool last = (t == nt - 2);
            const char* a1 = cA + (size_t)(t + 1) * kstep;
            const char* a2 = last ? nA : cA + (size_t)(t + 2) * kstep; const char* b2 = last ? nB : cB + (size_t)(t + 2) * kstep;
            const char* a3 = a2 + kstep; const char* b3 = b2 + kstep;
            if (last && has_next) S.a_ready(nxt);
            if constexpr (SP2) {
            PG8_LDB(B0, 0, 0); PG8_LDB(B1, 0, 1); PG8_SCHED; PG8_LDA(At, 0, 0); PG8_STAGE(PG8_SA(1, 1), a1 + hstepA, voffA);
            PG8_WAIT_V(8); PG8_WAIT_L(0); PG8_BAR; PG8_MMA(0, 0, At, B0); PG8_MMA(0, 1, At, B1); PG8_BAR; PG8_SCHED;
            PG8_LDA(At, 0, 1); PG8_STAGE(PG8_SB(0, 0), b2, voffB); PG8_STAGE(PG8_SB(0, 1), b2 + hstepB, voffB); PG8_STAGE(PG8_SA(0, 0), a2, voffA);
            PG8_WAIT_V(8); PG8_WAIT_L(0); PG8_BAR; PG8_MMA(1, 0, At, B0); PG8_MMA(1, 1, At, B1); PG8_BAR; PG8_SCHED;
            PG8_LDB(B0, 1, 0); PG8_LDB(B1, 1, 1); PG8_SCHED; PG8_LDA(At, 1, 0); PG8_STAGE(PG8_SA(0, 1), a2 + hstepA, voffA);
            PG8_WAIT_V(8); PG8_WAIT_L(0); PG8_BAR; PG8_MMA(0, 0, At, B0); PG8_MMA(0, 1, At, B1); PG8_BAR; PG8_SCHED;
            PG8_LDA(At, 1, 1); PG8_STAGE(PG8_SB(1, 0), b3, voffB); PG8_STAGE(PG8_SB(1, 1), b3 + hstepB, voffB); PG8_STAGE(PG8_SA(1, 0), a3, voffA);
            PG8_WAIT_V(8); PG8_WAIT_L(0); PG8_BAR; PG8_MMA(1, 0, At, B0); PG8_MMA(1, 1, At, B1); PG8_BAR; PG8_SCHED;
            } else {
            PG8_LDB(B0, 0, 0); PG8_SCHED; PG8_LDA(At, 0, 0); PG8_STAGE(PG8_SA(1, 1), a1 + hstepA, voffA);
            PG8_WAIT_L(8); PG8_BAR; PG8_WAIT_L(0); PG8_MMA(0, 0, At, B0); PG8_BAR; PG8_SCHED;
            PG8_LDB(B1, 0, 1); PG8_STAGE(PG8_SB(0, 0), b2, voffB);
            PG8_BAR; PG8_WAIT_L(0); PG8_MMA(0, 1, At, B1); PG8_BAR;
            PG8_LDA(At, 0, 1); PG8_STAGE(PG8_SA(0, 0), a2, voffA);
            PG8_BAR; PG8_WAIT_L(0); PG8_MMA(1, 0, At, B0); PG8_BAR; PG8_SCHED;
            PG8_STAGE(PG8_SB(0, 1), b2 + hstepB, voffB);
            PG8_WAIT_V(6); PG8_BAR; PG8_MMA(1, 1, At, B1); PG8_BAR;
            PG8_LDB(B0, 1, 0); PG8_SCHED; PG8_LDA(At, 1, 0); PG8_STAGE(PG8_SA(0, 1), a2 + hstepA, voffA);
            PG8_WAIT_L(8); PG8_BAR; PG8_WAIT_L(0); PG8_MMA(0, 0, At, B0); PG8_BAR; PG8_SCHED;
            PG8_LDB(B1, 1, 1); PG8_STAGE(PG8_SB(1, 0), b3, voffB);
            PG8_BAR; PG8_WAIT_L(0); PG8_MMA(0, 1, At, B1); PG8_BAR;
            PG8_LDA(At, 1, 1); PG8_STAGE(PG8_SA(1, 0), a3, voffA);
            PG8_BAR; PG8_WAIT_L(0); PG8_MMA(1, 0, At, B0); PG8_BAR; PG8_SCHED;
            PG8_STAGE(PG8_SB(1, 1), b3 + hstepB, voffB);
            PG8_WAIT_V(6); PG8_BAR; PG8_MMA(1, 1, At, B1); PG8_BAR;
            }
        }
        if constexpr (ALIGN_EPI) { if (wr == 0) PG8_BAR; }
        if constexpr (!Epi::AFTER_DRAIN) { E(acc, cur, wr, wc, fr, fq); S.done(cur); }
        if (!has_next) break;
#pragma unroll
        for (int a = 0; a < 2; ++a)
#pragma unroll
            for (int b = 0; b < 2; ++b)
#pragma unroll
                for (int m = 0; m < 4; ++m)
#pragma unroll
                    for (int n = 0; n < 2; ++n) acc[a][b][m][n] = (f32x4){0.f, 0.f, 0.f, 0.f};
        cur = nxt; cA = nA; cB = nB; ++ui;
        if constexpr (ALIGN_EPI) { if (wr == 1) PG8_BAR; }
    }
    PG8_WAIT_V(0);
    if constexpr (!ALIGN_EPI) { if (wr == 0) PG8_BAR; }
    PG8_BAR;
    if constexpr (Epi::AFTER_DRAIN) { E.fused(acc, cur, wr, wc, fr, fq, lds, wid, lane); S.done(cur); }
#undef PG8_SA
#undef PG8_SB
#undef PG8_STAGE
#undef PG8_LDA
#undef PG8_LDB
#undef PG8_MMA
#undef PG8_WAIT_V
#undef PG8_WAIT_L
#undef PG8_BAR
#undef PG8_SCHED
}
}

namespace pg8 {
struct PEpiBf16 { static constexpr bool PERM = true, AFTER_DRAIN = false; bf16_t* O; int ldc;
    __device__ __forceinline__ void operator()(const f32x4 (&acc)[2][2][4][2], const Unit& u, int wr, int wc, int fr, int fq) const {
        const int row0 = u.pm * BM + wr * 64 + fr, col0 = u.pn * BM + wc * 32 + 8 * fq;
#pragma unroll
        for (int ai = 0; ai < 2; ++ai)
#pragma unroll
            for (int m = 0; m < 4; ++m) { bf16_t* rowp = O + (size_t)(row0 + ai * HALF + m * 16) * ldc + col0;
#pragma unroll
                for (int bj = 0; bj < 2; ++bj) { const f32x4 v0 = acc[ai][bj][m][0], v1 = acc[ai][bj][m][1]; u32x4 w;
                    w.x = ::pk2s(v0[0], v0[1]); w.y = ::pk2s(v0[2], v0[3]); w.z = ::pk2s(v1[0], v1[1]); w.w = ::pk2s(v1[2], v1[3]);
                    *(u32x4*)(rowp + bj * HALF) = w; } }
    } };
struct PEpiResid { static constexpr bool PERM = false, AFTER_DRAIN = false; const float* xin; float* xout;
    __device__ __forceinline__ void operator()(const f32x4 (&acc)[2][2][4][2], const Unit& u, int wr, int wc, int fr, int fq) const {
        const int row0 = u.pm * BM + wr * 64 + fr, col0 = u.pn * BM + wc * 32 + 4 * fq;
#pragma unroll
        for (int ai = 0; ai < 2; ++ai)
#pragma unroll
            for (int m = 0; m < 4; ++m) { const size_t off = (size_t)(row0 + ai * HALF + m * 16) * D_MODEL + col0;
#pragma unroll
                for (int bj = 0; bj < 2; ++bj)
#pragma unroll
                    for (int n = 0; n < 2; ++n) { f32x4 v = *(const f32x4*)(xin + off + bj * HALF + n * 16); v += acc[ai][bj][m][n]; *(f32x4*)(xout + off + bj * HALF + n * 16) = v; }
                asm volatile("" ::: "memory"); }
    } };
struct PEpiBf16S { static constexpr bool PERM = true, AFTER_DRAIN = false; bf16_t* O; int ldc; const float* rstd;
    __device__ __forceinline__ void operator()(const f32x4 (&acc)[2][2][4][2], const Unit& u, int wr, int wc, int fr, int fq) const {
        const int row0 = u.pm * BM + wr * 64 + fr, col0 = u.pn * BM + wc * 32 + 8 * fq;
#pragma unroll
        for (int ai = 0; ai < 2; ++ai)
#pragma unroll
            for (int m = 0; m < 4; ++m) { const int row = row0 + ai * HALF + m * 16; const float rs = rstd[row]; bf16_t* rowp = O + (size_t)row * ldc + col0;
#pragma unroll
                for (int bj = 0; bj < 2; ++bj) { const f32x4 v0 = acc[ai][bj][m][0] * rs, v1 = acc[ai][bj][m][1] * rs; u32x4 w;
                    w.x = ::pk2(v0[0], v0[1]); w.y = ::pk2(v0[2], v0[3]); w.z = ::pk2(v1[0], v1[1]); w.w = ::pk2(v1[2], v1[3]);
                    *(u32x4*)(rowp + bj * HALF) = w; } }
    } };
struct PEpiResidX { static constexpr bool PERM = true, AFTER_DRAIN = false; const float* xin; float* xout; bf16_t* xb; float* ssp;
    __device__ __forceinline__ void operator()(const f32x4 (&acc)[2][2][4][2], const Unit& u, int wr, int wc, int fr, int fq) const {
        const int row0 = u.pm * BM + wr * 64 + fr, col0 = u.pn * BM + wc * 32 + 8 * fq;
#pragma unroll
        for (int ai = 0; ai < 2; ++ai)
#pragma unroll
            for (int m = 0; m < 4; ++m) { const int row = row0 + ai * HALF + m * 16; const size_t off = (size_t)row * D_MODEL + col0; float ss = 0.f;
#pragma unroll
                for (int bj = 0; bj < 2; ++bj) { f32x4 v0 = *(const f32x4*)(xin + off + bj * HALF), v1 = *(const f32x4*)(xin + off + bj * HALF + 4);
                    v0 += acc[ai][bj][m][0]; v1 += acc[ai][bj][m][1]; *(f32x4*)(xout + off + bj * HALF) = v0; *(f32x4*)(xout + off + bj * HALF + 4) = v1;
                    ss += ((v0[0] * v0[0] + v0[1] * v0[1]) + (v0[2] * v0[2] + v0[3] * v0[3])) + ((v1[0] * v1[0] + v1[1] * v1[1]) + (v1[2] * v1[2] + v1[3] * v1[3]));
                    u32x4 w; w.x = ::pk2(v0[0], v0[1]); w.y = ::pk2(v0[2], v0[3]); w.z = ::pk2(v1[0], v1[1]); w.w = ::pk2(v1[2], v1[3]); *(u32x4*)(xb + off + bj * HALF) = w; }
                ss += __shfl_xor(ss, 16); ss += __shfl_xor(ss, 32);
                if (fq == 0) ssp[(size_t)row * 32 + u.pn * 4 + wc] = ss;
                asm volatile("" ::: "memory"); }
    } };
template <class Epi> __device__ __forceinline__ void run(LDSA char* lds_phys, const bf16_t* A, int lda, const bf16_t* Bt, int M, int N, int K, const Epi& E) {
    Gemm g{A, Bt, M, N, K, lda}; StaticOrder S; S.init(M, N, (int)gridDim.x, (int)blockIdx.x);
    gemm_phase<Epi, StaticOrder, true, true>((PG8_LAS unsigned char*)lds_phys, g, S, E);
}
}

struct TileDesc { const bf16_t* kp; const bf16_t* vp; const bf16_t* k2p; int kidx0; };
constexpr int ATT_VOFF = 25600, ATT_BOFF = 46080, ATT_VSTR = 320;
constexpr int CMP_POFF = 37888, CMP_PSTR = 68, CMP_LOFF = CMP_POFF + 4 * 32 * CMP_PSTR * 4;

typedef short s16x4 __attribute__((ext_vector_type(4)));
DEVI bf16x8 vfrag(LDSA char* vp) {
    const s16x4 a = __builtin_amdgcn_ds_read_tr16_b64_v4i16((LDSA s16x4*)vp), b = __builtin_amdgcn_ds_read_tr16_b64_v4i16((LDSA s16x4*)(vp + 8 * ATT_VSTR));
    return (bf16x8){a[0], a[1], a[2], a[3], b[0], b[1], b[2], b[3]};
}
template <int C> DEVI void pv_step(LDSA char* vp, f32x16& o, const bf16x8 (&pk)[2][2]) {
    const bf16x8 f00 = vfrag(vp + 64 * C), f01 = vfrag(vp + 16 * ATT_VSTR + 64 * C), f10 = vfrag(vp + 32 * ATT_VSTR + 64 * C), f11 = vfrag(vp + 48 * ATT_VSTR + 64 * C);
    o = mfma32(f00, pk[0][0], o); o = mfma32(f01, pk[0][1], o); o = mfma32(f10, pk[1][0], o); o = mfma32(f11, pk[1][1], o);
}

template <int MODE, class TileFn, class EpiFn>
DEVI void attn_core(LDSA char* lds, int tid, const bf16_t* qrow, int qidx, int qidx0w, int ntiles, int nsync, int kst, int vst, int k2st, TileFn tilefn, const float* btab, int bmax,
                    unsigned long long selm, EpiFn epi) {
    constexpr int DQK = (MODE == 0) ? 192 : 128, KSTR = DQK * 2 + 16, KCH = DQK / 8, NKL = 64 * KCH / 256, NKS = DQK / 16;
    constexpr bool LBIAS = (MODE == 1 || MODE == 2 || MODE == 3);
    const int lane = tid & 63, wave = __builtin_amdgcn_readfirstlane(tid >> 6), n = lane & 31, h = lane >> 5;
    LDSA char* Ks = lds; LDSA char* Vs = lds + (MODE == 4 ? 17408 : ATT_VOFF); LDSA float* Bw = (LDSA float*)(lds + ATT_BOFF) + wave * 96;
    bf16x8 qf[NKS];
#pragma unroll
    for (int ks = 0; ks < NKS; ++ks) qf[ks] = *(const bf16x8*)(qrow + 16 * ks + 8 * h);
    if (MODE == 0) {
        const float* ct = btab + (size_t)qidx * 32 + 8 * h; const float* st = ct + 4096 * 32;
#pragma unroll
        for (int kk = 0; kk < 2; ++kk) { v4i a = __builtin_bit_cast(v4i, qf[8 + kk]), b2 = __builtin_bit_cast(v4i, qf[10 + kk]);
#pragma unroll
            for (int j = 0; j < 4; ++j) { const float c0 = ct[16 * kk + 2 * j], c1 = ct[16 * kk + 2 * j + 1], s0_ = st[16 * kk + 2 * j], s1_ = st[16 * kk + 2 * j + 1];
                const float x10 = lo2f((unsigned)a[j]), x11 = hi2f((unsigned)a[j]), x20 = lo2f((unsigned)b2[j]), x21 = hi2f((unsigned)b2[j]);
                a[j] = (int)pk2(x10 * c0 - x20 * s0_, x11 * c1 - x21 * s1_); b2[j] = (int)pk2(x10 * s0_ + x20 * c0, x11 * s1_ + x21 * c1); }
            qf[8 + kk] = __builtin_bit_cast(bf16x8, a); qf[10 + kk] = __builtin_bit_cast(bf16x8, b2); }
    }
    f32x16 o[4];
#pragma unroll
    for (int c = 0; c < 4; ++c) o[c] = zero16();
    float m = -INFINITY, l = 0.f;
    u32x4 kreg[4], vreg[4]; float breg0 = 0.f, breg1 = 0.f; int next_kidx0 = 0;
    LDSA char* const vp = Vs + (4 * h + ((lane & 15) >> 2)) * ATT_VSTR + (16 * ((lane >> 4) & 1) + 4 * (lane & 3)) * 2;
    const unsigned koff = (unsigned)(tid >> 4) * (unsigned)kst + (tid & 15) * 8, voff = (unsigned)(tid >> 4) * (unsigned)vst + (tid & 15) * 8;
    const unsigned k2off = (unsigned)(tid >> 3) * (unsigned)k2st + (tid & 7) * 8;
    u32x4 k2reg[2];
#define AISSUE(it) do { TileDesc td; tilefn((it), td); next_kidx0 = td.kidx0; \
        _Pragma("unroll") for (int u = 0; u < 4; ++u) kreg[u] = *(const u32x4*)(td.kp + (size_t)(16 * u) * kst + koff); \
        if (MODE == 0) { _Pragma("unroll") for (int u = 0; u < 2; ++u) k2reg[u] = *(const u32x4*)(td.k2p + (size_t)(32 * u) * k2st + k2off); } \
        _Pragma("unroll") for (int u = 0; u < 4; ++u) vreg[u] = *(const u32x4*)(td.vp + (size_t)(16 * u) * vst + voff); \
        if (LBIAS) { const int D0 = qidx0w - td.kidx0; int i0 = D0 + 31 - lane, i1 = D0 + 31 - (lane + 64); \
            breg0 = (i0 >= 0 && i0 <= bmax) ? btab[i0] : 0.f; breg1 = (lane < 32 && i1 >= 0 && i1 <= bmax) ? btab[i1] : 0.f; } } while (0)
    AISSUE(0);
    const int nloop = (MODE == 3) ? nsync : ntiles;
    for (int it = 0; it < nloop; ++it) {
        const int kidx0 = next_kidx0; const bool act = (MODE == 3) ? (it < ntiles) : true;
        __syncthreads();
        if (act) {
#pragma unroll
        for (int u = 0; u < 4; ++u) *(LDSA u32x4*)(Ks + (tid >> 4) * KSTR + (tid & 15) * 16 + u * 16 * KSTR) = kreg[u];
        if (MODE == 0) {
#pragma unroll
            for (int u = 0; u < 2; ++u) *(LDSA u32x4*)(Ks + (tid >> 3) * KSTR + 256 + (tid & 7) * 16 + u * 32 * KSTR) = k2reg[u]; }
#pragma unroll
        for (int u = 0; u < 4; ++u) *(LDSA u32x4*)(Vs + (tid >> 4) * ATT_VSTR + (tid & 15) * 16 + u * 16 * ATT_VSTR) = vreg[u];
        if (LBIAS) { Bw[lane] = breg0; if (lane < 32) Bw[lane + 64] = breg1; }
        }
        __syncthreads();
        if (it + 1 < ntiles) AISSUE(it + 1);
        __builtin_amdgcn_sched_barrier(0);
        const int dlo = qidx0w - (kidx0 + 63);
        const int dhi = qidx0w + 31 - kidx0;
        bool skip = false, full = false; bool selbit = true;
        if (MODE == 0) { skip = dhi < 0; full = dlo >= 0; }
        if (MODE == 1) { skip = dhi < 0 || dlo >= 512; full = dlo >= 0 && dhi < 512; }
        if (MODE == 2) { skip = dhi < 0 || dlo > 128; full = dlo >= 0 && dhi <= 128; }
        if (MODE == 3) { selbit = (selm >> (kidx0 >> 6)) & 1ull; skip = (__ballot(selbit) == 0ull) || dhi < 0; full = false; }
        if (MODE == 4) { skip = false; full = false; }
        if (act && !skip) {
            f32x16 s0 = zero16(), s1 = zero16();
            LDSA char* kb = Ks + n * KSTR + h * 16;
#pragma unroll
            for (int ks = 0; ks < NKS; ++ks) {
                const bf16x8 k0 = *(LDSA bf16x8*)(kb + ks * 32), k1 = *(LDSA bf16x8*)(kb + 32 * KSTR + ks * 32);
                s0 = mfma32(k0, qf[ks], s0); s1 = mfma32(k1, qf[ks], s1);
            }
            const float sc = (MODE == 0) ? 1.0f : NSA_SCALE2;
            int dbase = qidx - kidx0 - 4 * h;
            asm volatile("" : "+v"(dbase));
            float tmax = -INFINITY;
            if (MODE == 3 && dlo >= 0) {
                const float sel_off = selbit ? 0.f : -INFINITY;
#pragma unroll
                for (int mt = 0; mt < 2; ++mt)
#pragma unroll
                    for (int r = 0; r < 16; ++r) {
                        const int ko = 32 * mt + 8 * (r >> 2) + (r & 3);
                        float v = (mt ? s1[r] : s0[r]) * sc + Bw[(31 - n + 4 * h) + ko] + sel_off;
                        if (mt) s1[r] = v; else s0[r] = v;
                        tmax = fmaxf(tmax, v);
                    }
            } else
            if ((MODE == 0 || MODE == 1 || MODE == 2) && full) {
#pragma unroll
                for (int mt = 0; mt < 2; ++mt)
#pragma unroll
                    for (int r = 0; r < 16; ++r) {
                        const int ko = 32 * mt + 8 * (r >> 2) + (r & 3);
                        float v = (mt ? s1[r] : s0[r]) * sc;
                        if (LBIAS) v += Bw[(31 - n + 4 * h) + ko];
                        if (mt) s1[r] = v; else s0[r] = v;
                        tmax = fmaxf(tmax, v);
                    }
            } else {
#pragma unroll
            for (int mt = 0; mt < 2; ++mt)
#pragma unroll
                for (int r = 0; r < 16; ++r) {
                    const int ko = 32 * mt + 8 * (r >> 2) + (r & 3);
                    float v = (mt ? s1[r] : s0[r]) * sc;
                    if (LBIAS) v += Bw[(31 - n + 4 * h) + ko];
                    if (MODE == 4) { const int kidx = kidx0 + 4 * h + ko; const int nvalid = (qidx + 1) >> 6;
                        if (kidx < nvalid) v += btab[qidx - 64 * kidx - 63]; else v = -INFINITY; }
                    else if (!full) { const int dist = dbase - ko; bool ok = dist >= 0;
                        if (MODE == 1) ok = ok && dist < 512;
                        if (MODE == 2) ok = ok && dist <= 128;
                        if (MODE == 3) ok = ok && selbit;
                        if (!ok) v = -INFINITY; }
                    if (mt) s1[r] = v; else s0[r] = v;
                    tmax = fmaxf(tmax, v);
                }
                asm volatile("" ::: "memory");
            }
            tmax = fmaxf(tmax, __shfl_xor(tmax, 32));
            const float mnew = fmaxf(m, tmax), msafe = (mnew == -INFINITY) ? 0.f : mnew;
            const float alpha = fexp2(m - msafe);
            float ps = 0.f;
#pragma unroll
            for (int r = 0; r < 16; ++r) { s0[r] = fexp2(s0[r] - msafe); ps += s0[r]; }
#pragma unroll
            for (int r = 0; r < 16; ++r) { s1[r] = fexp2(s1[r] - msafe); ps += s1[r]; }
            l = l * alpha + ps; m = mnew;
            if (__ballot(alpha != 1.0f) != 0ull) {
#pragma unroll
                for (int c = 0; c < 4; ++c)
#pragma unroll
                    for (int r = 0; r < 16; ++r) o[c][r] *= alpha;
            }
            if (MODE == 4) {
                LDSA float* pb = (LDSA float*)(lds + CMP_POFF) + (wave * 32 + n) * CMP_PSTR + 4 * h;
#pragma unroll
                for (int mt = 0; mt < 2; ++mt)
#pragma unroll
                    for (int g = 0; g < 4; ++g) { f32x4 pv; for (int e = 0; e < 4; ++e) pv[e] = mt ? s1[4 * g + e] : s0[4 * g + e]; *(LDSA f32x4*)(pb + 32 * mt + 8 * g) = pv; }
            }
            bf16x8 pk[2][2];
#pragma unroll
            for (int j = 0; j < 2; ++j) {
                v4i a; a.x = (int)pk2(s0[8 * j], s0[8 * j + 1]); a.y = (int)pk2(s0[8 * j + 2], s0[8 * j + 3]); a.z = (int)pk2(s0[8 * j + 4], s0[8 * j + 5]); a.w = (int)pk2(s0[8 * j + 6], s0[8 * j + 7]);
                pk[0][j] = __builtin_bit_cast(bf16x8, a);
                v4i b; b.x = (int)pk2(s1[8 * j], s1[8 * j + 1]); b.y = (int)pk2(s1[8 * j + 2], s1[8 * j + 3]); b.z = (int)pk2(s1[8 * j + 4], s1[8 * j + 5]); b.w = (int)pk2(s1[8 * j + 6], s1[8 * j + 7]);
                pk[1][j] = __builtin_bit_cast(bf16x8, b);
            }
            pv_step<0>(vp, o[0], pk); pv_step<1>(vp, o[1], pk); pv_step<2>(vp, o[2], pk); pv_step<3>(vp, o[3], pk);
        }
    }
#undef AISSUE
    l += __shfl_xor(l, 32);
    epi(o, l, m);
    __syncthreads();
}

template <int MAP> DEVI int colmap(int n) {
    if (MAP == 1) { if (n < 2560) return n; if (n < 8704) return n + 24; if (n < 8728) return n - 8704 + 2560; return -1; }
    if (MAP == 2) { if (n < 2048) return n; if (n < 4096) return n + 64; if (n < 4160) return n - 4096 + 2048; return -1; }
    return n;
}
template <int MAP>
DEVI void transpose_job(LDSA char* lds, int tid, const float* __restrict__ src, int K, int Nsrc, bf16_t* __restrict__ dst, int Npad, float wscale = 1.0f, const float* __restrict__ kscale = nullptr) {
    LDSA float* T = (LDSA float*)lds;
    const int nKt = K / 64, nNt = Npad / 64, nt = nKt * nNt, G = vgrid();
    for (int t = vblock(); t < nt; t += G) {
        const int kt = t % nKt, ntile = t / nKt, k0 = kt * 64, n0 = ntile * 64;
        const int nl = tid & 63, sc = colmap<MAP>(n0 + nl);
#pragma unroll
        for (int u = 0; u < 16; ++u) { const int kl = (tid >> 6) + 4 * u; T[kl * 65 + nl] = (sc >= 0) ? src[(size_t)(k0 + kl) * Nsrc + sc] * (kscale ? kscale[k0 + kl] : wscale) : 0.f; }
        __syncthreads();
#pragma unroll
        for (int u = 0; u < 2; ++u) { const int c = tid + 256 * u, n2 = c >> 3, kc = c & 7; u32x4 w;
            w.x = pk2(T[(kc * 8 + 0) * 65 + n2], T[(kc * 8 + 1) * 65 + n2]); w.y = pk2(T[(kc * 8 + 2) * 65 + n2], T[(kc * 8 + 3) * 65 + n2]);
            w.z = pk2(T[(kc * 8 + 4) * 65 + n2], T[(kc * 8 + 5) * 65 + n2]); w.w = pk2(T[(kc * 8 + 6) * 65 + n2], T[(kc * 8 + 7) * 65 + n2]);
            *(u32x4*)(dst + (size_t)(n0 + n2) * K + k0 + kc * 8) = w; }
        __syncthreads();
    }
}
DEVI int t5_bucket(int d) { if (d < 16) return d; const float v = __builtin_log2f((float)d * 0.0625f) * (16.0f / 7.0f); int b = 16 + (int)v; return b > 31 ? 31 : b; }

DEVI void phase_prep(const Params& P, LDSA char* lds, int tid) {
    unsigned char* ws = P.ws;
    for (int i = 0; i < 2; ++i) {
        transpose_job<1>(lds, tid, P.ev_w_in + (size_t)i * 2048 * 8728, 2048, 8728, (bf16_t*)(ws + WS_WEVIN + i * SZ_WEVIN), LDZE, 1.0f, P.norm_w + (2 * i) * D_MODEL);
        transpose_job<0>(lds, tid, P.ev_w_out + (size_t)i * 1536 * 2048, 1536, 2048, (bf16_t*)(ws + WS_WEVOUT + i * SZ_WEVOUT), 2048);
        transpose_job<2>(lds, tid, P.od_w_in + (size_t)i * 2048 * 4160, 2048, 4160, (bf16_t*)(ws + WS_WODIN + i * SZ_WODIN), LDZO, 1.0f, P.norm_w + (2 * i + 1) * D_MODEL);
        transpose_job<0>(lds, tid, P.w_qb + (size_t)i * 1536 * 3072, 1536, 3072, (bf16_t*)(ws + WS_WQB + i * SZ_WQB), 3072, MLA_SCALE2);
        transpose_job<0>(lds, tid, P.w_kvb + (size_t)i * 512 * 4096, 512, 4096, (bf16_t*)(ws + WS_WKVB + i * SZ_WKVB), 4096);
        transpose_job<0>(lds, tid, P.od_w_out + (size_t)i * 2048 * 2048, 2048, 2048, (bf16_t*)(ws + WS_WODOUT + i * SZ_WODOUT), 2048);
        for (int kv = 0; kv < 2; ++kv)
            transpose_job<0>(lds, tid, P.cmp_w1 + (size_t)(i * 2 + kv) * 8192 * 128, 8192, 128, (bf16_t*)(ws + WS_W1 + (i * 2 + kv) * SZ_W1), 128);
    }
    const int G = vgrid(), gt = vblock() * GTHREADS + tid, GT = G * GTHREADS;
    float* biasT = (float*)(ws + WS_BIAST); float* biasD = (float*)(ws + WS_BIASD);
    for (int i = gt; i < 20 * 4096; i += GT) { const int hh = i >> 12, d = i & 4095; biasT[i] = P.rel_bias[t5_bucket(d) * 20 + hh] * LOG2E; }
    for (int i = gt; i < 12 * 132; i += GT) { const int gh = i / 132, j = i % 132, g = gh >> 2; const int dd = g == 0 ? 1 : (g == 1 ? 4 : 16);
        biasD[i] = (j <= 128) ? P.rel_bias[t5_bucket(j * dd) * 20 + 8 + gh] * LOG2E : 0.f; }
    float* cosT = (float*)(ws + WS_COS); float* sinT = (float*)(ws + WS_SIN);
    double dz; { int zz = 0; asm volatile("" : "+v"(zz)); dz = (double)zz; }
    for (int i = gt; i < 4096 * 32; i += GT) {
        const int t = i >> 5, fi = i & 31; double f = 1.0; for (int q = 0; q < fi; ++q) f *= 0.7498942093324559;
        const float ang = (float)t * (float)f; const double a = (double)ang; const double kq = __builtin_rint(a * 0.6366197723675814);
        const double r = a - kq * 1.5707963267948966, r2 = r * r;
        const double sn = r * (1.0 + r2 * ((dz - 1.0 / 6) + r2 * ((dz + 1.0 / 120) + r2 * ((dz - 1.0 / 5040) + r2 * ((dz + 1.0 / 362880) + r2 * ((dz - 1.0 / 39916800) + r2 * (dz + 1.0 / 6227020800.0)))))));
        const double cs = 1.0 + r2 * ((dz - 0.5) + r2 * ((dz + 1.0 / 24) + r2 * ((dz - 1.0 / 720) + r2 * ((dz + 1.0 / 40320) + r2 * ((dz - 1.0 / 3628800) + r2 * (dz + 1.0 / 479001600.0))))));
        const int qd = ((int)kq) & 3; double S = sn, C = cs; if (qd == 1) { S = cs; C = -sn; } else if (qd == 2) { S = -sn; C = -cs; } else if (qd == 3) { S = -cs; C = sn; }
        cosT[i] = (float)C; sinT[i] = (float)S;
    }
    float* posp = (float*)(ws + WS_POSP); LDSA float* red = (LDSA float*)lds;
    for (int it = vblock(); it < 32; it += G) {
        const int lkv = it >> 3, part = it & 7, j = tid & 127, half = tid >> 7;
        const float* pos = P.cmp_pos + (size_t)lkv * 8192; const float* w1 = P.cmp_w1 + (size_t)lkv * 8192 * 128;
        float s = 0.f; const int kb = part * 1024 + half * 512;
        for (int k = 0; k < 512; ++k) s += pos[kb + k] * w1[(size_t)(kb + k) * 128 + j];
        __syncthreads(); if (half) red[j] = s; __syncthreads(); if (!half) posp[(lkv * 8 + part) * 128 + j] = s + red[j]; __syncthreads();
    }
}

template <bool OUTF32>
DEVI void phase_rms(const float* __restrict__ x, const float* __restrict__ w, void* outp, int tid) {
    const int lane = tid & 63, wave = __builtin_amdgcn_readfirstlane(tid >> 6), G = vgrid();
    for (int rb = vblock(); rb < MTOK / 4; rb += G) {
        const int row = rb * 4 + wave; const float* xr = x + (size_t)row * D_MODEL;
        f32x4 v[8]; float ss = 0.f;
#pragma unroll
        for (int u = 0; u < 8; ++u) { v[u] = *(const f32x4*)(xr + (u * 64 + lane) * 4); ss += v[u][0] * v[u][0] + v[u][1] * v[u][1] + v[u][2] * v[u][2] + v[u][3] * v[u][3]; }
        ss = wave_sum(ss); const float rstd = rsqrtf(ss * (1.0f / D_MODEL) + 1e-6f);
#pragma unroll
        for (int u = 0; u < 8; ++u) { const f32x4 ww = *(const f32x4*)(w + (u * 64 + lane) * 4); f32x4 y; for (int e = 0; e < 4; ++e) y[e] = v[u][e] * rstd * ww[e];
            if (OUTF32) *(f32x4*)((float*)outp + (size_t)row * D_MODEL + (u * 64 + lane) * 4) = y;
            else { u32x2 pk; pk.x = pk2(y[0], y[1]); pk.y = pk2(y[2], y[3]); *(u32x2*)((bf16_t*)outp + (size_t)row * D_MODEL + (u * 64 + lane) * 4) = pk; } }
    }
}

DEVI void phase_xb(const float* __restrict__ x, bf16_t* xb, float* rstd, int tid) {
    const int lane = tid & 63, wave = __builtin_amdgcn_readfirstlane(tid >> 6), G = vgrid();
    for (int rb = vblock(); rb < MTOK / 4; rb += G) {
        const int row = rb * 4 + wave; const float* xr = x + (size_t)row * D_MODEL;
        f32x4 v[8]; float ss = 0.f;
#pragma unroll
        for (int u = 0; u < 8; ++u) { v[u] = *(const f32x4*)(xr + (u * 64 + lane) * 4); ss += v[u][0] * v[u][0] + v[u][1] * v[u][1] + v[u][2] * v[u][2] + v[u][3] * v[u][3]; }
        ss = wave_sum(ss); if (lane == 0) rstd[row] = rsqrtf(ss * (1.0f / D_MODEL) + 1e-6f);
#pragma unroll
        for (int u = 0; u < 8; ++u) { u32x2 pk; pk.x = pk2(v[u][0], v[u][1]); pk.y = pk2(v[u][2], v[u][3]); *(u32x2*)(xb + (size_t)row * D_MODEL + (u * 64 + lane) * 4) = pk; }
    }
}
DEVI void phase_rstd(const float* __restrict__ ssp, float* rstd, int tid) {
    const int G = vgrid();
    for (int row = vblock() * GTHREADS + tid; row < MTOK; row += G * GTHREADS) {
        const f32x4* p = (const f32x4*)(ssp + (size_t)row * 32); float s = 0.f;
#pragma unroll
        for (int u = 0; u < 8; ++u) { const f32x4 a = p[u]; s += (a[0] + a[1]) + (a[2] + a[3]); }
        rstd[row] = rsqrtf(s * (1.0f / D_MODEL) + 1e-6f);
    }
}

DEVI void phase_norms(bf16_t* z, const float* __restrict__ qn, const float* __restrict__ kvn, const float* cosT, const float* sinT, int tid) {
    const int lane = tid & 63, wave = __builtin_amdgcn_readfirstlane(tid >> 6), G = vgrid();
    for (int rb = vblock(); rb < MTOK / 4; rb += G) {
        const int row = rb * 4 + wave; bf16_t* zr = z + (size_t)row * LDZO;
        u32x4 c[3]; float ss = 0.f;
#pragma unroll
        for (int u = 0; u < 3; ++u) { c[u] = *(const u32x4*)(zr + OC_CQ + (u * 64 + lane) * 8);
#pragma unroll
            for (int e = 0; e < 4; ++e) { const float a = lo2f(c[u][e]), b = hi2f(c[u][e]); ss += a * a + b * b; } }
        ss = wave_sum(ss); float rstd = rsqrtf(ss * (1.0f / 1536) + 1e-6f);
#pragma unroll
        for (int u = 0; u < 3; ++u) { const float* wp = qn + (u * 64 + lane) * 8; u32x4 o;
#pragma unroll
            for (int e = 0; e < 4; ++e) o[e] = pk2(lo2f(c[u][e]) * rstd * wp[2 * e], hi2f(c[u][e]) * rstd * wp[2 * e + 1]);
            *(u32x4*)(zr + OC_CQ + (u * 64 + lane) * 8) = o; }
        u32x4 k = *(const u32x4*)(zr + OC_CKV + lane * 8); ss = 0.f;
#pragma unroll
        for (int e = 0; e < 4; ++e) { const float a = lo2f(k[e]), b = hi2f(k[e]); ss += a * a + b * b; }
        ss = wave_sum(ss); rstd = rsqrtf(ss * (1.0f / 512) + 1e-6f);
        { const float* wp = kvn + lane * 8; u32x4 o;
#pragma unroll
            for (int e = 0; e < 4; ++e) o[e] = pk2(lo2f(k[e]) * rstd * wp[2 * e], hi2f(k[e]) * rstd * wp[2 * e + 1]);
            *(u32x4*)(zr + OC_CKV + lane * 8) = o; }
        const int t = row & (SEQ - 1), i = lane & 31;
        const float x1 = bf2f(zr[OC_KPE + i]), x2 = bf2f(zr[OC_KPE + 32 + i]); const float cs = cosT[t * 32 + i], sn = sinT[t * 32 + i];
        const float r = (lane < 32) ? (x1 * cs - x2 * sn) : (x1 * sn + x2 * cs);
        zr[OC_KPE + lane] = (bf16_t)(pk2(r, r) & 0xffff);
    }
}

DEVI void phase_cmp2(const Params& P, int layer_i, LDSA char* lds, int tid) {
    unsigned char* ws = P.ws; const int G = vgrid(); LDSA float* S = (LDSA float*)lds;
    const float* part = (const float*)(ws + WS_CMPP); const float* posp = (const float*)(ws + WS_POSP);
    for (int it = vblock(); it < 128; it += G) {
        const int kv = it >> 6, r0 = (it & 63) * 16, lkv = layer_i * 2 + kv;
#pragma unroll
        for (int u = 0; u < 8; ++u) { const int e = tid + 256 * u, r = e >> 7, j = e & 127; float s = 0.f;
            for (int sp = 0; sp < 8; ++sp) s += part[((size_t)(kv * 8 + sp) * 1024 + r0 + r) * 128 + j] + posp[(lkv * 8 + sp) * 128 + j];
            S[e] = siluf_(s); }
        __syncthreads();
        const int j = tid & 127, rh = tid >> 7; const float* w2 = P.cmp_w2 + (size_t)lkv * 128 * 128; float acc[8];
#pragma unroll
        for (int r = 0; r < 8; ++r) acc[r] = 0.f;
        for (int k = 0; k < 128; ++k) { const float w = w2[k * 128 + j];
#pragma unroll
            for (int r = 0; r < 8; ++r) acc[r] += S[(rh * 8 + r) * 128 + k] * w; }
        bf16_t* dst = (bf16_t*)(ws + (kv ? WS_VCMP : WS_KCMP));
#pragma unroll
        for (int r = 0; r < 8; ++r) dst[(size_t)(r0 + rh * 8 + r) * 128 + j] = (bf16_t)(pk2(acc[r], acc[r]) & 0xffff);
        __syncthreads();
    }
}

DEVI void item_win(const Params& P, LDSA char* lds, int tid, int item) {
    const bf16_t* z = (const bf16_t*)(P.ws + WS_R1); bf16_t* owin = (bf16_t*)(P.ws + WS_H) + (size_t)MTOK * 1024;
    const int g = item & 1, ch = (item >> 1) & 127, b = item >> 8, t0 = ch * 32, lane = tid & 63, wave = __builtin_amdgcn_readfirstlane(tid >> 6), n = lane & 31, hg = g * 4 + wave;
    const int kfirst = (t0 - 511 > 0 ? t0 - 511 : 0) & ~63, klast = (t0 + 31) & ~63, ntiles = (klast - kfirst) / 64 + 1;
    const bf16_t* zb = z + (size_t)b * SEQ * LDZE;
    auto tilefn = [&](int it, TileDesc& td) { const int k0 = kfirst + it * 64; td.kp = zb + (size_t)k0 * LDZE + EC_KW + g * 128; td.vp = zb + (size_t)k0 * LDZE + EC_VW + g * 128;
        td.k2p = nullptr; td.kidx0 = k0; };
    const size_t row = (size_t)b * SEQ + t0 + n;
    auto epi = [&](f32x16 (&o)[4], float l, float) { const float inv = l > 0.f ? 1.0f / l : 0.f; const int h = lane >> 5;
#pragma unroll
        for (int c = 0; c < 4; ++c)
#pragma unroll
            for (int q = 0; q < 4; ++q) { u32x2 w; w.x = pk2(o[c][4 * q] * inv, o[c][4 * q + 1] * inv); w.y = pk2(o[c][4 * q + 2] * inv, o[c][4 * q + 3] * inv);
                *(u32x2*)(owin + row * 1024 + hg * 128 + 32 * c + 8 * q + 4 * h) = w; } };
    attn_core<1>(lds, tid, zb + (size_t)(t0 + n) * LDZE + EC_QA + hg * 128, t0 + n, t0, ntiles, ntiles, LDZE, LDZE, 0, tilefn, (const float*)(P.ws + WS_BIAST) + hg * 4096, 4095, 0ull, epi);
}

DEVI void item_dil(const Params& P, LDSA char* lds, int tid, int item) {
    const bf16_t* z = (const bf16_t*)(P.ws + WS_R1); bf16_t* dout = (bf16_t*)(P.ws + WS_DIL); float* lse = (float*)(P.ws + WS_LSE);
    const int sub = (item >> 1) & 31, gh = ((item >> 6) % 6) * 2 + (item & 1), b = item / (32 * 12), g = gh >> 2, hh = gh & 3, lane = tid & 63, wave = __builtin_amdgcn_readfirstlane(tid >> 6), n = lane & 31;
    const int dd = g == 0 ? 1 : (g == 1 ? 4 : 16), cpr = 32 / dd  , r = sub / cpr, i0 = (sub % cpr) * 128;
    const int kfirst = i0 >= 128 ? i0 - 128 : 0, ntiles = (i0 + 128 - kfirst) / 64;
    const bf16_t* zb = z + ((size_t)b * SEQ + r) * LDZE;
    const int st = dd * LDZE;
    auto tilefn = [&](int it, TileDesc& td) { const int k0 = kfirst + it * 64; td.kp = zb + (size_t)k0 * st + EC_KB + gh * 128; td.vp = zb + (size_t)k0 * st + EC_VB + gh * 128;
        td.k2p = nullptr; td.kidx0 = k0; };
    const int qi = i0 + 32 * wave + n; const size_t row = (size_t)b * SEQ + r + (size_t)dd * qi;
    auto epi = [&](f32x16 (&o)[4], float l, float m) { const float inv = l > 0.f ? 1.0f / l : 0.f; const int h = lane >> 5;
        bf16_t* op = dout + ((size_t)g * MTOK + row) * 512 + hh * 128;
#pragma unroll
        for (int c = 0; c < 4; ++c)
#pragma unroll
            for (int q = 0; q < 4; ++q) { u32x2 w; w.x = pk2(o[c][4 * q] * inv, o[c][4 * q + 1] * inv); w.y = pk2(o[c][4 * q + 2] * inv, o[c][4 * q + 3] * inv);
                *(u32x2*)(op + 32 * c + 8 * q + 4 * h) = w; }
        if (h == 0) lse[((size_t)g * MTOK + row) * 4 + hh] = m + __builtin_log2f(l); };
    attn_core<2>(lds, tid, zb + (size_t)qi * st + EC_QB + gh * 128, qi, i0 + 32 * wave, ntiles, ntiles, st, st, 0, tilefn, (const float*)(P.ws + WS_BIASD) + gh * 132, 128, 0ull, epi);
}

DEVI void item_cmp1(const Params& P, int layer_i, LDSA char* lds, int tid, int item) {
    const int sp = item & 7, pm = (item >> 3) & 3, kv = item >> 5;
    AFCmp af{(const bf16_t*)(P.ws + WS_R1), kv ? EC_VC : EC_KC};
    EpiF32 ef{(float*)(P.ws + WS_CMPP) + (size_t)(kv * 8 + sp) * 1024 * 128, 128};
    gemm_tile4(lds, tid, af, (const bf16_t*)(P.ws + WS_W1 + (layer_i * 2 + kv) * SZ_W1), 8192, sp * 16, 16, pm * 256, 0, ef);
}

DEVI void item_cmpatt(const Params& P, LDSA char* lds, int tid, int item) {
    const bf16_t* z = (const bf16_t*)(P.ws + WS_R1); bf16_t* ocmp = (bf16_t*)(P.ws + WS_H);
    const int g = item & 1, ch = (item >> 1) & 127, b = item >> 8, t0 = ch * 32, lane = tid & 63, wave = __builtin_amdgcn_readfirstlane(tid >> 6), n = lane & 31, hg = g * 4 + wave;
    const bf16_t* kc = (const bf16_t*)(P.ws + WS_KCMP) + (size_t)(b * 2 + g) * 64 * 128; const bf16_t* vc = (const bf16_t*)(P.ws + WS_VCMP) + (size_t)(b * 2 + g) * 64 * 128;
    auto tilefn = [&](int, TileDesc& td) { td.kp = kc; td.vp = vc; td.k2p = nullptr; td.kidx0 = 0; };
    const size_t row = (size_t)b * SEQ + t0 + n;
    auto epi = [&](f32x16 (&o)[4], float l, float) { const float inv = l > 0.f ? 1.0f / l : 0.f; const int h = lane >> 5;
#pragma unroll
        for (int c = 0; c < 4; ++c)
#pragma unroll
            for (int q = 0; q < 4; ++q) { u32x2 w; w.x = pk2(o[c][4 * q] * inv, o[c][4 * q + 1] * inv); w.y = pk2(o[c][4 * q + 2] * inv, o[c][4 * q + 3] * inv);
                *(u32x2*)(ocmp + row * 1024 + hg * 128 + 32 * c + 8 * q + 4 * h) = w; }
        if (h == 0) ((LDSA float*)(lds + CMP_LOFF))[wave * 32 + n] = inv; };
    attn_core<4>(lds, tid, z + ((size_t)b * SEQ + t0 + n) * LDZE + EC_QA + hg * 128, t0 + n, t0, 1, 1, 128, 128, 0, tilefn, (const float*)(P.ws + WS_BIAST) + hg * 4096, 4095, 0ull, epi);
    LDSA float* pb = (LDSA float*)(lds + CMP_POFF); LDSA float* linv = (LDSA float*)(lds + CMP_LOFF); LDSA float* imp = (LDSA float*)lds;
    const int qi = tid >> 3, part = tid & 7, t = t0 + qi, cur = t >> 6;
#pragma unroll
    for (int e = 0; e < 8; ++e) { const int j = part * 8 + e; float s = 0.f;
#pragma unroll
        for (int w = 0; w < 4; ++w) s += pb[(w * 32 + qi) * CMP_PSTR + j] * linv[w * 32 + qi];
        if (j == 0 || j == cur || j == cur - 1) s = INFINITY;
        imp[qi * 64 + j] = s; }
    __syncthreads();
    unsigned long long bits = 0ull;
#pragma unroll
    for (int e = 0; e < 8; ++e) { const int j = part * 8 + e; const float vj = imp[qi * 64 + j]; int cnt = 0;
        for (int i = 0; i <= cur; ++i) { const float vi = imp[qi * 64 + i]; cnt += (vi > vj || (vi == vj && i < j)) ? 1 : 0; }
        if (j <= cur && cnt < 16) bits |= 1ull << j; }
    bits |= __shfl_xor(bits, 1); bits |= __shfl_xor(bits, 2); bits |= __shfl_xor(bits, 4);
    if (part == 0) ((unsigned long long*)(P.ws + WS_SEL))[(size_t)(b * 2 + g) * SEQ + t] = bits;
    __syncthreads();
}

DEVI void item_slc(const Params& P, LDSA char* lds, int tid, int item) {
    bf16_t* z = (bf16_t*)(P.ws + WS_R1); const bf16_t* ocmp = (const bf16_t*)(P.ws + WS_H); const bf16_t* owin = ocmp + (size_t)MTOK * 1024;
    const int g = item & 1, ch = (item >> 1) & 127, b = item >> 8, t0 = ch * 32, lane = tid & 63, wave = __builtin_amdgcn_readfirstlane(tid >> 6), n = lane & 31, hg = g * 4 + wave;
    const unsigned long long selm = ((const unsigned long long*)(P.ws + WS_SEL))[(size_t)(b * 2 + g) * SEQ + t0 + n];
    unsigned long long U = selm;
#pragma unroll
    for (int o = 16; o >= 1; o >>= 1) U |= __shfl_xor(U, o);
    { const unsigned ulo = __builtin_amdgcn_readfirstlane((unsigned)U), uhi = __builtin_amdgcn_readfirstlane((unsigned)(U >> 32)); U = ((unsigned long long)uhi << 32) | ulo; }
    const int ntiles = __popcll(U); unsigned long long rem = U;
    LDSA int* xw = (LDSA int*)(lds - grp_() * GRP_LDS + LDS_BYTES - 64);
    if (tid == 0) xw[grp_()] = ntiles;
    __syncthreads();
    const int nsync = xw[0] > xw[1] ? xw[0] : xw[1];
    const bf16_t* zb = z + (size_t)b * SEQ * LDZE;
    auto tilefn = [&](int, TileDesc& td) { const int j = __ffsll((long long)rem) - 1; rem &= rem - 1; const int k0 = j * 64;
        td.kp = zb + (size_t)k0 * LDZE + EC_KS + g * 128; td.vp = zb + (size_t)k0 * LDZE + EC_VS + g * 128; td.k2p = nullptr; td.kidx0 = k0; };
    const size_t row = (size_t)b * SEQ + t0 + n;
    auto epi = [&](f32x16 (&o)[4], float l, float) { if (P.dry) return; const float inv = l > 0.f ? 1.0f / l : 0.f;
        const int tq = opq(tid), h = (tq >> 5) & 1, hg = g * 4 + (tq >> 6); const size_t row = (size_t)b * SEQ + t0 + (tq & 31);
        bf16_t* zr = z + row * LDZE;
        const float g0 = sigmoidf_(bf2f(zr[EC_G3 + hg * 3 + 0])), g1 = sigmoidf_(bf2f(zr[EC_G3 + hg * 3 + 1])) * inv, g2 = sigmoidf_(bf2f(zr[EC_G3 + hg * 3 + 2]));
#pragma unroll
        for (int c = 0; c < 4; ++c)
#pragma unroll
            for (int q = 0; q < 4; ++q) { const int dv = hg * 128 + 32 * c + 8 * q + 4 * h;
                const u32x2 oc = *(const u32x2*)(ocmp + row * 1024 + dv), ow = *(const u32x2*)(owin + row * 1024 + dv), gt = *(const u32x2*)(zr + EC_GATEA + dv);
                const float m0 = (g0 * lo2f(oc.x) + g1 * o[c][4 * q] + g2 * lo2f(ow.x)) * siluf_(lo2f(gt.x));
                const float m1 = (g0 * hi2f(oc.x) + g1 * o[c][4 * q + 1] + g2 * hi2f(ow.x)) * siluf_(hi2f(gt.x));
                const float m2 = (g0 * lo2f(oc.y) + g1 * o[c][4 * q + 2] + g2 * lo2f(ow.y)) * siluf_(lo2f(gt.y));
                const float m3 = (g0 * hi2f(oc.y) + g1 * o[c][4 * q + 3] + g2 * hi2f(ow.y)) * siluf_(hi2f(gt.y));
                u32x2 w; w.x = pk2(m0, m1); w.y = pk2(m2, m3); *(u32x2*)(zr + EC_GATEA + dv) = w;
                if (q & 1) { asm volatile("" ::: "memory"); __builtin_amdgcn_sched_barrier(0); } } };
    attn_core<3>(lds, tid, zb + (size_t)(t0 + n) * LDZE + EC_QA + hg * 128, t0 + n, t0, ntiles, nsync, LDZE, LDZE, 0, tilefn, (const float*)(P.ws + WS_BIAST) + hg * 4096, 4095, selm, epi);
}

DEVI void item_mixb(const Params& P, int tid, int item) {
    bf16_t* z = (bf16_t*)(P.ws + WS_R1); const bf16_t* dout = (const bf16_t*)(P.ws + WS_DIL); const float* lse = (const float*)(P.ws + WS_LSE);
    const int lane = tid & 63, wave = __builtin_amdgcn_readfirstlane(tid >> 6), hh = lane >> 4; const size_t row = (size_t)item * 4 + wave;
    const float l0 = lse[row * 4 + hh], l1 = lse[((size_t)MTOK + row) * 4 + hh], l2 = lse[((size_t)2 * MTOK + row) * 4 + hh];
    const float mx = fmaxf(l0, fmaxf(l1, l2)); float a0 = fexp2(l0 - mx), a1 = fexp2(l1 - mx), a2 = fexp2(l2 - mx); const float is = 1.0f / (a0 + a1 + a2); a0 *= is; a1 *= is; a2 *= is;
    const u32x4 o0 = *(const u32x4*)(dout + row * 512 + lane * 8), o1 = *(const u32x4*)(dout + ((size_t)MTOK + row) * 512 + lane * 8), o2 = *(const u32x4*)(dout + ((size_t)2 * MTOK + row) * 512 + lane * 8);
    const u32x4 gt = *(const u32x4*)(z + row * LDZE + EC_GATEB + lane * 8); bf16_t* gp = z + row * LDZE + EC_QB + lane * 8; u32x4 w;
#pragma unroll
    for (int e = 0; e < 4; ++e) { const float lo = (a0 * lo2f(o0[e]) + a1 * lo2f(o1[e]) + a2 * lo2f(o2[e])) * siluf_(lo2f(gt[e]));
        const float hi = (a0 * hi2f(o0[e]) + a1 * hi2f(o1[e]) + a2 * hi2f(o2[e])) * siluf_(hi2f(gt[e])); w[e] = pk2(lo, hi); }
    if (!P.dry) *(u32x4*)gp = w;
}

DEVI void item_mla(const Params& P, LDSA char* lds, int tid, int item) {
    bf16_t* z = (bf16_t*)(P.ws + WS_R1); const bf16_t* kvb = (const bf16_t*)(P.ws + WS_KV); const bf16_t* q = (const bf16_t*)(P.ws + WS_H);
    const int bh = 2 * ((item >> 3) & 63) + (item & 1), r_ = ((item >> 1) & 3) + 4 * (item >> 9), kk_ = r_ >> 2, j_ = r_ & 3;
    const int qb = 31 - ((kk_ & 1) ? 4 * kk_ + 3 - j_ : 4 * kk_ + j_), hd = bh & 15, b = bh >> 4, lane = tid & 63, wave = __builtin_amdgcn_readfirstlane(tid >> 6), n = lane & 31;
    const int q0 = qb * 128, ntiles = (q0 + 128) / 64;
    const bf16_t* kvr = kvb + (size_t)b * SEQ * 4096 + hd * 256; const bf16_t* zb = z + (size_t)b * SEQ * LDZO;
    auto tilefn = [&](int it, TileDesc& td) { const int k0 = it * 64; td.kp = kvr + (size_t)k0 * 4096; td.vp = kvr + (size_t)k0 * 4096 + 128;
        td.k2p = zb + (size_t)k0 * LDZO + OC_KPE; td.kidx0 = k0; };
    const int qi = q0 + 32 * wave + n; const size_t row = (size_t)b * SEQ + qi;
    auto epi = [&](f32x16 (&o)[4], float l, float) { if (P.dry) return; const float inv = l > 0.f ? 1.0f / l : 0.f; const int h = lane >> 5; bf16_t* gp = z + row * LDZO + OC_GATE + hd * 128;
#pragma unroll
        for (int c = 0; c < 4; ++c)
#pragma unroll
            for (int qq = 0; qq < 4; ++qq) { bf16_t* p = gp + 32 * c + 8 * qq + 4 * h; const u32x2 gt = *(const u32x2*)p; u32x2 w;
                w.x = pk2(o[c][4 * qq] * inv * siluf_(lo2f(gt.x)), o[c][4 * qq + 1] * inv * siluf_(hi2f(gt.x)));
                w.y = pk2(o[c][4 * qq + 2] * inv * siluf_(lo2f(gt.y)), o[c][4 * qq + 3] * inv * siluf_(hi2f(gt.y))); *(u32x2*)p = w; } };
    attn_core<0>(lds, tid, q + row * 3072 + hd * 192, qi, q0 + 32 * wave, ntiles, ntiles, 4096, 4096, LDZO, tilefn, (const float*)(P.ws + WS_COS), 0, 0ull, epi);
}


template <class EpiFn>
DEVI void mla_core8(LDSA char* lds, int tid, const bf16_t* qrow, int qidx, int qidx0w, int ntiles, const bf16_t* kvr  , const bf16_t* kpe  ,
                    const float* ctab, EpiFn epi) {
    constexpr int KSTR = 400, STG = 46080, NKS = 12;
    const int lane = tid & 63, n = lane & 31, h = lane >> 5;
    bf16x8 qf[NKS];
#pragma unroll
    for (int ks = 0; ks < NKS; ++ks) qf[ks] = *(const bf16x8*)(qrow + 16 * ks + 8 * h);
    {
        const float* ct = ctab + (size_t)qidx * 32 + 8 * h; const float* st = ct + 4096 * 32;
#pragma unroll
        for (int kk = 0; kk < 2; ++kk) { v4i a = __builtin_bit_cast(v4i, qf[8 + kk]), b2 = __builtin_bit_cast(v4i, qf[10 + kk]);
#pragma unroll
            for (int j = 0; j < 4; ++j) { const float c0 = ct[16 * kk + 2 * j], c1 = ct[16 * kk + 2 * j + 1], s0_ = st[16 * kk + 2 * j], s1_ = st[16 * kk + 2 * j + 1];
                const float x10 = lo2f((unsigned)a[j]), x11 = hi2f((unsigned)a[j]), x20 = lo2f((unsigned)b2[j]), x21 = hi2f((unsigned)b2[j]);
                a[j] = (int)pk2(x10 * c0 - x20 * s0_, x11 * c1 - x21 * s1_); b2[j] = (int)pk2(x10 * s0_ + x20 * c0, x11 * s1_ + x21 * c1); }
            qf[8 + kk] = __builtin_bit_cast(bf16x8, a); qf[10 + kk] = __builtin_bit_cast(bf16x8, b2); }
    }
    f32x16 o[4];
#pragma unroll
    for (int c = 0; c < 4; ++c) o[c] = zero16();
    float m = -INFINITY, l = 0.f;
    u32x4 kreg[2], k2reg, vreg[2];
    const unsigned koff = (unsigned)(tid >> 4) * 4096u + (tid & 15) * 8, k2off = (unsigned)(tid >> 3) * (unsigned)LDZO + (tid & 7) * 8;
    LDSA char* const vp0 = lds + 25600 + (4 * h + ((lane & 15) >> 2)) * ATT_VSTR + (16 * ((lane >> 4) & 1) + 4 * (lane & 3)) * 2;
#define MISSUE(it) do { const bf16_t* kp_ = kvr + (size_t)(it) * 64 * 4096; \
        _Pragma("unroll") for (int u = 0; u < 2; ++u) { kreg[u] = *(const u32x4*)(kp_ + (size_t)(32 * u) * 4096 + koff); vreg[u] = *(const u32x4*)(kp_ + 128 + (size_t)(32 * u) * 4096 + koff); } \
        k2reg = *(const u32x4*)(kpe + (size_t)(it) * 64 * LDZO + k2off); } while (0)
#define MSTORE(s) do { LDSA char* ks_ = lds + (s) * STG; \
        _Pragma("unroll") for (int u = 0; u < 2; ++u) { *(LDSA u32x4*)(ks_ + (tid >> 4) * KSTR + (tid & 15) * 16 + u * 32 * KSTR) = kreg[u]; \
            *(LDSA u32x4*)(ks_ + 25600 + (tid >> 4) * ATT_VSTR + (tid & 15) * 16 + u * 32 * ATT_VSTR) = vreg[u]; } \
        *(LDSA u32x4*)(ks_ + (tid >> 3) * KSTR + 256 + (tid & 7) * 16) = k2reg; } while (0)
    MISSUE(0); MSTORE(0);
    if (ntiles > 1) MISSUE(1);
    __syncthreads();
    for (int it = 0; it < ntiles; ++it) {
        const int kidx0 = it * 64, stg = (it & 1) * STG;
        const int dlo = qidx0w - (kidx0 + 63), dhi = qidx0w + 31 - kidx0;
        const bool skip = dhi < 0, full = dlo >= 0;
        if (!skip) {
            f32x16 s0 = zero16(), s1 = zero16();
            LDSA char* kb = lds + stg + n * KSTR + h * 16;
#pragma unroll
            for (int ks = 0; ks < NKS; ++ks) {
                const bf16x8 k0 = *(LDSA bf16x8*)(kb + ks * 32), k1 = *(LDSA bf16x8*)(kb + 32 * KSTR + ks * 32);
                s0 = mfma32(k0, qf[ks], s0); s1 = mfma32(k1, qf[ks], s1);
            }
            int dbase = qidx - kidx0 - 4 * h;
            asm volatile("" : "+v"(dbase));
            float tmax = -INFINITY;
            if (full) {
#pragma unroll
                for (int r = 0; r < 16; ++r) tmax = fmaxf(tmax, fmaxf(s0[r], s1[r]));
            } else {
#pragma unroll
                for (int mt = 0; mt < 2; ++mt)
#pragma unroll
                    for (int r = 0; r < 16; ++r) {
                        const int ko = 32 * mt + 8 * (r >> 2) + (r & 3);
                        float v = mt ? s1[r] : s0[r];
                        if (dbase - ko < 0) v = -INFINITY;
                        if (mt) s1[r] = v; else s0[r] = v;
                        tmax = fmaxf(tmax, v);
                    }
                asm volatile("" ::: "memory");
            }
            tmax = fmaxf(tmax, __shfl_xor(tmax, 32));
            const float mnew = fmaxf(m, tmax), msafe = (mnew == -INFINITY) ? 0.f : mnew;
            const float alpha = fexp2(m - msafe);
            float ps = 0.f;
#pragma unroll
            for (int r = 0; r < 16; ++r) { s0[r] = fexp2(s0[r] - msafe); ps += s0[r]; }
#pragma unroll
            for (int r = 0; r < 16; ++r) { s1[r] = fexp2(s1[r] - msafe); ps += s1[r]; }
            l = l * alpha + ps; m = mnew;
            if (__ballot(alpha != 1.0f) != 0ull) {
#pragma unroll
                for (int c = 0; c < 4; ++c)
#pragma unroll
                    for (int r = 0; r < 16; ++r) o[c][r] *= alpha;
            }
            bf16x8 pk[2][2];
#pragma unroll
            for (int j = 0; j < 2; ++j) {
                v4i a; a.x = (int)pk2(s0[8 * j], s0[8 * j + 1]); a.y = (int)pk2(s0[8 * j + 2], s0[8 * j + 3]); a.z = (int)pk2(s0[8 * j + 4], s0[8 * j + 5]); a.w = (int)pk2(s0[8 * j + 6], s0[8 * j + 7]);
                pk[0][j] = __builtin_bit_cast(bf16x8, a);
                v4i b; b.x = (int)pk2(s1[8 * j], s1[8 * j + 1]); b.y = (int)pk2(s1[8 * j + 2], s1[8 * j + 3]); b.z = (int)pk2(s1[8 * j + 4], s1[8 * j + 5]); b.w = (int)pk2(s1[8 * j + 6], s1[8 * j + 7]);
                pk[1][j] = __builtin_bit_cast(bf16x8, b);
            }
            LDSA char* const vp = vp0 + stg;
            pv_step<0>(vp, o[0], pk); pv_step<1>(vp, o[1], pk); pv_step<2>(vp, o[2], pk); pv_step<3>(vp, o[3], pk);
        }
        if (it + 1 < ntiles) MSTORE((it + 1) & 1);
        if (it + 2 < ntiles) MISSUE(it + 2);
        __syncthreads();
    }
#undef MISSUE
#undef MSTORE
    l += __shfl_xor(l, 32);
    epi(o, l, m);
}

DEVI void item_mla8(const Params& P, LDSA char* lds, int tid, int item) {
    bf16_t* z = (bf16_t*)(P.ws + WS_R1); const bf16_t* kvb = (const bf16_t*)(P.ws + WS_KV); const bf16_t* q = (const bf16_t*)(P.ws + WS_H);
    const int bh = (item >> 1) & 127, kk_ = item >> 8, j_ = item & 1, qb = 15 - ((kk_ & 1) ? 2 * kk_ + 1 - j_ : 2 * kk_ + j_), hd = bh & 15, b = bh >> 4;
    const int lane = tid & 63, wave = __builtin_amdgcn_readfirstlane(tid >> 6), n = lane & 31, q0 = qb * 256, ntiles = (q0 + 256) / 64;
    const bf16_t* kvr = kvb + (size_t)b * SEQ * 4096 + hd * 256; const bf16_t* kpe = z + (size_t)b * SEQ * LDZO + OC_KPE;
    const int qi = q0 + 32 * wave + n; const size_t row = (size_t)b * SEQ + qi;
    auto epi = [&](f32x16 (&o)[4], float l, float) { if (P.dry) return; const float inv = l > 0.f ? 1.0f / l : 0.f; const int h = lane >> 5; bf16_t* gp = z + row * LDZO + OC_GATE + hd * 128;
#pragma unroll
        for (int c = 0; c < 4; ++c)
#pragma unroll
            for (int qq = 0; qq < 4; ++qq) { bf16_t* p = gp + 32 * c + 8 * qq + 4 * h; const u32x2 gt = *(const u32x2*)p; u32x2 w;
                w.x = pk2(o[c][4 * qq] * inv * siluf_(lo2f(gt.x)), o[c][4 * qq + 1] * inv * siluf_(hi2f(gt.x)));
                w.y = pk2(o[c][4 * qq + 2] * inv * siluf_(lo2f(gt.y)), o[c][4 * qq + 3] * inv * siluf_(hi2f(gt.y))); *(u32x2*)p = w; } };
    mla_core8(lds, tid, q + row * 3072 + hd * 192, qi, q0 + 32 * wave, ntiles, kvr, kpe, (const float*)(P.ws + WS_COS), epi);
}

constexpr int N_PHASES = 28;
DEVI void run_phase(const Params& P, int ph, LDSA char* lds, int tid) {
    unsigned char* ws = P.ws; const int G = vgrid(), v = vblock();
    bf16_t* hbuf = (bf16_t*)(ws + WS_H); bf16_t* zbuf = (bf16_t*)(ws + WS_R1);
    if (ph == 0) { phase_prep(P, lds, opq(tid)); phase_xb(P.x, hbuf, (float*)(ws + WS_RSTD), opq(tid)); return; }
    if (ph == 27) { phase_rms<true>(P.out, P.final_norm_w, P.out, opq(tid)); return; }
    int layer, sub; { const int q = ph - 1; if (q < 7) { layer = 0; sub = q; } else if (q < 13) { layer = 1; sub = q - 7; } else if (q < 20) { layer = 2; sub = q - 13; } else { layer = 3; sub = q - 20; } }
    const int li = layer >> 1; const float* xin = (layer == 0) ? P.x : P.out;
#ifdef DBG_LAYERS
    if (!((DBG_LAYERS >> layer) & 1)) {
        if (layer == 0 && sub == 6) { for (size_t i = (size_t)blockIdx.x * NTHREADS + tid; i < (size_t)MTOK * D_MODEL / 4; i += (size_t)G * NTHREADS) ((f32x4*)P.out)[i] = ((const f32x4*)P.x)[i]; }
        return;
    }
#endif
#ifdef DBG_SKIP_SUB
    if ((DBG_SKIP_SUB >> sub) & 1) return;
#endif
    if (sub == 0) { if (layer != 0) phase_rstd((const float*)(ws + WS_SSP), (float*)(ws + WS_RSTD), opq(tid)); return; }
    if ((layer & 1) == 0) {
        if (sub == 1) {
            pg8::run(lds - grp_() * GRP_LDS, hbuf, 2048, (const bf16_t*)(ws + WS_WEVIN + li * SZ_WEVIN), MTOK, LDZE, 2048, pg8::PEpiBf16S{zbuf, LDZE, (const float*)(ws + WS_RSTD)}); return; }
        if (sub == 2) { const int nwin = 2048, ndil = 3072, ncmp = 64, nt = nwin + ndil + ncmp;
            (void)nt;
            for (int it = v; it < ndil; it += G) item_dil(P, lds, opq(tid), it);
            (void)nwin;
            { int t_ = tid; asm volatile("" : "+v"(t_)); for (int it = v; it < ncmp; it += G) item_cmp1(P, li, lds, t_, it); }
            return; }
        if (sub == 3) { phase_cmp2(P, li, lds, opq(tid)); return; }
        if (sub == 4) return;
        if (sub == 5) {
            for (int it = v; it < 2048; it += G) { const int item = it ^ (((it >> 9) & 1) ? 0 : 254);
                item_cmpatt(P, lds, opq(tid), item); item_win(P, lds, opq(tid), item); item_slc(P, lds, opq(tid), item); }
            { int t_ = tid; asm volatile("" : "+v"(t_)); for (int it = v; it < MTOK / 4; it += G) item_mixb(P, t_, it); }
            return; }
        if (sub == 6) { pg8::run(lds - grp_() * GRP_LDS, zbuf + EC_GATEA, LDZE, (const bf16_t*)(ws + WS_WEVOUT + li * SZ_WEVOUT), MTOK, 2048, 1536, pg8::PEpiResidX{xin, P.out, hbuf, (float*)(ws + WS_SSP)}); return; }
    } else {
        if (sub == 1) { pg8::run(lds - grp_() * GRP_LDS, hbuf, 2048, (const bf16_t*)(ws + WS_WODIN + li * SZ_WODIN), MTOK, LDZO, 2048, pg8::PEpiBf16S{zbuf, LDZO, (const float*)(ws + WS_RSTD)}); return; }
        if (sub == 2) { phase_norms(zbuf, P.q_norm + li * 1536, P.kv_norm + li * 512, (const float*)(ws + WS_COS), (const float*)(ws + WS_SIN), opq(tid)); return; }
        if (sub == 3) {
            pg8::run(lds - grp_() * GRP_LDS, zbuf + OC_CQ, LDZO, (const bf16_t*)(ws + WS_WQB + li * SZ_WQB), MTOK, 3072, 1536, pg8::PEpiBf16{hbuf, 3072});
            pg8::run(lds - grp_() * GRP_LDS, zbuf + OC_CKV, LDZO, (const bf16_t*)(ws + WS_WKVB + li * SZ_WKVB), MTOK, 4096, 512, pg8::PEpiBf16{(bf16_t*)(ws + WS_KV), 4096}); return; }
        if (sub == 4) { for (int it = pblock(); it < 2048; it += (int)gridDim.x) item_mla8(P, lds - grp_() * GRP_LDS, opq((int)threadIdx.x), it); return; }
        if (sub == 5) { pg8::run(lds - grp_() * GRP_LDS, zbuf + OC_GATE, LDZO, (const bf16_t*)(ws + WS_WODOUT + li * SZ_WODOUT), MTOK, 2048, 2048, pg8::PEpiResidX{xin, P.out, hbuf, (float*)(ws + WS_SSP)}); return; }
    }
}

DEVI void grid_barrier(unsigned* bar, unsigned gen) {
    __syncthreads();
    if (threadIdx.x == 0) {
        const unsigned G = gridDim.x, x = blockIdx.x & 7u;
        unsigned* gcnt = bar + 32 * 8;
        __builtin_amdgcn_fence(__ATOMIC_RELEASE, "agent");
        if ((G & 7u) == 0u) {
            if (__hip_atomic_fetch_add(bar + 32 * x, 1u, __ATOMIC_ACQ_REL, __HIP_MEMORY_SCOPE_AGENT) + 1u == gen * (G >> 3)) {
                if (__hip_atomic_fetch_add(gcnt, 1u, __ATOMIC_ACQ_REL, __HIP_MEMORY_SCOPE_AGENT) + 1u == gen * 8u) {
#pragma unroll
                    for (int i = 0; i < 8; ++i) __hip_atomic_store(bar + 32 * (9 + i), gen, __ATOMIC_RELEASE, __HIP_MEMORY_SCOPE_AGENT);
                }
            }
            while (__hip_atomic_load(bar + 32 * (9 + x), __ATOMIC_RELAXED, __HIP_MEMORY_SCOPE_AGENT) < gen) __builtin_amdgcn_s_sleep(1);
        } else {
            __hip_atomic_fetch_add(gcnt, 1u, __ATOMIC_RELAXED, __HIP_MEMORY_SCOPE_AGENT);
            while (__hip_atomic_load(gcnt, __ATOMIC_RELAXED, __HIP_MEMORY_SCOPE_AGENT) < gen * G) __builtin_amdgcn_s_sleep(2);
        }
        __builtin_amdgcn_fence(__ATOMIC_ACQUIRE, "agent");
    }
    __syncthreads();
}

__global__ void __launch_bounds__(NTHREADS, 2) fwd_kernel(Params P) {
    extern __shared__ __attribute__((aligned(16))) unsigned char smem[];
    LDSA char* lds = (LDSA char*)smem;
    const int tid = threadIdx.x & (GTHREADS - 1);
    lds += grp_() * GRP_LDS;
    unsigned bar_gen = 0;
    for (int ph = P.ph_lo; ph < P.ph_hi; ++ph) {
        if (ph == 1 || ph == 5 || ph == 18) continue;
        if (ph > P.ph_lo) {
            if (P.ph_lo < 0) cg::this_grid().sync();
            grid_barrier((unsigned*)(P.ws + WS_BAR), ++bar_gen);
        }
        int tid_ = tid; asm volatile("" : "+v"(tid_));
        Params Q = P; { size_t z0 = 0, z1 = 0; asm volatile("" : "+s"(z0), "+s"(z1)); Q.ws = P.ws + z0; Q.out = P.out + z1; }
#ifdef DBG_DRY_PH
        if (ph == DBG_DRY_PH) { Params Q2 = Q; Q2.dry = 1; int t3_ = tid; asm volatile("" : "+v"(t3_)); run_phase(Q2, ph, lds, t3_); __syncthreads(); }
#endif
        run_phase(Q, ph, lds, tid_);
#ifdef DBG_REPEAT_PH
        if (ph == DBG_REPEAT_PH) { __syncthreads(); int t2_ = tid; asm volatile("" : "+v"(t2_)); run_phase(Q, ph, lds, t2_); }
#endif
    }
}

extern "C" void kernel_launch(void* const* d_in, const int* in_sizes, int n_in, void* d_out, int out_size, void* d_ws, size_t ws_size, hipStream_t stream) {
    static int grid = 0;
    if (grid == 0) {
        if (n_in != 15 || ws_size < WS_END) { fprintf(stderr, "kernel_launch: need 15 inputs and %zu bytes of workspace (got %d, %zu)\n", (size_t)WS_END, n_in, ws_size); grid = -1; return; }
        int dev = 0, cus = 0, per_cu = 0;
        hipGetDevice(&dev); hipDeviceGetAttribute(&cus, hipDeviceAttributeMultiprocessorCount, dev);
        if (hipFuncSetAttribute((const void*)fwd_kernel, hipFuncAttributeMaxDynamicSharedMemorySize, LDS_BYTES) != hipSuccess) { fprintf(stderr, "hipFuncSetAttribute failed\n"); grid = -1; return; }
        if (hipOccupancyMaxActiveBlocksPerMultiprocessor(&per_cu, (const void*)fwd_kernel, NTHREADS, LDS_BYTES) != hipSuccess || per_cu < 1) { fprintf(stderr, "occupancy query failed (%d)\n", per_cu); per_cu = 1; }
        if (per_cu > 1) per_cu = 1;
        grid = cus * per_cu;
        fprintf(stderr, "kernel_launch: grid %d (%d CUs x %d)\n", grid, cus, per_cu);
    }
    if (grid < 0) return;
    Params p{};
    p.x = (const float*)d_in[0]; p.rel_bias = (const float*)d_in[1]; p.norm_w = (const float*)d_in[2]; p.final_norm_w = (const float*)d_in[3]; p.ev_w_in = (const float*)d_in[4];
    p.cmp_pos = (const float*)d_in[5]; p.cmp_w1 = (const float*)d_in[6]; p.cmp_w2 = (const float*)d_in[7]; p.ev_w_out = (const float*)d_in[8]; p.od_w_in = (const float*)d_in[9];
    p.q_norm = (const float*)d_in[10]; p.w_qb = (const float*)d_in[11]; p.kv_norm = (const float*)d_in[12]; p.w_kvb = (const float*)d_in[13]; p.od_w_out = (const float*)d_in[14];
    p.out = (float*)d_out; p.ws = (unsigned char*)d_ws;
#if ONE_LAUNCH
    p.ph_lo = 0; p.ph_hi = N_PHASES;
    if (hipMemsetAsync((char*)d_ws + WS_BAR, 0, 4096, stream) != hipSuccess) { fprintf(stderr, "memset failed\n"); return; }
    void* args[] = {&p};
    hipError_t e = hipLaunchCooperativeKernel((const void*)fwd_kernel, dim3(grid), dim3(NTHREADS), args, LDS_BYTES, stream);
    if (e != hipSuccess) fprintf(stderr, "cooperative launch failed: %s (grid %d)\n", hipGetErrorString(e), grid);
#else
    for (int ph = 0; ph < N_PHASES; ++ph) { p.ph_lo = ph; p.ph_hi = ph + 1; hipLaunchKernelGGL(fwd_kernel, dim3(grid), dim3(NTHREADS), LDS_BYTES, stream, p); }
#endif
}
```

```cpp
#include <hip/hip_runtime.h>
#include <hip/hip_cooperative_groups.h>
#include <cstdio>
#include <cstdint>
namespace cg = cooperative_groups;


#ifndef ONE_LAUNCH
#define ONE_LAUNCH 1
#endif

typedef unsigned short bf16_t;
typedef short bf16x8 __attribute__((ext_vector_type(8)));
typedef float f32x16 __attribute__((ext_vector_type(16)));
typedef float f32x4 __attribute__((ext_vector_type(4)));
typedef unsigned u32x4 __attribute__((ext_vector_type(4)));
typedef unsigned u32x2 __attribute__((ext_vector_type(2)));
typedef int v2i __attribute__((ext_vector_type(2)));
typedef int v4i __attribute__((ext_vector_type(4)));
#define LDSA __attribute__((address_space(3)))
#define DEVI __device__ __forceinline__

constexpr int D_MODEL = 2048, BATCH = 8, SEQ = 4096, MTOK = BATCH * SEQ;
constexpr int LDZE = 8960;
constexpr int LDZO = 4352;
constexpr int EC_QA = 0, EC_KC = 1024, EC_VC = 1280, EC_KS = 1536, EC_VS = 1792, EC_KW = 2048, EC_VW = 2304, EC_GATEA = 2560,
              EC_QB = 3584, EC_KB = 5120, EC_VB = 6656, EC_GATEB = 8192, EC_G3 = 8704;
constexpr int OC_CQ = 0, OC_CKV = 1536, OC_GATE = 2048, OC_KPE = 4096;
constexpr float LOG2E = 1.4426950408889634f;
constexpr float NSA_SCALE2 = 0.08838834764831845f * LOG2E;
constexpr float MLA_SCALE2 = 0.07216878364870323f * LOG2E;
constexpr int GRP_LDS = 73728, LDS_BYTES = 2 * GRP_LDS;
constexpr int NTHREADS = 512, GTHREADS = 256;

constexpr size_t MB = 1024 * 1024;
constexpr size_t WS_BIAST = 0;
constexpr size_t WS_BIASD = WS_BIAST + 20 * 4096 * 4;
constexpr size_t WS_COS = 512 * 1024;
constexpr size_t WS_SIN = WS_COS + 512 * 1024;
constexpr size_t WS_POSP = WS_SIN + 512 * 1024;
constexpr size_t WS_BAR = 1920 * 1024;
constexpr size_t WS_KCMP = 2 * MB;
constexpr size_t WS_VCMP = WS_KCMP + 256 * 1024;
constexpr size_t WS_SEL = 3 * MB;
constexpr size_t WS_LSE = 4 * MB;
constexpr size_t WS_CMPP = 6 * MB;
constexpr size_t WS_RSTD = 14 * MB;
constexpr size_t WS_W = 16 * MB;
constexpr size_t SZ_WEVIN = (size_t)LDZE * 2048 * 2, SZ_WEVOUT = (size_t)2048 * 1536 * 2, SZ_WODIN = (size_t)LDZO * 2048 * 2,
                 SZ_WQB = (size_t)3072 * 1536 * 2, SZ_WKVB = (size_t)4096 * 512 * 2, SZ_WODOUT = (size_t)2048 * 2048 * 2, SZ_W1 = (size_t)128 * 8192 * 2;
constexpr size_t WS_WEVIN = WS_W, WS_WEVOUT = WS_WEVIN + 2 * SZ_WEVIN, WS_WODIN = WS_WEVOUT + 2 * SZ_WEVOUT, WS_WQB = WS_WODIN + 2 * SZ_WODIN,
                 WS_WKVB = WS_WQB + 2 * SZ_WQB, WS_WODOUT = WS_WKVB + 2 * SZ_WKVB, WS_W1 = WS_WODOUT + 2 * SZ_WODOUT, WS_WEND = WS_W1 + 4 * SZ_W1;
constexpr size_t WS_R1 = (WS_WEND + 4095) & ~(size_t)4095;
constexpr size_t SZ_R1 = (size_t)MTOK * LDZE * 2;
constexpr size_t WS_KV = WS_R1 + (size_t)MTOK * LDZO * 2;
constexpr size_t WS_H = WS_R1 + SZ_R1;
constexpr size_t WS_DIL = WS_H + (size_t)MTOK * 2048 * 2;
constexpr size_t WS_SSP = WS_DIL + (size_t)3 * MTOK * 512 * 2;
constexpr size_t WS_END = WS_SSP + (size_t)MTOK * 32 * 4;

struct Params {
    const float* x; const float* rel_bias; const float* norm_w; const float* final_norm_w; const float* ev_w_in; const float* cmp_pos;
    const float* cmp_w1; const float* cmp_w2; const float* ev_w_out; const float* od_w_in; const float* q_norm; const float* w_qb;
    const float* kv_norm; const float* w_kvb; const float* od_w_out;
    float* out; unsigned char* ws; int ph_lo, ph_hi; int dry, pad_;
};

DEVI float bf2f(bf16_t h) { return __uint_as_float((unsigned)h << 16); }
typedef __bf16 bf16v2_ __attribute__((ext_vector_type(2)));
typedef float f32v2_ __attribute__((ext_vector_type(2)));
DEVI unsigned pk2(float lo, float hi) { const f32v2_ v = {lo, hi}; return __builtin_bit_cast(unsigned, __builtin_convertvector(v, bf16v2_)); }
DEVI unsigned bfr_(float f) { const unsigned u = __float_as_uint(f); return (u + 0x7fffu + ((u >> 16) & 1u)) >> 16; }
DEVI unsigned pk2s(float lo, float hi) { return pk2(lo, hi); }
DEVI float lo2f(unsigned u) { return __uint_as_float(u << 16); }
DEVI float hi2f(unsigned u) { return __uint_as_float(u & 0xffff0000u); }
DEVI float fexp2(float x) { return __builtin_amdgcn_exp2f(x); }
DEVI float sigmoidf_(float x) { return 1.0f / (1.0f + __expf(-x)); }
DEVI float siluf_(float x) { return x / (1.0f + __expf(-x)); }
DEVI float wave_sum(float v) {
#pragma unroll
    for (int o = 32; o >= 1; o >>= 1) v += __shfl_xor(v, o);
    return v;
}
DEVI int pblock() { const int G = gridDim.x, b = blockIdx.x; return (G % 8 == 0) ? (b % 8) * (G / 8) + b / 8 : b; }
DEVI int grp_() { return __builtin_amdgcn_readfirstlane((int)(threadIdx.x >> 8)); }
DEVI int vgrid() { return (int)gridDim.x * 2; }
DEVI int vblock() { return pblock() * 2 + grp_(); }
template <int OFF> DEVI v2i trr(unsigned a) { v2i r; asm volatile("ds_read_b64_tr_b16 %0, %1 offset:%2" : "=v"(r) : "v"(a), "n"(OFF)); return r; }
DEVI f32x16 mfma32(bf16x8 a, bf16x8 b, f32x16 c) { return __builtin_amdgcn_mfma_f32_32x32x16_bf16(a, b, c, 0, 0, 0); }
DEVI int opq(int t) { asm volatile("" : "+v"(t)); return t; }
DEVI int opqs(int t) { asm volatile("" : "+s"(t)); return t; }
DEVI f32x16 zero16() { f32x16 z; for (int i = 0; i < 16; ++i) z[i] = 0.f; return z; }

template <int DM = 0, class AF, class EF>
DEVI void gemm_tile4(LDSA char* lds, int tid, AF af, const bf16_t* __restrict__ Bt, int ldb, int kt0, int nk, int row0, int col0, EF ef) {
    const int lane = tid & 63, wave = __builtin_amdgcn_readfirstlane(tid >> 6), wm = wave >> 1, wn = wave & 1, n32 = lane & 31, h = lane >> 5;
    f32x16 acc[4][2];
#pragma unroll
    for (int i = 0; i < 4; ++i)
#pragma unroll
        for (int j = 0; j < 2; ++j) acc[i][j] = zero16();
    u32x4 ra[8], rb[4];
    const int cr = tid >> 3, ckc = tid & 7;
#define GLOAD(kt) do { int cr_ = cr; asm volatile("" : "+v"(cr_));   \
        _Pragma("unroll") for (int u = 0; u < 8; ++u) ra[u] = *(const u32x4*)af(row0 + cr_ + 32 * u, (kt) * 64, ckc * 8); \
        _Pragma("unroll") for (int u = 0; u < 4; ++u) rb[u] = *(const u32x4*)(Bt + (size_t)(col0 + cr_ + 32 * u) * ldb + (kt) * 64 + ckc * 8); } while (0)
#define SSTORE() do { LDSA char* sb_ = lds + cr * 144 + ckc * 16; _Pragma("unroll") for (int u = 0; u < 8; ++u) *(LDSA u32x4*)(sb_ + u * 32 * 144) = ra[u]; \
        _Pragma("unroll") for (int u = 0; u < 4; ++u) *(LDSA u32x4*)(sb_ + 36864 + u * 32 * 144) = rb[u]; } while (0)
    GLOAD(kt0);
    LDSA char* As = lds + (wm * 128 + n32) * 144 + h * 16;
    LDSA char* Bs = lds + 36864 + (wn * 64 + n32) * 144 + h * 16;
    for (int i = 0; i < nk; ++i) {
        if (DM != 2 || i == 0) SSTORE();
        __syncthreads();
        if (DM != 2 && i + 1 < nk) GLOAD(kt0 + i + 1);
        if (DM != 1) {
#pragma unroll
            for (int ks = 0; ks < 4; ++ks) {
                const bf16x8 b0 = *(LDSA bf16x8*)(Bs + ks * 32), b1 = *(LDSA bf16x8*)(Bs + 32 * 144 + ks * 32);
#pragma unroll
                for (int ii = 0; ii < 4; ++ii) { const bf16x8 a = *(LDSA bf16x8*)(As + ii * 32 * 144 + ks * 32);
                    acc[ii][0] = mfma32(b0, a, acc[ii][0]); acc[ii][1] = mfma32(b1, a, acc[ii][1]); }
            }
        }
        __syncthreads();
    }
#undef GLOAD
#undef SSTORE
    ef(row0 + wm * 128 + n32, col0 + wn * 64 + 4 * h, acc);
}

struct AFPlain { const bf16_t* A; int lda; DEVI const bf16_t* operator()(int row, int kb, int kin) const { return A + (size_t)row * lda + kb + kin; } };
struct AFEvOut { const bf16_t* z; DEVI const bf16_t* operator()(int row, int kb, int kin) const { const int cb = kb < 1024 ? EC_GATEA + kb : EC_GATEB + (kb - 1024); return z + (size_t)row * LDZE + cb + kin; } };
struct AFCmp { const bf16_t* z; int colbase;
    DEVI const bf16_t* operator()(int R, int kb, int kin) const { const int k = kb + kin; const int b = R >> 7, g = (R >> 6) & 1, n = R & 63, l = k >> 7, d = k & 127;
        return z + (size_t)(b * SEQ + n * 64 + l) * LDZE + colbase + g * 128 + d; } };

struct EpiBf16 { bf16_t* C; int ldc;
    template <int NI> DEVI void operator()(int rbase, int cbase, f32x16 (&acc)[NI][2]) const {
#pragma unroll
        for (int i = 0; i < NI; ++i)
#pragma unroll
            for (int j = 0; j < 2; ++j)
#pragma unroll
                for (int g = 0; g < 4; ++g) { u32x2 w; w.x = pk2s(acc[i][j][4 * g], acc[i][j][4 * g + 1]); w.y = pk2s(acc[i][j][4 * g + 2], acc[i][j][4 * g + 3]);
                    *(u32x2*)(C + (size_t)(rbase + 32 * i) * ldc + cbase + 32 * j + 8 * g) = w; }
    } };
struct EpiResid { const float* xin; float* xout;
    template <int NI> DEVI void operator()(int rbase, int cbase, f32x16 (&acc)[NI][2]) const {
#pragma unroll
        for (int i = 0; i < NI; ++i)
#pragma unroll
            for (int j = 0; j < 2; ++j)
#pragma unroll
                for (int g = 0; g < 4; ++g) { const size_t off = (size_t)(rbase + 32 * i) * D_MODEL + cbase + 32 * j + 8 * g;
                    f32x4 v = *(const f32x4*)(xin + off); v[0] += acc[i][j][4 * g]; v[1] += acc[i][j][4 * g + 1]; v[2] += acc[i][j][4 * g + 2]; v[3] += acc[i][j][4 * g + 3];
                    *(f32x4*)(xout + off) = v; if (g == 3) asm volatile("" ::: "memory"); }
    } };
struct EpiProbe { float* C;
    template <int NI> DEVI void operator()(int rbase, int cbase, f32x16 (&acc)[NI][2]) const { float t = 0.f; for (int i = 0; i < NI; ++i) for (int j = 0; j < 2; ++j) for (int r = 0; r < 16; ++r) t += acc[i][j][r]; if (t == 123456.789f) C[rbase + cbase] = t; } };
struct EpiF32 { float* C; int ldc;
    template <int NI> DEVI void operator()(int rbase, int cbase, f32x16 (&acc)[NI][2]) const {
#pragma unroll
        for (int i = 0; i < NI; ++i)
#pragma unroll
            for (int j = 0; j < 2; ++j)
#pragma unroll
                for (int g = 0; g < 4; ++g) { f32x4 v; v[0] = acc[i][j][4 * g]; v[1] = acc[i][j][4 * g + 1]; v[2] = acc[i][j][4 * g + 2]; v[3] = acc[i][j][4 * g + 3];
                    *(f32x4*)(C + (size_t)(rbase + 32 * i) * ldc + cbase + 32 * j + 8 * g) = v; }
    } };
struct EpiQ { bf16_t* C; const float* cosT; const float* sinT;
    template <int NI> DEVI void operator()(int rbase, int cbase, f32x16 (&acc)[NI][2]) const {
        const int sub = (cbase & ~63) % 192;
        if (sub == 128) {
            const int hoff = cbase & 63;
#pragma unroll
            for (int i = 0; i < NI; ++i) { const int t = (rbase + 32 * i) & (SEQ - 1);
#pragma unroll
                for (int g = 0; g < 4; ++g) { const f32x4 c = *(const f32x4*)(cosT + t * 32 + hoff + 8 * g), s = *(const f32x4*)(sinT + t * 32 + hoff + 8 * g);
#pragma unroll
                    for (int e = 0; e < 4; ++e) { const float x1 = acc[i][0][4 * g + e], x2 = acc[i][1][4 * g + e];
                        acc[i][0][4 * g + e] = x1 * c[e] - x2 * s[e]; acc[i][1][4 * g + e] = x1 * s[e] + x2 * c[e]; }
                    asm volatile("" ::: "memory"); } }
        }
#pragma unroll
        for (int i = 0; i < NI; ++i)
#pragma unroll
            for (int j = 0; j < 2; ++j)
#pragma unroll
                for (int g = 0; g < 4; ++g) { u32x2 w; w.x = pk2(acc[i][j][4 * g] * MLA_SCALE2, acc[i][j][4 * g + 1] * MLA_SCALE2); w.y = pk2(acc[i][j][4 * g + 2] * MLA_SCALE2, acc[i][j][4 * g + 3] * MLA_SCALE2);
                    *(u32x2*)(C + (size_t)(rbase + 32 * i) * 3072 + cbase + 32 * j + 8 * g) = w; }
    } };

DEVI void tile_of(int L, int nM, int nN, int& pm, int& pn) { const int GM = 8, nig = GM * nN, gid = L / nig, fm = gid * GM; const int gsz = (nM - fm) < GM ? (nM - fm) : GM; pm = fm + (L % nig) % gsz; pn = (L % nig) / gsz; }

template <class AF, class EF>
DEVI void gemm_tile8(LDSA char* lds, int tid, AF af, const bf16_t* __restrict__ Bt, int ldb, int nk, int row0, int col0, EF ef) {
    const int lane = tid & 63, wave = __builtin_amdgcn_readfirstlane(tid >> 6), wm = wave >> 2, wn = wave & 3, n32 = lane & 31, h = lane >> 5;
    f32x16 acc[4][2];
#pragma unroll
    for (int i = 0; i < 4; ++i)
#pragma unroll
        for (int j = 0; j < 2; ++j) acc[i][j] = zero16();
    u32x4 ra[4], rb[4];
    const int cr = tid >> 3, ckc = tid & 7;
#define GLOAD(kt) do { int cr_ = cr; asm volatile("" : "+v"(cr_)); \
        _Pragma("unroll") for (int u = 0; u < 4; ++u) { ra[u] = *(const u32x4*)af(row0 + cr_ + 64 * u, (kt) * 64, ckc * 8); \
            rb[u] = *(const u32x4*)(Bt + (size_t)(col0 + cr_ + 64 * u) * ldb + (kt) * 64 + ckc * 8); } } while (0)
#define SSTORE(s) do { LDSA char* sb_ = lds + (s) * GRP_LDS + cr * 144 + ckc * 16; _Pragma("unroll") for (int u = 0; u < 4; ++u) { \
        *(LDSA u32x4*)(sb_ + u * 64 * 144) = ra[u]; *(LDSA u32x4*)(sb_ + 36864 + u * 64 * 144) = rb[u]; } } while (0)
    GLOAD(0); SSTORE(0);
    if (nk > 1) GLOAD(1);
    __syncthreads();
    for (int i = 0; i < nk; ++i) {
        LDSA char* As = lds + (i & 1) * GRP_LDS + (wm * 128 + n32) * 144 + h * 16;
        LDSA char* Bs = lds + (i & 1) * GRP_LDS + 36864 + (wn * 64 + n32) * 144 + h * 16;
#pragma unroll
        for (int ks = 0; ks < 4; ++ks) {
            const bf16x8 b0 = *(LDSA bf16x8*)(Bs + ks * 32), b1 = *(LDSA bf16x8*)(Bs + 32 * 144 + ks * 32);
#pragma unroll
            for (int ii = 0; ii < 4; ++ii) { const bf16x8 a = *(LDSA bf16x8*)(As + ii * 32 * 144 + ks * 32);
                acc[ii][0] = mfma32(b0, a, acc[ii][0]); acc[ii][1] = mfma32(b1, a, acc[ii][1]); }
        }
        if (i + 1 < nk) SSTORE((i + 1) & 1);
        if (i + 2 < nk) GLOAD(i + 2);
        __syncthreads();
    }
#undef GLOAD
#undef SSTORE
    ef(row0 + wm * 128 + n32, col0 + wn * 64 + 4 * h, acc);
}

template <class AF, class EF>
DEVI void gemm_phase(LDSA char* lds_phys, int tid_phys, AF af, const bf16_t* Bt, int ldb, int K, int M, int N, EF ef) {
    const int nM = M / 256, nN = N / 256, nt = nM * nN, G = gridDim.x, v = pblock();
    for (int L = v; L < nt; L += G) { int pm, pn; tile_of(L, nM, nN, pm, pn); gemm_tile8(lds_phys, tid_phys, af, Bt, ldb, K / 64, pm * 256, pn * 256, ef); }
}

namespace pg8 {
#define PG8_LAS __attribute__((address_space(3)))
typedef unsigned short bf16_t;
typedef short bf16x8 __attribute__((ext_vector_type(8)));
typedef float f32x4 __attribute__((ext_vector_type(4)));
typedef unsigned u32x4 __attribute__((ext_vector_type(4)));
constexpr int BM = 256, BK = 64, HALF = 128, HTB = HALF * BK * 2  , STAGE_BYTES = 8 * HTB, NXCD = 8, WGM = 4;

__host__ __device__ __forceinline__ int lds_byte(int r, int c) { const int st = (r >> 4) * 2 + (c >> 5), rr = r & 15, cc = c & 31, ob = rr * 64 + cc * 2; return st * 1024 + (ob ^ (((ob >> 9) & 1) << 5)); }
__host__ __device__ __forceinline__ void stage_rc(int b, int& R, int& C) { const int st = b / 1024, sb = b % 1024, swz = sb ^ (((sb >> 9) & 1) << 5); R = (st >> 1) * 16 + swz / 64; C = (st & 1) * 32 + (swz % 64) / 2; }
__host__ __device__ __forceinline__ int perm32(int rho) { const int n = rho >> 4, i = rho & 15; return 8 * (i >> 2) + 4 * n + (i & 3); }

struct Unit { int pm, pn; };
struct Gemm { const bf16_t* A; const bf16_t* Bt; int M, N, K, lda; };

struct StaticOrder {
    int nM, nN, nwg, G, c;
    __host__ __device__ void init(int M, int N, int G_, int c_) { nM = M / BM; nN = N / BM; nwg = nM * nN; G = G_; c = c_; }
    __host__ __device__ bool next(int i, Unit& u) const {
        const long L = (long)i * G + c; if (L >= nwg) return false;
        int wgid = (int)L; { const int q = nwg / NXCD, r = nwg % NXCD, xcd = wgid % NXCD, off = wgid / NXCD; wgid = (xcd < r ? xcd * (q + 1) : r * (q + 1) + (xcd - r) * q) + off; }
        const int nig = WGM * nN, gid = wgid / nig, fm = gid * WGM, gsz = (nM - fm) < WGM ? (nM - fm) : WGM;
        u.pm = fm + ((wgid % nig) % gsz); u.pn = (wgid % nig) / gsz; return true;
    }
    __device__ __forceinline__ void a_ready(const Unit&) const {}
    __device__ __forceinline__ void done(const Unit&) const {}
};
typedef float f32x4_ __attribute__((ext_vector_type(4)));
template <class Epi, class Sched, bool ALIGN_EPI = false, bool SP2 = false>
__device__ __forceinline__ void gemm_phase(PG8_LAS unsigned char* lds, const Gemm g, const Sched& S, const Epi& E) {
    const int tid = ::opq((int)threadIdx.x), wid = __builtin_amdgcn_readfirstlane(tid >> 6), lane = tid & 63, wr = wid >> 2, wc = wid & 3, fr = lane & 15, fq = lane >> 4;
    const int K = g.K, nt = K / BK;
    unsigned voffA[2], voffB[2];
#pragma unroll
    for (int i = 0; i < 2; ++i) { int R, C; stage_rc(tid * 16 + i * 8192, R, C); const int Rb = Epi::PERM ? ((R & ~31) + perm32(R & 31)) : R;
        voffA[i] = (unsigned)(R * g.lda + C) * 2u; voffB[i] = (unsigned)(Rb * K + C) * 2u; }
    const size_t kstep = (size_t)(BK * 2);
    const size_t hstepB = (size_t)HALF * K * 2, hstepA = (size_t)HALF * g.lda * 2;
    const size_t tstepB = 2 * hstepB, tstepA = 2 * hstepA;
    const unsigned ldsw = (unsigned)wid * 1024u;
    const int aoff = lds_byte(wr * 64 + fr, fq * 8), boff = lds_byte(wc * 32 + fr, fq * 8);
#define PG8_SA(b, h) (((b) * 2 + (h)) * HTB)
#define PG8_SB(b, h) ((4 + (b) * 2 + (h)) * HTB)
#define PG8_STAGE(bufoff, gbase, voff) do { _Pragma("unroll") for (int _i = 0; _i < 2; ++_i) \
        __builtin_amdgcn_global_load_lds((const unsigned*)((const char*)(gbase) + (voff)[_i]), (PG8_LAS unsigned*)(lds + (bufoff) + ldsw + _i * 8192), 16, 0, 0); } while (0)
#define PG8_LDA(dst, b, h) do { _Pragma("unroll") for (int m = 0; m < 4; ++m) _Pragma("unroll") for (int k = 0; k < 2; ++k) dst[m][k] = *(const PG8_LAS bf16x8*)(lds + PG8_SA(b, h) + aoff + m * 2048 + k * 1024); } while (0)
#define PG8_LDB(dst, b, h) do { _Pragma("unroll") for (int n = 0; n < 2; ++n) _Pragma("unroll") for (int k = 0; k < 2; ++k) dst[n][k] = *(const PG8_LAS bf16x8*)(lds + PG8_SB(b, h) + boff + n * 2048 + k * 1024); } while (0)
#define PG8_MMA(ai, bj, At, Bt) do { __builtin_amdgcn_s_setprio(1); _Pragma("unroll") for (int m = 0; m < 4; ++m) _Pragma("unroll") for (int n = 0; n < 2; ++n) _Pragma("unroll") for (int k = 0; k < 2; ++k) \
        acc[ai][bj][m][n] = __builtin_amdgcn_mfma_f32_16x16x32_bf16(Bt[n][k], At[m][k], acc[ai][bj][m][n], 0, 0, 0); __builtin_amdgcn_s_setprio(0); } while (0)
#define PG8_WAIT_V(n) asm volatile("s_waitcnt vmcnt(" #n ")" ::: "memory")
#define PG8_WAIT_L(n) asm volatile("s_waitcnt lgkmcnt(" #n ")" ::: "memory")
#define PG8_BAR __builtin_amdgcn_s_barrier()
#define PG8_SCHED __builtin_amdgcn_sched_barrier(0)
    Unit cur, nxt; int ui = 0;
    if (!S.next(0, cur)) return;
    f32x4 acc[2][2][4][2];
#pragma unroll
    for (int a = 0; a < 2; ++a)
#pragma unroll
        for (int b = 0; b < 2; ++b)
#pragma unroll
            for (int m = 0; m < 4; ++m)
#pragma unroll
                for (int n = 0; n < 2; ++n) acc[a][b][m][n] = (f32x4){0.f, 0.f, 0.f, 0.f};
    bf16x8 At[4][2], B0[2][2], B1[2][2];
    const char* cA = (const char*)g.A + (size_t)cur.pm * tstepA; const char* cB = (const char*)g.Bt + (size_t)cur.pn * tstepB;
    S.a_ready(cur);
    if constexpr (SP2) {
        PG8_STAGE(PG8_SB(0, 0), cB, voffB); PG8_STAGE(PG8_SB(0, 1), cB + hstepB, voffB); PG8_STAGE(PG8_SA(0, 0), cA, voffA); PG8_STAGE(PG8_SA(0, 1), cA + hstepA, voffA);
        if (wr == 1) PG8_BAR;
        PG8_WAIT_V(2); PG8_BAR;
        PG8_STAGE(PG8_SB(1, 0), cB + kstep, voffB); PG8_STAGE(PG8_SA(1, 0), cA + kstep, voffA); PG8_STAGE(PG8_SB(1, 1), cB + hstepB + kstep, voffB);
        PG8_WAIT_V(6); PG8_BAR;
    } else {
        PG8_STAGE(PG8_SB(0, 0), cB, voffB); PG8_STAGE(PG8_SA(0, 0), cA, voffA); PG8_STAGE(PG8_SB(0, 1), cB + hstepB, voffB); PG8_STAGE(PG8_SA(0, 1), cA + hstepA, voffA);
        if (wr == 1) PG8_BAR;
        PG8_WAIT_V(4); PG8_BAR;
        PG8_STAGE(PG8_SB(1, 0), cB + kstep, voffB); PG8_STAGE(PG8_SA(1, 0), cA + kstep, voffA); PG8_STAGE(PG8_SB(1, 1), cB + hstepB + kstep, voffB);
        PG8_WAIT_V(6); PG8_BAR;
    }
    for (;;) {
        const bool has_next = S.next(ui + 1, nxt);
        const char* nA = has_next ? (const char*)g.A + (size_t)nxt.pm * tstepA : cA; const char* nB = has_next ? (const char*)g.Bt + (size_t)nxt.pn * tstepB : cB;
        for (int t = 0; t < nt; t += 2) {
            const bool last = (t == nt - 2);
            const char* a1 = cA + (size_t)(t + 1) * kstep;
            const char* a2 = last ? nA : cA + (size_t)(t + 2) * kstep; const char* b2 = last ? nB : cB + (size_t)(t + 2) * kstep;
            const char* a3 = a2 + kstep; const char* b3 = b2 + kstep;
            if (last && has_next) S.a_ready(nxt);
            if constexpr (SP2) {
            PG8_LDB(B0, 0, 0); PG8_LDB(B1, 0, 1); PG8_SCHED; PG8_LDA(At, 0, 0); PG8_STAGE(PG8_SA(1, 1), a1 + hstepA, voffA);
            PG8_WAIT_V(8); PG8_WAIT_L(0); PG8_BAR; PG8_MMA(0, 0, At, B0); PG8_MMA(0, 1, At, B1); PG8_BAR; PG8_SCHED;
            PG8_LDA(At, 0, 1); PG8_STAGE(PG8_SB(0, 0), b2, voffB); PG8_STAGE(PG8_SB(0, 1), b2 + hstepB, voffB); PG8_STAGE(PG8_SA(0, 0), a2, voffA);
            PG8_WAIT_V(8); PG8_WAIT_L(0); PG8_BAR; PG8_MMA(1, 0, At, B0); PG8_MMA(1, 1, At, B1); PG8_BAR; PG8_SCHED;
            PG8_LDB(B0, 1, 0); PG8_LDB(B1, 1, 1); PG8_SCHED; PG8_LDA(At, 1, 0); PG8_STAGE(PG8_SA(0, 1), a2 + hstepA, voffA);
            PG8_WAIT_V(8); PG8_WAIT_L(0); PG8_BAR; PG8_MMA(0, 0, At, B0); PG8_MMA(0, 1, At, B1); PG8_BAR; PG8_SCHED;
            PG8_LDA(At, 1, 1); PG8_STAGE(PG8_SB(1, 0), b3, voffB); PG8_STAGE(PG8_SB(1, 1), b3 + hstepB, voffB); PG8_STAGE(PG8_SA(1, 0), a3, voffA);
            PG8_WAIT_V(8); PG8_WAIT_L(0); PG8_BAR; PG8_MMA(1, 0, At, B0); PG8_MMA(1, 1, At, B1); PG8_BAR; PG8_SCHED;
            } else {
            PG8_LDB(B0, 0, 0); PG8_SCHED; PG8_LDA(At, 0, 0); PG8_STAGE(PG8_SA(1, 1), a1 + hstepA, voffA);
            PG8_WAIT_L(8); PG8_BAR; PG8_WAIT_L(0); PG8_MMA(0, 0, At, B0); PG8_BAR; PG8_SCHED;
            PG8_LDB(B1, 0, 1); PG8_STAGE(PG8_SB(0, 0), b2, voffB);
            PG8_BAR; PG8_WAIT_L(0); PG8_MMA(0, 1, At, B1); PG8_BAR;
            PG8_LDA(At, 0, 1); PG8_STAGE(PG8_SA(0, 0), a2, voffA);
            PG8_BAR; PG8_WAIT_L(0); PG8_MMA(1, 0, At, B0); PG8_BAR; PG8_SCHED;
            PG8_STAGE(PG8_SB(0, 1), b2 + hstepB, voffB);
            PG8_WAIT_V(6); PG8_BAR; PG8_MMA(1, 1, At, B1); PG8_BAR;
            PG8_LDB(B0, 1, 0); PG8_SCHED; PG8_LDA(At, 1, 0); PG8_STAGE(PG8_SA(0, 1), a2 + hstepA, voffA);
            PG8_WAIT_L(8); PG8_BAR; PG8_WAIT_L(0); PG8_MMA(0, 0, At, B0); PG8_BAR; PG8_SCHED;
            PG8_LDB(B1, 1, 1); PG8_STAGE(PG8_SB(1, 0), b3, voffB);
            PG8_BAR; PG8_WAIT_L(0); PG8_MMA(0, 1, At, B1); PG8_BAR;
            PG8_LDA(At, 1, 1); PG8_STAGE(PG8_SA(1, 0), a3, voffA);
            PG8_BAR; PG8_WAIT_L(0); PG8_MMA(1, 0, At, B0); PG8_BAR; PG8_SCHED;
            PG8_STAGE(PG8_SB(1, 1), b3 + hstepB, voffB);
            PG8_WAIT_V(6); PG8_BAR; PG8_MMA(1, 1, At, B1); PG8_BAR;
            }
        }
        if constexpr (ALIGN_EPI) { if (wr == 0) PG8_BAR; }
        if constexpr (!Epi::AFTER_DRAIN) { E(acc, cur, wr, wc, fr, fq); S.done(cur); }
        if (!has_next) break;
#pragma unroll
        for (int a = 0; a < 2; ++a)
#pragma unroll
            for (int b = 0; b < 2; ++b)
#pragma unroll
                for (int m = 0; m < 4; ++m)
#pragma unroll
                    for (int n = 0; n < 2; ++n) acc[a][b][m][n] = (f32x4){0.f, 0.f, 0.f, 0.f};
        cur = nxt; cA = nA; cB = nB; ++ui;
        if constexpr (ALIGN_EPI) { if (wr == 1) PG8_BAR; }
    }
    PG8_WAIT_V(0);
    if constexpr (!ALIGN_EPI) { if (wr == 0) PG8_BAR; }
    PG8_BAR;
    if constexpr (Epi::AFTER_DRAIN) { E.fused(acc, cur, wr, wc, fr, fq, lds, wid, lane); S.done(cur); }
#undef PG8_SA
#undef PG8_SB
#undef PG8_STAGE
#undef PG8_LDA
#undef PG8_LDB
#undef PG8_MMA
#undef PG8_WAIT_V
#undef PG8_WAIT_L
#undef PG8_BAR
#undef PG8_SCHED
}
}

namespace pg8 {
struct PEpiBf16 { static constexpr bool PERM = true, AFTER_DRAIN = false; bf16_t* O; int ldc;
    __device__ __forceinline__ void operator()(const f32x4 (&acc)[2][2][4][2], const Unit& u, int wr, int wc, int fr, int fq) const {
        const int row0 = u.pm * BM + wr * 64 + fr, col0 = u.pn * BM + wc * 32 + 8 * fq;
#pragma unroll
        for (int ai = 0; ai < 2; ++ai)
#pragma unroll
            for (int m = 0; m < 4; ++m) { bf16_t* rowp = O + (size_t)(row0 + ai * HALF + m * 16) * ldc + col0;
#pragma unroll
                for (int bj = 0; bj < 2; ++bj) { const f32x4 v0 = acc[ai][bj][m][0], v1 = acc[ai][bj][m][1]; u32x4 w;
                    w.x = ::pk2s(v0[0], v0[1]); w.y = ::pk2s(v0[2], v0[3]); w.z = ::pk2s(v1[0], v1[1]); w.w = ::pk2s(v1[2], v1[3]);
                    *(u32x4*)(rowp + bj * HALF) = w; } }
    } };
struct PEpiResid { static constexpr bool PERM = false, AFTER_DRAIN = false; const float* xin; float* xout;
    __device__ __forceinline__ void operator()(const f32x4 (&acc)[2][2][4][2], const Unit& u, int wr, int wc, int fr, int fq) const {
        const int row0 = u.pm * BM + wr * 64 + fr, col0 = u.pn * BM + wc * 32 + 4 * fq;
#pragma unroll
        for (int ai = 0; ai < 2; ++ai)
#pragma unroll
            for (int m = 0; m < 4; ++m) { const size_t off = (size_t)(row0 + ai * HALF + m * 16) * D_MODEL + col0;
#pragma unroll
                for (int bj = 0; bj < 2; ++bj)
#pragma unroll
                    for (int n = 0; n < 2; ++n) { f32x4 v = *(const f32x4*)(xin + off + bj * HALF + n * 16); v += acc[ai][bj][m][n]; *(f32x4*)(xout + off + bj * HALF + n * 16) = v; }
                asm volatile("" ::: "memory"); }
    } };
struct PEpiBf16S { static constexpr bool PERM = true, AFTER_DRAIN = false; bf16_t* O; int ldc; const float* rstd;
    __device__ __forceinline__ void operator()(const f32x4 (&acc)[2][2][4][2], const Unit& u, int wr, int wc, int fr, int fq) const {
        const int row0 = u.pm * BM + wr * 64 + fr, col0 = u.pn * BM + wc * 32 + 8 * fq;
#pragma unroll
        for (int ai = 0; ai < 2; ++ai)
#pragma unroll
            for (int m = 0; m < 4; ++m) { const int row = row0 + ai * HALF + m * 16; const float rs = rstd[row]; bf16_t* rowp = O + (size_t)row * ldc + col0;
#pragma unroll
                for (int bj = 0; bj < 2; ++bj) { const f32x4 v0 = acc[ai][bj][m][0] * rs, v1 = acc[ai][bj][m][1] * rs; u32x4 w;
                    w.x = ::pk2(v0[0], v0[1]); w.y = ::pk2(v0[2], v0[3]); w.z = ::pk2(v1[0], v1[1]); w.w = ::pk2(v1[2], v1[3]);
                    *(u32x4*)(rowp + bj * HALF) = w; } }
    } };
struct PEpiResidX { static constexpr bool PERM = true, AFTER_DRAIN = false; const float* xin; float* xout; bf16_t* xb; float* ssp;
    __device__ __forceinline__ void operator()(const f32x4 (&acc)[2][2][4][2], const Unit& u, int wr, int wc, int fr, int fq) const {
        const int row0 = u.pm * BM + wr * 64 + fr, col0 = u.pn * BM + wc * 32 + 8 * fq;
#pragma unroll
        for (int ai = 0; ai < 2; ++ai)
#pragma unroll
            for (int m = 0; m < 4; ++m) { const int row = row0 + ai * HALF + m * 16; const size_t off = (size_t)row * D_MODEL + col0; float ss = 0.f;
#pragma unroll
                for (int bj = 0; bj < 2; ++bj) { f32x4 v0 = *(const f32x4*)(xin + off + bj * HALF), v1 = *(const f32x4*)(xin + off + bj * HALF + 4);
                    v0 += acc[ai][bj][m][0]; v1 += acc[ai][bj][m][1]; *(f32x4*)(xout + off + bj * HALF) = v0; *(f32x4*)(xout + off + bj * HALF + 4) = v1;
                    ss += ((v0[0] * v0[0] + v0[1] * v0[1]) + (v0[2] * v0[2] + v0[3] * v0[3])) + ((v1[0] * v1[0] + v1[1] * v1[1]) + (v1[2] * v1[2] + v1[3] * v1[3]));
                    u32x4 w; w.x = ::pk2(v0[0], v0[1]); w.y = ::pk2(v0[2], v0[3]); w.z = ::pk2(v1[0], v1[1]); w.w = ::pk2(v1[2], v1[3]); *(u32x4*)(xb + off + bj * HALF) = w; }
                ss += __shfl_xor(ss, 16); ss += __shfl_xor(ss, 32);
                if (fq == 0) ssp[(size_t)row * 32 + u.pn * 4 + wc] = ss;
                asm volatile("" ::: "memory"); }
    } };
template <class Epi> __device__ __forceinline__ void run(LDSA char* lds_phys, const bf16_t* A, int lda, const bf16_t* Bt, int M, int N, int K, const Epi& E) {
    Gemm g{A, Bt, M, N, K, lda}; StaticOrder S; S.init(M, N, (int)gridDim.x, (int)blockIdx.x);
    gemm_phase<Epi, StaticOrder, true, true>((PG8_LAS unsigned char*)lds_phys, g, S, E);
}
}

struct TileDesc { const bf16_t* kp; const bf16_t* vp; const bf16_t* k2p; int kidx0; };
constexpr int ATT_VOFF = 25600, ATT_BOFF = 46080, ATT_VSTR = 320;
constexpr int CMP_POFF = 37888, CMP_PSTR = 68, CMP_LOFF = CMP_POFF + 4 * 32 * CMP_PSTR * 4;

typedef short s16x4 __attribute__((ext_vector_type(4)));
DEVI bf16x8 vfrag(LDSA char* vp) {
    const s16x4 a = __builtin_amdgcn_ds_read_tr16_b64_v4i16((LDSA s16x4*)vp), b = __builtin_amdgcn_ds_read_tr16_b64_v4i16((LDSA s16x4*)(vp + 8 * ATT_VSTR));
    return (bf16x8){a[0], a[1], a[2], a[3], b[0], b[1], b[2], b[3]};
}
template <int C> DEVI void pv_step(LDSA char* vp, f32x16& o, const bf16x8 (&pk)[2][2]) {
    const bf16x8 f00 = vfrag(vp + 64 * C), f01 = vfrag(vp + 16 * ATT_VSTR + 64 * C), f10 = vfrag(vp + 32 * ATT_VSTR + 64 * C), f11 = vfrag(vp + 48 * ATT_VSTR + 64 * C);
    o = mfma32(f00, pk[0][0], o); o = mfma32(f01, pk[0][1], o); o = mfma32(f10, pk[1][0], o); o = mfma32(f11, pk[1][1], o);
}

template <int MODE, class TileFn, class EpiFn>
DEVI void attn_core(LDSA char* lds, int tid, const bf16_t* qrow, int qidx, int qidx0w, int ntiles, int nsync, int kst, int vst, int k2st, TileFn tilefn, const float* btab, int bmax,
                    unsigned long long selm, EpiFn epi) {
    constexpr int DQK = (MODE == 0) ? 192 : 128, KSTR = DQK * 2 + 16, KCH = DQK / 8, NKL = 64 * KCH / 256, NKS = DQK / 16;
    constexpr bool LBIAS = (MODE == 1 || MODE == 2 || MODE == 3);
    const int lane = tid & 63, wave = __builtin_amdgcn_readfirstlane(tid >> 6), n = lane & 31, h = lane >> 5;
    LDSA char* Ks = lds; LDSA char* Vs = lds + (MODE == 4 ? 17408 : ATT_VOFF); LDSA float* Bw = (LDSA float*)(lds + ATT_BOFF) + wave * 96;
    bf16x8 qf[NKS];
#pragma unroll
    for (int ks = 0; ks < NKS; ++ks) qf[ks] = *(const bf16x8*)(qrow + 16 * ks + 8 * h);
    if (MODE == 0) {
        const float* ct = btab + (size_t)qidx * 32 + 8 * h; const float* st = ct + 4096 * 32;
#pragma unroll
        for (int kk = 0; kk < 2; ++kk) { v4i a = __builtin_bit_cast(v4i, qf[8 + kk]), b2 = __builtin_bit_cast(v4i, qf[10 + kk]);
#pragma unroll
            for (int j = 0; j < 4; ++j) { const float c0 = ct[16 * kk + 2 * j], c1 = ct[16 * kk + 2 * j + 1], s0_ = st[16 * kk + 2 * j], s1_ = st[16 * kk + 2 * j + 1];
                const float x10 = lo2f((unsigned)a[j]), x11 = hi2f((unsigned)a[j]), x20 = lo2f((unsigned)b2[j]), x21 = hi2f((unsigned)b2[j]);
                a[j] = (int)pk2(x10 * c0 - x20 * s0_, x11 * c1 - x21 * s1_); b2[j] = (int)pk2(x10 * s0_ + x20 * c0, x11 * s1_ + x21 * c1); }
            qf[8 + kk] = __builtin_bit_cast(bf16x8, a); qf[10 + kk] = __builtin_bit_cast(bf16x8, b2); }
    }
    f32x16 o[4];
#pragma unroll
    for (int c = 0; c < 4; ++c) o[c] = zero16();
    float m = -INFINITY, l = 0.f;
    u32x4 kreg[4], vreg[4]; float breg0 = 0.f, breg1 = 0.f; int next_kidx0 = 0;
    LDSA char* const vp = Vs + (4 * h + ((lane & 15) >> 2)) * ATT_VSTR + (16 * ((lane >> 4) & 1) + 4 * (lane & 3)) * 2;
    const unsigned koff = (unsigned)(tid >> 4) * (unsigned)kst + (tid & 15) * 8, voff = (unsigned)(tid >> 4) * (unsigned)vst + (tid & 15) * 8;
    const unsigned k2off = (unsigned)(tid >> 3) * (unsigned)k2st + (tid & 7) * 8;
    u32x4 k2reg[2];
#define AISSUE(it) do { TileDesc td; tilefn((it), td); next_kidx0 = td.kidx0; \
        _Pragma("unroll") for (int u = 0; u < 4; ++u) kreg[u] = *(const u32x4*)(td.kp + (size_t)(16 * u) * kst + koff); \
        if (MODE == 0) { _Pragma("unroll") for (int u = 0; u < 2; ++u) k2reg[u] = *(const u32x4*)(td.k2p + (size_t)(32 * u) * k2st + k2off); } \
        _Pragma("unroll") for (int u = 0; u < 4; ++u) vreg[u] = *(const u32x4*)(td.vp + (size_t)(16 * u) * vst + voff); \
        if (LBIAS) { const int D0 = qidx0w - td.kidx0; int i0 = D0 + 31 - lane, i1 = D0 + 31 - (lane + 64); \
            breg0 = (i0 >= 0 && i0 <= bmax) ? btab[i0] : 0.f; breg1 = (lane < 32 && i1 >= 0 && i1 <= bmax) ? btab[i1] : 0.f; } } while (0)
    AISSUE(0);
    const int nloop = (MODE == 3) ? nsync : ntiles;
    for (int it = 0; it < nloop; ++it) {
        const int kidx0 = next_kidx0; const bool act = (MODE == 3) ? (it < ntiles) : true;
        __syncthreads();
        if (act) {
#pragma unroll
        for (int u = 0; u < 4; ++u) *(LDSA u32x4*)(Ks + (tid >> 4) * KSTR + (tid & 15) * 16 + u * 16 * KSTR) = kreg[u];
        if (MODE == 0) {
#pragma unroll
            for (int u = 0; u < 2; ++u) *(LDSA u32x4*)(Ks + (tid >> 3) * KSTR + 256 + (tid & 7) * 16 + u * 32 * KSTR) = k2reg[u]; }
#pragma unroll
        for (int u = 0; u < 4; ++u) *(LDSA u32x4*)(Vs + (tid >> 4) * ATT_VSTR + (tid & 15) * 16 + u * 16 * ATT_VSTR) = vreg[u];
        if (LBIAS) { Bw[lane] = breg0; if (lane < 32) Bw[lane + 64] = breg1; }
        }
        __syncthreads();
        if (it + 1 < ntiles) AISSUE(it + 1);
        __builtin_amdgcn_sched_barrier(0);
        const int dlo = qidx0w - (kidx0 + 63);
        const int dhi = qidx0w + 31 - kidx0;
        bool skip = false, full = false; bool selbit = true;
        if (MODE == 0) { skip = dhi < 0; full = dlo >= 0; }
        if (MODE == 1) { skip = dhi < 0 || dlo >= 512; full = dlo >= 0 && dhi < 512; }
        if (MODE == 2) { skip = dhi < 0 || dlo > 128; full = dlo >= 0 && dhi <= 128; }
        if (MODE == 3) { selbit = (selm >> (kidx0 >> 6)) & 1ull; skip = (__ballot(selbit) == 0ull) || dhi < 0; full = false; }
        if (MODE == 4) { skip = false; full = false; }
        if (act && !skip) {
            f32x16 s0 = zero16(), s1 = zero16();
            LDSA char* kb = Ks + n * KSTR + h * 16;
#pragma unroll
            for (int ks = 0; ks < NKS; ++ks) {
                const bf16x8 k0 = *(LDSA bf16x8*)(kb + ks * 32), k1 = *(LDSA bf16x8*)(kb + 32 * KSTR + ks * 32);
                s0 = mfma32(k0, qf[ks], s0); s1 = mfma32(k1, qf[ks], s1);
            }
            const float sc = (MODE == 0) ? 1.0f : NSA_SCALE2;
            int dbase = qidx - kidx0 - 4 * h;
            asm volatile("" : "+v"(dbase));
            float tmax = -INFINITY;
            if ((MODE == 0 || MODE == 1 || MODE == 2) && full) {
#pragma unroll
                for (int mt = 0; mt < 2; ++mt)
#pragma unroll
                    for (int r = 0; r < 16; ++r) {
                        const int ko = 32 * mt + 8 * (r >> 2) + (r & 3);
                        float v = (mt ? s1[r] : s0[r]) * sc;
                        if (LBIAS) v += Bw[(31 - n + 4 * h) + ko];
                        if (mt) s1[r] = v; else s0[r] = v;
                        tmax = fmaxf(tmax, v);
                    }
            } else {
#pragma unroll
            for (int mt = 0; mt < 2; ++mt)
#pragma unroll
                for (int r = 0; r < 16; ++r) {
                    const int ko = 32 * mt + 8 * (r >> 2) + (r & 3);
                    float v = (mt ? s1[r] : s0[r]) * sc;
                    if (LBIAS) v += Bw[(31 - n + 4 * h) + ko];
                    if (MODE == 4) { const int kidx = kidx0 + 4 * h + ko; const int nvalid = (qidx + 1) >> 6;
                        if (kidx < nvalid) v += btab[qidx - 64 * kidx - 63]; else v = -INFINITY; }
                    else if (!full) { const int dist = dbase - ko; bool ok = dist >= 0;
                        if (MODE == 1) ok = ok && dist < 512;
                        if (MODE == 2) ok = ok && dist <= 128;
                        if (MODE == 3) ok = ok && selbit;
                        if (!ok) v = -INFINITY; }
                    if (mt) s1[r] = v; else s0[r] = v;
                    tmax = fmaxf(tmax, v);
                }
                asm volatile("" ::: "memory");
            }
            tmax = fmaxf(tmax, __shfl_xor(tmax, 32));
            const float mnew = fmaxf(m, tmax), msafe = (mnew == -INFINITY) ? 0.f : mnew;
            const float alpha = fexp2(m - msafe);
            float ps = 0.f;
#pragma unroll
            for (int r = 0; r < 16; ++r) { s0[r] = fexp2(s0[r] - msafe); ps += s0[r]; }
#pragma unroll
            for (int r = 0; r < 16; ++r) { s1[r] = fexp2(s1[r] - msafe); ps += s1[r]; }
            l = l * alpha + ps; m = mnew;
            if (__ballot(alpha != 1.0f) != 0ull) {
#pragma unroll
                for (int c = 0; c < 4; ++c)
#pragma unroll
                    for (int r = 0; r < 16; ++r) o[c][r] *= alpha;
            }
            if (MODE == 4) {
                LDSA float* pb = (LDSA float*)(lds + CMP_POFF) + (wave * 32 + n) * CMP_PSTR + 4 * h;
#pragma unroll
                for (int mt = 0; mt < 2; ++mt)
#pragma unroll
                    for (int g = 0; g < 4; ++g) { f32x4 pv; for (int e = 0; e < 4; ++e) pv[e] = mt ? s1[4 * g + e] : s0[4 * g + e]; *(LDSA f32x4*)(pb + 32 * mt + 8 * g) = pv; }
            }
            bf16x8 pk[2][2];
#pragma unroll
            for (int j = 0; j < 2; ++j) {
                v4i a; a.x = (int)pk2(s0[8 * j], s0[8 * j + 1]); a.y = (int)pk2(s0[8 * j + 2], s0[8 * j + 3]); a.z = (int)pk2(s0[8 * j + 4], s0[8 * j + 5]); a.w = (int)pk2(s0[8 * j + 6], s0[8 * j + 7]);
                pk[0][j] = __builtin_bit_cast(bf16x8, a);
                v4i b; b.x = (int)pk2(s1[8 * j], s1[8 * j + 1]); b.y = (int)pk2(s1[8 * j + 2], s1[8 * j + 3]); b.z = (int)pk2(s1[8 * j + 4], s1[8 * j + 5]); b.w = (int)pk2(s1[8 * j + 6], s1[8 * j + 7]);
                pk[1][j] = __builtin_bit_cast(bf16x8, b);
            }
            pv_step<0>(vp, o[0], pk); pv_step<1>(vp, o[1], pk); pv_step<2>(vp, o[2], pk); pv_step<3>(vp, o[3], pk);
        }
    }
#undef AISSUE
    l += __shfl_xor(l, 32);
    epi(o, l, m);
    __syncthreads();
}

template <int MAP> DEVI int colmap(int n) {
    if (MAP == 1) { if (n < 2560) return n; if (n < 8704) return n + 24; if (n < 8728) return n - 8704 + 2560; return -1; }
    if (MAP == 2) { if (n < 2048) return n; if (n < 4096) return n + 64; if (n < 4160) return n - 4096 + 2048; return -1; }
    return n;
}
template <int MAP>
DEVI void transpose_job(LDSA char* lds, int tid, const float* __restrict__ src, int K, int Nsrc, bf16_t* __restrict__ dst, int Npad, float wscale = 1.0f, const float* __restrict__ kscale = nullptr) {
    LDSA float* T = (LDSA float*)lds;
    const int nKt = K / 64, nNt = Npad / 64, nt = nKt * nNt, G = vgrid();
    for (int t = vblock(); t < nt; t += G) {
        const int kt = t % nKt, ntile = t / nKt, k0 = kt * 64, n0 = ntile * 64;
        const int nl = tid & 63, sc = colmap<MAP>(n0 + nl);
#pragma unroll
        for (int u = 0; u < 16; ++u) { const int kl = (tid >> 6) + 4 * u; T[kl * 65 + nl] = (sc >= 0) ? src[(size_t)(k0 + kl) * Nsrc + sc] * (kscale ? kscale[k0 + kl] : wscale) : 0.f; }
        __syncthreads();
#pragma unroll
        for (int u = 0; u < 2; ++u) { const int c = tid + 256 * u, n2 = c >> 3, kc = c & 7; u32x4 w;
            w.x = pk2(T[(kc * 8 + 0) * 65 + n2], T[(kc * 8 + 1) * 65 + n2]); w.y = pk2(T[(kc * 8 + 2) * 65 + n2], T[(kc * 8 + 3) * 65 + n2]);
            w.z = pk2(T[(kc * 8 + 4) * 65 + n2], T[(kc * 8 + 5) * 65 + n2]); w.w = pk2(T[(kc * 8 + 6) * 65 + n2], T[(kc * 8 + 7) * 65 + n2]);
            *(u32x4*)(dst + (size_t)(n0 + n2) * K + k0 + kc * 8) = w; }
        __syncthreads();
    }
}
DEVI int t5_bucket(int d) { if (d < 16) return d; const float v = __builtin_log2f((float)d * 0.0625f) * (16.0f / 7.0f); int b = 16 + (int)v; return b > 31 ? 31 : b; }

DEVI void phase_prep(const Params& P, LDSA char* lds, int tid) {
    unsigned char* ws = P.ws;
    for (int i = 0; i < 2; ++i) {
        transpose_job<1>(lds, tid, P.ev_w_in + (size_t)i * 2048 * 8728, 2048, 8728, (bf16_t*)(ws + WS_WEVIN + i * SZ_WEVIN), LDZE, 1.0f, P.norm_w + (2 * i) * D_MODEL);
        transpose_job<0>(lds, tid, P.ev_w_out + (size_t)i * 1536 * 2048, 1536, 2048, (bf16_t*)(ws + WS_WEVOUT + i * SZ_WEVOUT), 2048);
        transpose_job<2>(lds, tid, P.od_w_in + (size_t)i * 2048 * 4160, 2048, 4160, (bf16_t*)(ws + WS_WODIN + i * SZ_WODIN), LDZO, 1.0f, P.norm_w + (2 * i + 1) * D_MODEL);
        transpose_job<0>(lds, tid, P.w_qb + (size_t)i * 1536 * 3072, 1536, 3072, (bf16_t*)(ws + WS_WQB + i * SZ_WQB), 3072, MLA_SCALE2);
        transpose_job<0>(lds, tid, P.w_kvb + (size_t)i * 512 * 4096, 512, 4096, (bf16_t*)(ws + WS_WKVB + i * SZ_WKVB), 4096);
        transpose_job<0>(lds, tid, P.od_w_out + (size_t)i * 2048 * 2048, 2048, 2048, (bf16_t*)(ws + WS_WODOUT + i * SZ_WODOUT), 2048);
        for (int kv = 0; kv < 2; ++kv)
            transpose_job<0>(lds, tid, P.cmp_w1 + (size_t)(i * 2 + kv) * 8192 * 128, 8192, 128, (bf16_t*)(ws + WS_W1 + (i * 2 + kv) * SZ_W1), 128);
    }
    const int G = vgrid(), gt = vblock() * GTHREADS + tid, GT = G * GTHREADS;
    float* biasT = (float*)(ws + WS_BIAST); float* biasD = (float*)(ws + WS_BIASD);
    for (int i = gt; i < 20 * 4096; i += GT) { const int hh = i >> 12, d = i & 4095; biasT[i] = P.rel_bias[t5_bucket(d) * 20 + hh] * LOG2E; }
    for (int i = gt; i < 12 * 132; i += GT) { const int gh = i / 132, j = i % 132, g = gh >> 2; const int dd = g == 0 ? 1 : (g == 1 ? 4 : 16);
        biasD[i] = (j <= 128) ? P.rel_bias[t5_bucket(j * dd) * 20 + 8 + gh] * LOG2E : 0.f; }
    float* cosT = (float*)(ws + WS_COS); float* sinT = (float*)(ws + WS_SIN);
    double dz; { int zz = 0; asm volatile("" : "+v"(zz)); dz = (double)zz; }
    for (int i = gt; i < 4096 * 32; i += GT) {
        const int t = i >> 5, fi = i & 31; double f = 1.0; for (int q = 0; q < fi; ++q) f *= 0.7498942093324559;
        const float ang = (float)t * (float)f; const double a = (double)ang; const double kq = __builtin_rint(a * 0.6366197723675814);
        const double r = a - kq * 1.5707963267948966, r2 = r * r;
        const double sn = r * (1.0 + r2 * ((dz - 1.0 / 6) + r2 * ((dz + 1.0 / 120) + r2 * ((dz - 1.0 / 5040) + r2 * ((dz + 1.0 / 362880) + r2 * ((dz - 1.0 / 39916800) + r2 * (dz + 1.0 / 6227020800.0)))))));
        const double cs = 1.0 + r2 * ((dz - 0.5) + r2 * ((dz + 1.0 / 24) + r2 * ((dz - 1.0 / 720) + r2 * ((dz + 1.0 / 40320) + r2 * ((dz - 1.0 / 3628800) + r2 * (dz + 1.0 / 479001600.0))))));
        const int qd = ((int)kq) & 3; double S = sn, C = cs; if (qd == 1) { S = cs; C = -sn; } else if (qd == 2) { S = -sn; C = -cs; } else if (qd == 3) { S = -cs; C = sn; }
        cosT[i] = (float)C; sinT[i] = (float)S;
    }
    float* posp = (float*)(ws + WS_POSP); LDSA float* red = (LDSA float*)lds;
    for (int it = vblock(); it < 32; it += G) {
        const int lkv = it >> 3, part = it & 7, j = tid & 127, half = tid >> 7;
        const float* pos = P.cmp_pos + (size_t)lkv * 8192; const float* w1 = P.cmp_w1 + (size_t)lkv * 8192 * 128;
        float s = 0.f; const int kb = part * 1024 + half * 512;
        for (int k = 0; k < 512; ++k) s += pos[kb + k] * w1[(size_t)(kb + k) * 128 + j];
        __syncthreads(); if (half) red[j] = s; __syncthreads(); if (!half) posp[(lkv * 8 + part) * 128 + j] = s + red[j]; __syncthreads();
    }
}

template <bool OUTF32>
DEVI void phase_rms(const float* __restrict__ x, const float* __restrict__ w, void* outp, int tid) {
    const int lane = tid & 63, wave = __builtin_amdgcn_readfirstlane(tid >> 6), G = vgrid();
    for (int rb = vblock(); rb < MTOK / 4; rb += G) {
        const int row = rb * 4 + wave; const float* xr = x + (size_t)row * D_MODEL;
        f32x4 v[8]; float ss = 0.f;
#pragma unroll
        for (int u = 0; u < 8; ++u) { v[u] = *(const f32x4*)(xr + (u * 64 + lane) * 4); ss += v[u][0] * v[u][0] + v[u][1] * v[u][1] + v[u][2] * v[u][2] + v[u][3] * v[u][3]; }
        ss = wave_sum(ss); const float rstd = rsqrtf(ss * (1.0f / D_MODEL) + 1e-6f);
#pragma unroll
        for (int u = 0; u < 8; ++u) { const f32x4 ww = *(const f32x4*)(w + (u * 64 + lane) * 4); f32x4 y; for (int e = 0; e < 4; ++e) y[e] = v[u][e] * rstd * ww[e];
            if (OUTF32) *(f32x4*)((float*)outp + (size_t)row * D_MODEL + (u * 64 + lane) * 4) = y;
            else { u32x2 pk; pk.x = pk2(y[0], y[1]); pk.y = pk2(y[2], y[3]); *(u32x2*)((bf16_t*)outp + (size_t)row * D_MODEL + (u * 64 + lane) * 4) = pk; } }
    }
}

DEVI void phase_xb(const float* __restrict__ x, bf16_t* xb, float* rstd, int tid) {
    const int lane = tid & 63, wave = __builtin_amdgcn_readfirstlane(tid >> 6), G = vgrid();
    for (int rb = vblock(); rb < MTOK / 4; rb += G) {
        const int row = rb * 4 + wave; const float* xr = x + (size_t)row * D_MODEL;
        f32x4 v[8]; float ss = 0.f;
#pragma unroll
        for (int u = 0; u < 8; ++u) { v[u] = *(const f32x4*)(xr + (u * 64 + lane) * 4); ss += v[u][0] * v[u][0] + v[u][1] * v[u][1] + v[u][2] * v[u][2] + v[u][3] * v[u][3]; }
        ss = wave_sum(ss); if (lane == 0) rstd[row] = rsqrtf(ss * (1.0f / D_MODEL) + 1e-6f);
#pragma unroll
        for (int u = 0; u < 8; ++u) { u32x2 pk; pk.x = pk2(v[u][0], v[u][1]); pk.y = pk2(v[u][2], v[u][3]); *(u32x2*)(xb + (size_t)row * D_MODEL + (u * 64 + lane) * 4) = pk; }
    }
}
DEVI void phase_rstd(const float* __restrict__ ssp, float* rstd, int tid) {
    const int G = vgrid();
    for (int row = vblock() * GTHREADS + tid; row < MTOK; row += G * GTHREADS) {
        const f32x4* p = (const f32x4*)(ssp + (size_t)row * 32); float s = 0.f;
#pragma unroll
        for (int u = 0; u < 8; ++u) { const f32x4 a = p[u]; s += (a[0] + a[1]) + (a[2] + a[3]); }
        rstd[row] = rsqrtf(s * (1.0f / D_MODEL) + 1e-6f);
    }
}

DEVI void phase_norms(bf16_t* z, const float* __restrict__ qn, const float* __restrict__ kvn, const float* cosT, const float* sinT, int tid) {
    const int lane = tid & 63, wave = __builtin_amdgcn_readfirstlane(tid >> 6), G = vgrid();
    for (int rb = vblock(); rb < MTOK / 4; rb += G) {
        const int row = rb * 4 + wave; bf16_t* zr = z + (size_t)row * LDZO;
        u32x4 c[3]; float ss = 0.f;
#pragma unroll
        for (int u = 0; u < 3; ++u) { c[u] = *(const u32x4*)(zr + OC_CQ + (u * 64 + lane) * 8);
#pragma unroll
            for (int e = 0; e < 4; ++e) { const float a = lo2f(c[u][e]), b = hi2f(c[u][e]); ss += a * a + b * b; } }
        ss = wave_sum(ss); float rstd = rsqrtf(ss * (1.0f / 1536) + 1e-6f);
#pragma unroll
        for (int u = 0; u < 3; ++u) { const float* wp = qn + (u * 64 + lane) * 8; u32x4 o;
#pragma unroll
            for (int e = 0; e < 4; ++e) o[e] = pk2(lo2f(c[u][e]) * rstd * wp[2 * e], hi2f(c[u][e]) * rstd * wp[2 * e + 1]);
            *(u32x4*)(zr + OC_CQ + (u * 64 + lane) * 8) = o; }
        u32x4 k = *(const u32x4*)(zr + OC_CKV + lane * 8); ss = 0.f;
#pragma unroll
        for (int e = 0; e < 4; ++e) { const float a = lo2f(k[e]), b = hi2f(k[e]); ss += a * a + b * b; }
        ss = wave_sum(ss); rstd = rsqrtf(ss * (1.0f / 512) + 1e-6f);
        { const float* wp = kvn + lane * 8; u32x4 o;
#pragma unroll
            for (int e = 0; e < 4; ++e) o[e] = pk2(lo2f(k[e]) * rstd * wp[2 * e], hi2f(k[e]) * rstd * wp[2 * e + 1]);
            *(u32x4*)(zr + OC_CKV + lane * 8) = o; }
        const int t = row & (SEQ - 1), i = lane & 31;
        const float x1 = bf2f(zr[OC_KPE + i]), x2 = bf2f(zr[OC_KPE + 32 + i]); const float cs = cosT[t * 32 + i], sn = sinT[t * 32 + i];
        const float r = (lane < 32) ? (x1 * cs - x2 * sn) : (x1 * sn + x2 * cs);
        zr[OC_KPE + lane] = (bf16_t)(pk2(r, r) & 0xffff);
    }
}

DEVI void phase_cmp2(const Params& P, int layer_i, LDSA char* lds, int tid) {
    unsigned char* ws = P.ws; const int G = vgrid(); LDSA float* S = (LDSA float*)lds;
    const float* part = (const float*)(ws + WS_CMPP); const float* posp = (const float*)(ws + WS_POSP);
    for (int it = vblock(); it < 128; it += G) {
        const int kv = it >> 6, r0 = (it & 63) * 16, lkv = layer_i * 2 + kv;
#pragma unroll
        for (int u = 0; u < 8; ++u) { const int e = tid + 256 * u, r = e >> 7, j = e & 127; float s = 0.f;
            for (int sp = 0; sp < 8; ++sp) s += part[((size_t)(kv * 8 + sp) * 1024 + r0 + r) * 128 + j] + posp[(lkv * 8 + sp) * 128 + j];
            S[e] = siluf_(s); }
        __syncthreads();
        const int j = tid & 127, rh = tid >> 7; const float* w2 = P.cmp_w2 + (size_t)lkv * 128 * 128; float acc[8];
#pragma unroll
        for (int r = 0; r < 8; ++r) acc[r] = 0.f;
        for (int k = 0; k < 128; ++k) { const float w = w2[k * 128 + j];
#pragma unroll
            for (int r = 0; r < 8; ++r) acc[r] += S[(rh * 8 + r) * 128 + k] * w; }
        bf16_t* dst = (bf16_t*)(ws + (kv ? WS_VCMP : WS_KCMP));
#pragma unroll
        for (int r = 0; r < 8; ++r) dst[(size_t)(r0 + rh * 8 + r) * 128 + j] = (bf16_t)(pk2(acc[r], acc[r]) & 0xffff);
        __syncthreads();
    }
}

DEVI void item_win(const Params& P, LDSA char* lds, int tid, int item) {
    const bf16_t* z = (const bf16_t*)(P.ws + WS_R1); bf16_t* owin = (bf16_t*)(P.ws + WS_H) + (size_t)MTOK * 1024;
    const int g = item & 1, ch = (item >> 1) & 127, b = item >> 8, t0 = ch * 32, lane = tid & 63, wave = __builtin_amdgcn_readfirstlane(tid >> 6), n = lane & 31, hg = g * 4 + wave;
    const int kfirst = (t0 - 511 > 0 ? t0 - 511 : 0) & ~63, klast = (t0 + 31) & ~63, ntiles = (klast - kfirst) / 64 + 1;
    const bf16_t* zb = z + (size_t)b * SEQ * LDZE;
    auto tilefn = [&](int it, TileDesc& td) { const int k0 = kfirst + it * 64; td.kp = zb + (size_t)k0 * LDZE + EC_KW + g * 128; td.vp = zb + (size_t)k0 * LDZE + EC_VW + g * 128;
        td.k2p = nullptr; td.kidx0 = k0; };
    const size_t row = (size_t)b * SEQ + t0 + n;
    auto epi = [&](f32x16 (&o)[4], float l, float) { const float inv = l > 0.f ? 1.0f / l : 0.f; const int h = lane >> 5;
#pragma unroll
        for (int c = 0; c < 4; ++c)
#pragma unroll
            for (int q = 0; q < 4; ++q) { u32x2 w; w.x = pk2(o[c][4 * q] * inv, o[c][4 * q + 1] * inv); w.y = pk2(o[c][4 * q + 2] * inv, o[c][4 * q + 3] * inv);
                *(u32x2*)(owin + row * 1024 + hg * 128 + 32 * c + 8 * q + 4 * h) = w; } };
    attn_core<1>(lds, tid, zb + (size_t)(t0 + n) * LDZE + EC_QA + hg * 128, t0 + n, t0, ntiles, ntiles, LDZE, LDZE, 0, tilefn, (const float*)(P.ws + WS_BIAST) + hg * 4096, 4095, 0ull, epi);
}

DEVI void item_dil(const Params& P, LDSA char* lds, int tid, int item) {
    const bf16_t* z = (const bf16_t*)(P.ws + WS_R1); bf16_t* dout = (bf16_t*)(P.ws + WS_DIL); float* lse = (float*)(P.ws + WS_LSE);
    const int sub = (item >> 1) & 31, gh = ((item >> 6) % 6) * 2 + (item & 1), b = item / (32 * 12), g = gh >> 2, hh = gh & 3, lane = tid & 63, wave = __builtin_amdgcn_readfirstlane(tid >> 6), n = lane & 31;
    const int dd = g == 0 ? 1 : (g == 1 ? 4 : 16), cpr = 32 / dd  , r = sub / cpr, i0 = (sub % cpr) * 128;
    const int kfirst = i0 >= 128 ? i0 - 128 : 0, ntiles = (i0 + 128 - kfirst) / 64;
    const bf16_t* zb = z + ((size_t)b * SEQ + r) * LDZE;
    const int st = dd * LDZE;
    auto tilefn = [&](int it, TileDesc& td) { const int k0 = kfirst + it * 64; td.kp = zb + (size_t)k0 * st + EC_KB + gh * 128; td.vp = zb + (size_t)k0 * st + EC_VB + gh * 128;
        td.k2p = nullptr; td.kidx0 = k0; };
    const int qi = i0 + 32 * wave + n; const size_t row = (size_t)b * SEQ + r + (size_t)dd * qi;
    auto epi = [&](f32x16 (&o)[4], float l, float m) { const float inv = l > 0.f ? 1.0f / l : 0.f; const int h = lane >> 5;
        bf16_t* op = dout + ((size_t)g * MTOK + row) * 512 + hh * 128;
#pragma unroll
        for (int c = 0; c < 4; ++c)
#pragma unroll
            for (int q = 0; q < 4; ++q) { u32x2 w; w.x = pk2(o[c][4 * q] * inv, o[c][4 * q + 1] * inv); w.y = pk2(o[c][4 * q + 2] * inv, o[c][4 * q + 3] * inv);
                *(u32x2*)(op + 32 * c + 8 * q + 4 * h) = w; }
        if (h == 0) lse[((size_t)g * MTOK + row) * 4 + hh] = m + __builtin_log2f(l); };
    attn_core<2>(lds, tid, zb + (size_t)qi * st + EC_QB + gh * 128, qi, i0 + 32 * wave, ntiles, ntiles, st, st, 0, tilefn, (const float*)(P.ws + WS_BIASD) + gh * 132, 128, 0ull, epi);
}

DEVI void item_cmp1(const Params& P, int layer_i, LDSA char* lds, int tid, int item) {
    const int sp = item & 7, pm = (item >> 3) & 3, kv = item >> 5;
    AFCmp af{(const bf16_t*)(P.ws + WS_R1), kv ? EC_VC : EC_KC};
    EpiF32 ef{(float*)(P.ws + WS_CMPP) + (size_t)(kv * 8 + sp) * 1024 * 128, 128};
    gemm_tile4(lds, tid, af, (const bf16_t*)(P.ws + WS_W1 + (layer_i * 2 + kv) * SZ_W1), 8192, sp * 16, 16, pm * 256, 0, ef);
}

DEVI void item_cmpatt(const Params& P, LDSA char* lds, int tid, int item) {
    const bf16_t* z = (const bf16_t*)(P.ws + WS_R1); bf16_t* ocmp = (bf16_t*)(P.ws + WS_H);
    const int g = item & 1, ch = (item >> 1) & 127, b = item >> 8, t0 = ch * 32, lane = tid & 63, wave = __builtin_amdgcn_readfirstlane(tid >> 6), n = lane & 31, hg = g * 4 + wave;
    const bf16_t* kc = (const bf16_t*)(P.ws + WS_KCMP) + (size_t)(b * 2 + g) * 64 * 128; const bf16_t* vc = (const bf16_t*)(P.ws + WS_VCMP) + (size_t)(b * 2 + g) * 64 * 128;
    auto tilefn = [&](int, TileDesc& td) { td.kp = kc; td.vp = vc; td.k2p = nullptr; td.kidx0 = 0; };
    const size_t row = (size_t)b * SEQ + t0 + n;
    auto epi = [&](f32x16 (&o)[4], float l, float) { const float inv = l > 0.f ? 1.0f / l : 0.f; const int h = lane >> 5;
#pragma unroll
        for (int c = 0; c < 4; ++c)
#pragma unroll
            for (int q = 0; q < 4; ++q) { u32x2 w; w.x = pk2(o[c][4 * q] * inv, o[c][4 * q + 1] * inv); w.y = pk2(o[c][4 * q + 2] * inv, o[c][4 * q + 3] * inv);
                *(u32x2*)(ocmp + row * 1024 + hg * 128 + 32 * c + 8 * q + 4 * h) = w; }
        if (h == 0) ((LDSA float*)(lds + CMP_LOFF))[wave * 32 + n] = inv; };
    attn_core<4>(lds, tid, z + ((size_t)b * SEQ + t0 + n) * LDZE + EC_QA + hg * 128, t0 + n, t0, 1, 1, 128, 128, 0, tilefn, (const float*)(P.ws + WS_BIAST) + hg * 4096, 4095, 0ull, epi);
    LDSA float* pb = (LDSA float*)(lds + CMP_POFF); LDSA float* linv = (LDSA float*)(lds + CMP_LOFF); LDSA float* imp = (LDSA float*)lds;
    const int qi = tid >> 3, part = tid & 7, t = t0 + qi, cur = t >> 6;
#pragma unroll
    for (int e = 0; e < 8; ++e) { const int j = part * 8 + e; float s = 0.f;
#pragma unroll
        for (int w = 0; w < 4; ++w) s += pb[(w * 32 + qi) * CMP_PSTR + j] * linv[w * 32 + qi];
        if (j == 0 || j == cur || j == cur - 1) s = INFINITY;
        imp[qi * 64 + j] = s; }
    __syncthreads();
    unsigned long long bits = 0ull;
#pragma unroll
    for (int e = 0; e < 8; ++e) { const int j = part * 8 + e; const float vj = imp[qi * 64 + j]; int cnt = 0;
        for (int i = 0; i <= cur; ++i) { const float vi = imp[qi * 64 + i]; cnt += (vi > vj || (vi == vj && i < j)) ? 1 : 0; }
        if (j <= cur && cnt < 16) bits |= 1ull << j; }
    bits |= __shfl_xor(bits, 1); bits |= __shfl_xor(bits, 2); bits |= __shfl_xor(bits, 4);
    if (part == 0) ((unsigned long long*)(P.ws + WS_SEL))[(size_t)(b * 2 + g) * SEQ + t] = bits;
    __syncthreads();
}

DEVI void item_slc(const Params& P, LDSA char* lds, int tid, int item) {
    bf16_t* z = (bf16_t*)(P.ws + WS_R1); const bf16_t* ocmp = (const bf16_t*)(P.ws + WS_H); const bf16_t* owin = ocmp + (size_t)MTOK * 1024;
    const int g = item & 1, ch = (item >> 1) & 127, b = item >> 8, t0 = ch * 32, lane = tid & 63, wave = __builtin_amdgcn_readfirstlane(tid >> 6), n = lane & 31, hg = g * 4 + wave;
    const unsigned long long selm = ((const unsigned long long*)(P.ws + WS_SEL))[(size_t)(b * 2 + g) * SEQ + t0 + n];
    unsigned long long U = selm;
#pragma unroll
    for (int o = 16; o >= 1; o >>= 1) U |= __shfl_xor(U, o);
    { const unsigned ulo = __builtin_amdgcn_readfirstlane((unsigned)U), uhi = __builtin_amdgcn_readfirstlane((unsigned)(U >> 32)); U = ((unsigned long long)uhi << 32) | ulo; }
    const int ntiles = __popcll(U); unsigned long long rem = U;
    LDSA int* xw = (LDSA int*)(lds - grp_() * GRP_LDS + LDS_BYTES - 64);
    if (tid == 0) xw[grp_()] = ntiles;
    __syncthreads();
    const int nsync = xw[0] > xw[1] ? xw[0] : xw[1];
    const bf16_t* zb = z + (size_t)b * SEQ * LDZE;
    auto tilefn = [&](int, TileDesc& td) { const int j = __ffsll((long long)rem) - 1; rem &= rem - 1; const int k0 = j * 64;
        td.kp = zb + (size_t)k0 * LDZE + EC_KS + g * 128; td.vp = zb + (size_t)k0 * LDZE + EC_VS + g * 128; td.k2p = nullptr; td.kidx0 = k0; };
    const size_t row = (size_t)b * SEQ + t0 + n;
    auto epi = [&](f32x16 (&o)[4], float l, float) { if (P.dry) return; const float inv = l > 0.f ? 1.0f / l : 0.f;
        const int tq = opq(tid), h = (tq >> 5) & 1, hg = g * 4 + (tq >> 6); const size_t row = (size_t)b * SEQ + t0 + (tq & 31);
        bf16_t* zr = z + row * LDZE;
        const float g0 = sigmoidf_(bf2f(zr[EC_G3 + hg * 3 + 0])), g1 = sigmoidf_(bf2f(zr[EC_G3 + hg * 3 + 1])) * inv, g2 = sigmoidf_(bf2f(zr[EC_G3 + hg * 3 + 2]));
#pragma unroll
        for (int c = 0; c < 4; ++c)
#pragma unroll
            for (int q = 0; q < 4; ++q) { const int dv = hg * 128 + 32 * c + 8 * q + 4 * h;
                const u32x2 oc = *(const u32x2*)(ocmp + row * 1024 + dv), ow = *(const u32x2*)(owin + row * 1024 + dv), gt = *(const u32x2*)(zr + EC_GATEA + dv);
                const float m0 = (g0 * lo2f(oc.x) + g1 * o[c][4 * q] + g2 * lo2f(ow.x)) * siluf_(lo2f(gt.x));
                const float m1 = (g0 * hi2f(oc.x) + g1 * o[c][4 * q + 1] + g2 * hi2f(ow.x)) * siluf_(hi2f(gt.x));
                const float m2 = (g0 * lo2f(oc.y) + g1 * o[c][4 * q + 2] + g2 * lo2f(ow.y)) * siluf_(lo2f(gt.y));
                const float m3 = (g0 * hi2f(oc.y) + g1 * o[c][4 * q + 3] + g2 * hi2f(ow.y)) * siluf_(hi2f(gt.y));
                u32x2 w; w.x = pk2(m0, m1); w.y = pk2(m2, m3); *(u32x2*)(zr + EC_GATEA + dv) = w;
                if (q & 1) { asm volatile("" ::: "memory"); __builtin_amdgcn_sched_barrier(0); } } };
    attn_core<3>(lds, tid, zb + (size_t)(t0 + n) * LDZE + EC_QA + hg * 128, t0 + n, t0, ntiles, nsync, LDZE, LDZE, 0, tilefn, (const float*)(P.ws + WS_BIAST) + hg * 4096, 4095, selm, epi);
}

DEVI void item_mixb(const Params& P, int tid, int item) {
    bf16_t* z = (bf16_t*)(P.ws + WS_R1); const bf16_t* dout = (const bf16_t*)(P.ws + WS_DIL); const float* lse = (const float*)(P.ws + WS_LSE);
    const int lane = tid & 63, wave = __builtin_amdgcn_readfirstlane(tid >> 6), hh = lane >> 4; const size_t row = (size_t)item * 4 + wave;
    const float l0 = lse[row * 4 + hh], l1 = lse[((size_t)MTOK + row) * 4 + hh], l2 = lse[((size_t)2 * MTOK + row) * 4 + hh];
    const float mx = fmaxf(l0, fmaxf(l1, l2)); float a0 = fexp2(l0 - mx), a1 = fexp2(l1 - mx), a2 = fexp2(l2 - mx); const float is = 1.0f / (a0 + a1 + a2); a0 *= is; a1 *= is; a2 *= is;
    const u32x4 o0 = *(const u32x4*)(dout + row * 512 + lane * 8), o1 = *(const u32x4*)(dout + ((size_t)MTOK + row) * 512 + lane * 8), o2 = *(const u32x4*)(dout + ((size_t)2 * MTOK + row) * 512 + lane * 8);
    const u32x4 gt = *(const u32x4*)(z + row * LDZE + EC_GATEB + lane * 8); bf16_t* gp = z + row * LDZE + EC_QB + lane * 8; u32x4 w;
#pragma unroll
    for (int e = 0; e < 4; ++e) { const float lo = (a0 * lo2f(o0[e]) + a1 * lo2f(o1[e]) + a2 * lo2f(o2[e])) * siluf_(lo2f(gt[e]));
        const float hi = (a0 * hi2f(o0[e]) + a1 * hi2f(o1[e]) + a2 * hi2f(o2[e])) * siluf_(hi2f(gt[e])); w[e] = pk2(lo, hi); }
    if (!P.dry) *(u32x4*)gp = w;
}

DEVI void item_mla(const Params& P, LDSA char* lds, int tid, int item) {
    bf16_t* z = (bf16_t*)(P.ws + WS_R1); const bf16_t* kvb = (const bf16_t*)(P.ws + WS_KV); const bf16_t* q = (const bf16_t*)(P.ws + WS_H);
    const int bh = 2 * ((item >> 3) & 63) + (item & 1), r_ = ((item >> 1) & 3) + 4 * (item >> 9), kk_ = r_ >> 2, j_ = r_ & 3;
    const int qb = 31 - ((kk_ & 1) ? 4 * kk_ + 3 - j_ : 4 * kk_ + j_), hd = bh & 15, b = bh >> 4, lane = tid & 63, wave = __builtin_amdgcn_readfirstlane(tid >> 6), n = lane & 31;
    const int q0 = qb * 128, ntiles = (q0 + 128) / 64;
    const bf16_t* kvr = kvb + (size_t)b * SEQ * 4096 + hd * 256; const bf16_t* zb = z + (size_t)b * SEQ * LDZO;
    auto tilefn = [&](int it, TileDesc& td) { const int k0 = it * 64; td.kp = kvr + (size_t)k0 * 4096; td.vp = kvr + (size_t)k0 * 4096 + 128;
        td.k2p = zb + (size_t)k0 * LDZO + OC_KPE; td.kidx0 = k0; };
    const int qi = q0 + 32 * wave + n; const size_t row = (size_t)b * SEQ + qi;
    auto epi = [&](f32x16 (&o)[4], float l, float) { if (P.dry) return; const float inv = l > 0.f ? 1.0f / l : 0.f; const int h = lane >> 5; bf16_t* gp = z + row * LDZO + OC_GATE + hd * 128;
#pragma unroll
        for (int c = 0; c < 4; ++c)
#pragma unroll
            for (int qq = 0; qq < 4; ++qq) { bf16_t* p = gp + 32 * c + 8 * qq + 4 * h; const u32x2 gt = *(const u32x2*)p; u32x2 w;
                w.x = pk2(o[c][4 * qq] * inv * siluf_(lo2f(gt.x)), o[c][4 * qq + 1] * inv * siluf_(hi2f(gt.x)));
                w.y = pk2(o[c][4 * qq + 2] * inv * siluf_(lo2f(gt.y)), o[c][4 * qq + 3] * inv * siluf_(hi2f(gt.y))); *(u32x2*)p = w; } };
    attn_core<0>(lds, tid, q + row * 3072 + hd * 192, qi, q0 + 32 * wave, ntiles, ntiles, 4096, 4096, LDZO, tilefn, (const float*)(P.ws + WS_COS), 0, 0ull, epi);
}


template <class EpiFn>
DEVI void mla_core8(LDSA char* lds, int tid, const bf16_t* qrow, int qidx, int qidx0w, int ntiles, const bf16_t* kvr  , const bf16_t* kpe  ,
                    const float* ctab, EpiFn epi) {
    constexpr int KSTR = 400, STG = 46080, NKS = 12;
    const int lane = tid & 63, n = lane & 31, h = lane >> 5;
    bf16x8 qf[NKS];
#pragma unroll
    for (int ks = 0; ks < NKS; ++ks) qf[ks] = *(const bf16x8*)(qrow + 16 * ks + 8 * h);
    {
        const float* ct = ctab + (size_t)qidx * 32 + 8 * h; const float* st = ct + 4096 * 32;
#pragma unroll
        for (int kk = 0; kk < 2; ++kk) { v4i a = __builtin_bit_cast(v4i, qf[8 + kk]), b2 = __builtin_bit_cast(v4i, qf[10 + kk]);
#pragma unroll
            for (int j = 0; j < 4; ++j) { const float c0 = ct[16 * kk + 2 * j], c1 = ct[16 * kk + 2 * j + 1], s0_ = st[16 * kk + 2 * j], s1_ = st[16 * kk + 2 * j + 1];
                const float x10 = lo2f((unsigned)a[j]), x11 = hi2f((unsigned)a[j]), x20 = lo2f((unsigned)b2[j]), x21 = hi2f((unsigned)b2[j]);
                a[j] = (int)pk2(x10 * c0 - x20 * s0_, x11 * c1 - x21 * s1_); b2[j] = (int)pk2(x10 * s0_ + x20 * c0, x11 * s1_ + x21 * c1); }
            qf[8 + kk] = __builtin_bit_cast(bf16x8, a); qf[10 + kk] = __builtin_bit_cast(bf16x8, b2); }
    }
    f32x16 o[4];
#pragma unroll
    for (int c = 0; c < 4; ++c) o[c] = zero16();
    float m = -INFINITY, l = 0.f;
    u32x4 kreg[2], k2reg, vreg[2];
    const unsigned koff = (unsigned)(tid >> 4) * 4096u + (tid & 15) * 8, k2off = (unsigned)(tid >> 3) * (unsigned)LDZO + (tid & 7) * 8;
    LDSA char* const vp0 = lds + 25600 + (4 * h + ((lane & 15) >> 2)) * ATT_VSTR + (16 * ((lane >> 4) & 1) + 4 * (lane & 3)) * 2;
#define MISSUE(it) do { const bf16_t* kp_ = kvr + (size_t)(it) * 64 * 4096; \
        _Pragma("unroll") for (int u = 0; u < 2; ++u) { kreg[u] = *(const u32x4*)(kp_ + (size_t)(32 * u) * 4096 + koff); vreg[u] = *(const u32x4*)(kp_ + 128 + (size_t)(32 * u) * 4096 + koff); } \
        k2reg = *(const u32x4*)(kpe + (size_t)(it) * 64 * LDZO + k2off); } while (0)
#define MSTORE(s) do { LDSA char* ks_ = lds + (s) * STG; \
        _Pragma("unroll") for (int u = 0; u < 2; ++u) { *(LDSA u32x4*)(ks_ + (tid >> 4) * KSTR + (tid & 15) * 16 + u * 32 * KSTR) = kreg[u]; \
            *(LDSA u32x4*)(ks_ + 25600 + (tid >> 4) * ATT_VSTR + (tid & 15) * 16 + u * 32 * ATT_VSTR) = vreg[u]; } \
        *(LDSA u32x4*)(ks_ + (tid >> 3) * KSTR + 256 + (tid & 7) * 16) = k2reg; } while (0)
    MISSUE(0); MSTORE(0);
    if (ntiles > 1) MISSUE(1);
    __syncthreads();
    for (int it = 0; it < ntiles; ++it) {
        const int kidx0 = it * 64, stg = (it & 1) * STG;
        const int dlo = qidx0w - (kidx0 + 63), dhi = qidx0w + 31 - kidx0;
        const bool skip = dhi < 0, full = dlo >= 0;
        if (!skip) {
            f32x16 s0 = zero16(), s1 = zero16();
            LDSA char* kb = lds + stg + n * KSTR + h * 16;
#pragma unroll
            for (int ks = 0; ks < NKS; ++ks) {
                const bf16x8 k0 = *(LDSA bf16x8*)(kb + ks * 32), k1 = *(LDSA bf16x8*)(kb + 32 * KSTR + ks * 32);
                s0 = mfma32(k0, qf[ks], s0); s1 = mfma32(k1, qf[ks], s1);
            }
            int dbase = qidx - kidx0 - 4 * h;
            asm volatile("" : "+v"(dbase));
            float tmax = -INFINITY;
            if (full) {
#pragma unroll
                for (int r = 0; r < 16; ++r) tmax = fmaxf(tmax, fmaxf(s0[r], s1[r]));
            } else {
#pragma unroll
                for (int mt = 0; mt < 2; ++mt)
#pragma unroll
                    for (int r = 0; r < 16; ++r) {
                        const int ko = 32 * mt + 8 * (r >> 2) + (r & 3);
                        float v = mt ? s1[r] : s0[r];
                        if (dbase - ko < 0) v = -INFINITY;
                        if (mt) s1[r] = v; else s0[r] = v;
                        tmax = fmaxf(tmax, v);
                    }
                asm volatile("" ::: "memory");
            }
            tmax = fmaxf(tmax, __shfl_xor(tmax, 32));
            const float mnew = fmaxf(m, tmax), msafe = (mnew == -INFINITY) ? 0.f : mnew;
            const float alpha = fexp2(m - msafe);
            float ps = 0.f;
#pragma unroll
            for (int r = 0; r < 16; ++r) { s0[r] = fexp2(s0[r] - msafe); ps += s0[r]; }
#pragma unroll
            for (int r = 0; r < 16; ++r) { s1[r] = fexp2(s1[r] - msafe); ps += s1[r]; }
            l = l * alpha + ps; m = mnew;
            if (__ballot(alpha != 1.0f) != 0ull) {
#pragma unroll
                for (int c = 0; c < 4; ++c)
#pragma unroll
                    for (int r = 0; r < 16; ++r) o[c][r] *= alpha;
            }
            bf16x8 pk[2][2];
#pragma unroll
            for (int j = 0; j < 2; ++j) {
                v4i a; a.x = (int)pk2(s0[8 * j], s0[8 * j + 1]); a.y = (int)pk2(s0[8 * j + 2], s0[8 * j + 3]); a.z = (int)pk2(s0[8 * j + 4], s0[8 * j + 5]); a.w = (int)pk2(s0[8 * j + 6], s0[8 * j + 7]);
                pk[0][j] = __builtin_bit_cast(bf16x8, a);
                v4i b; b.x = (int)pk2(s1[8 * j], s1[8 * j + 1]); b.y = (int)pk2(s1[8 * j + 2], s1[8 * j + 3]); b.z = (int)pk2(s1[8 * j + 4], s1[8 * j + 5]); b.w = (int)pk2(s1[8 * j + 6], s1[8 * j + 7]);
                pk[1][j] = __builtin_bit_cast(bf16x8, b);
            }
            LDSA char* const vp = vp0 + stg;
            pv_step<0>(vp, o[0], pk); pv_step<1>(vp, o[1], pk); pv_step<2>(vp, o[2], pk); pv_step<3>(vp, o[3], pk);
        }
        if (it + 1 < ntiles) MSTORE((it + 1) & 1);
        if (it + 2 < ntiles) MISSUE(it + 2);
        __syncthreads();
    }
#undef MISSUE
#undef MSTORE
    l += __shfl_xor(l, 32);
    epi(o, l, m);
}

DEVI void item_mla8(const Params& P, LDSA char* lds, int tid, int item) {
    bf16_t* z = (bf16_t*)(P.ws + WS_R1); const bf16_t* kvb = (const bf16_t*)(P.ws + WS_KV); const bf16_t* q = (const bf16_t*)(P.ws + WS_H);
    const int bh = (item >> 1) & 127, kk_ = item >> 8, j_ = item & 1, qb = 15 - ((kk_ & 1) ? 2 * kk_ + 1 - j_ : 2 * kk_ + j_), hd = bh & 15, b = bh >> 4;
    const int lane = tid & 63, wave = __builtin_amdgcn_readfirstlane(tid >> 6), n = lane & 31, q0 = qb * 256, ntiles = (q0 + 256) / 64;
    const bf16_t* kvr = kvb + (size_t)b * SEQ * 4096 + hd * 256; const bf16_t* kpe = z + (size_t)b * SEQ * LDZO + OC_KPE;
    const int qi = q0 + 32 * wave + n; const size_t row = (size_t)b * SEQ + qi;
    auto epi = [&](f32x16 (&o)[4], float l, float) { if (P.dry) return; const float inv = l > 0.f ? 1.0f / l : 0.f; const int h = lane >> 5; bf16_t* gp = z + row * LDZO + OC_GATE + hd * 128;
#pragma unroll
        for (int c = 0; c < 4; ++c)
#pragma unroll
            for (int qq = 0; qq < 4; ++qq) { bf16_t* p = gp + 32 * c + 8 * qq + 4 * h; const u32x2 gt = *(const u32x2*)p; u32x2 w;
                w.x = pk2(o[c][4 * qq] * inv * siluf_(lo2f(gt.x)), o[c][4 * qq + 1] * inv * siluf_(hi2f(gt.x)));
                w.y = pk2(o[c][4 * qq + 2] * inv * siluf_(lo2f(gt.y)), o[c][4 * qq + 3] * inv * siluf_(hi2f(gt.y))); *(u32x2*)p = w; } };
    mla_core8(lds, tid, q + row * 3072 + hd * 192, qi, q0 + 32 * wave, ntiles, kvr, kpe, (const float*)(P.ws + WS_COS), epi);
}

constexpr int N_PHASES = 28;
DEVI void run_phase(const Params& P, int ph, LDSA char* lds, int tid) {
    unsigned char* ws = P.ws; const int G = vgrid(), v = vblock();
    bf16_t* hbuf = (bf16_t*)(ws + WS_H); bf16_t* zbuf = (bf16_t*)(ws + WS_R1);
    if (ph == 0) { phase_prep(P, lds, opq(tid)); phase_xb(P.x, hbuf, (float*)(ws + WS_RSTD), opq(tid)); return; }
    if (ph == 27) { phase_rms<true>(P.out, P.final_norm_w, P.out, opq(tid)); return; }
    int layer, sub; { const int q = ph - 1; if (q < 7) { layer = 0; sub = q; } else if (q < 13) { layer = 1; sub = q - 7; } else if (q < 20) { layer = 2; sub = q - 13; } else { layer = 3; sub = q - 20; } }
    const int li = layer >> 1; const float* xin = (layer == 0) ? P.x : P.out;
#ifdef DBG_LAYERS
    if (!((DBG_LAYERS >> layer) & 1)) {
        if (layer == 0 && sub == 6) { for (size_t i = (size_t)blockIdx.x * NTHREADS + tid; i < (size_t)MTOK * D_MODEL / 4; i += (size_t)G * NTHREADS) ((f32x4*)P.out)[i] = ((const f32x4*)P.x)[i]; }
        return;
    }
#endif
#ifdef DBG_SKIP_SUB
    if ((DBG_SKIP_SUB >> sub) & 1) return;
#endif
    if (sub == 0) { if (layer != 0) phase_rstd((const float*)(ws + WS_SSP), (float*)(ws + WS_RSTD), opq(tid)); return; }
    if ((layer & 1) == 0) {
        if (sub == 1) {
            pg8::run(lds - grp_() * GRP_LDS, hbuf, 2048, (const bf16_t*)(ws + WS_WEVIN + li * SZ_WEVIN), MTOK, LDZE, 2048, pg8::PEpiBf16S{zbuf, LDZE, (const float*)(ws + WS_RSTD)}); return; }
        if (sub == 2) { const int nwin = 2048, ndil = 3072, ncmp = 64, nt = nwin + ndil + ncmp;
            (void)nt;
            if (G == 512) {
                const int kmax = v < 64 ? 4 : 6;
                for (int k = 0; k < kmax; ++k) item_dil(P, lds, opq(tid), v + 512 * k);
                if (v >= 64 && v < 192) { const int i = v - 64; item_dil(P, lds, opq(tid), i < 64 ? i + 2048 : i - 64 + 2560); }
            } else
            for (int it = v; it < ndil; it += G) item_dil(P, lds, opq(tid), it);
            (void)nwin;
            { int t_ = tid; asm volatile("" : "+v"(t_)); for (int it = v; it < ncmp; it += G) item_cmp1(P, li, lds, t_, it); }
            return; }
        if (sub == 3) { phase_cmp2(P, li, lds, opq(tid)); return; }
        if (sub == 4) return;
        if (sub == 5) {
            for (int it = v; it < 2048; it += G) { const int item = it ^ (((it >> 9) & 1) ? 0 : 254);
                item_cmpatt(P, lds, opq(tid), item); item_win(P, lds, opq(tid), item); item_slc(P, lds, opq(tid), item); }
            { int t_ = tid; asm volatile("" : "+v"(t_)); for (int it = v; it < MTOK / 4; it += G) item_mixb(P, t_, it); }
            return; }
        if (sub == 6) { pg8::run(lds - grp_() * GRP_LDS, zbuf + EC_GATEA, LDZE, (const bf16_t*)(ws + WS_WEVOUT + li * SZ_WEVOUT), MTOK, 2048, 1536, pg8::PEpiResidX{xin, P.out, hbuf, (float*)(ws + WS_SSP)}); return; }
    } else {
        if (sub == 1) { pg8::run(lds - grp_() * GRP_LDS, hbuf, 2048, (const bf16_t*)(ws + WS_WODIN + li * SZ_WODIN), MTOK, LDZO, 2048, pg8::PEpiBf16S{zbuf, LDZO, (const float*)(ws + WS_RSTD)}); return; }
        if (sub == 2) { phase_norms(zbuf, P.q_norm + li * 1536, P.kv_norm + li * 512, (const float*)(ws + WS_COS), (const float*)(ws + WS_SIN), opq(tid)); return; }
        if (sub == 3) {
            pg8::run(lds - grp_() * GRP_LDS, zbuf + OC_CQ, LDZO, (const bf16_t*)(ws + WS_WQB + li * SZ_WQB), MTOK, 3072, 1536, pg8::PEpiBf16{hbuf, 3072});
            pg8::run(lds - grp_() * GRP_LDS, zbuf + OC_CKV, LDZO, (const bf16_t*)(ws + WS_WKVB + li * SZ_WKVB), MTOK, 4096, 512, pg8::PEpiBf16{(bf16_t*)(ws + WS_KV), 4096}); return; }
        if (sub == 4) { for (int it = pblock(); it < 2048; it += (int)gridDim.x) item_mla8(P, lds - grp_() * GRP_LDS, opq((int)threadIdx.x), it); return; }
        if (sub == 5) { pg8::run(lds - grp_() * GRP_LDS, zbuf + OC_GATE, LDZO, (const bf16_t*)(ws + WS_WODOUT + li * SZ_WODOUT), MTOK, 2048, 2048, pg8::PEpiResidX{xin, P.out, hbuf, (float*)(ws + WS_SSP)}); return; }
    }
}

DEVI void grid_barrier(unsigned* bar, unsigned gen) {
    __syncthreads();
    if (threadIdx.x == 0) {
        const unsigned G = gridDim.x, x = blockIdx.x & 7u;
        unsigned* gcnt = bar + 32 * 8;
        __builtin_amdgcn_fence(__ATOMIC_RELEASE, "agent");
        if ((G & 7u) == 0u) {
            if (__hip_atomic_fetch_add(bar + 32 * x, 1u, __ATOMIC_ACQ_REL, __HIP_MEMORY_SCOPE_AGENT) + 1u == gen * (G >> 3)) {
                if (__hip_atomic_fetch_add(gcnt, 1u, __ATOMIC_ACQ_REL, __HIP_MEMORY_SCOPE_AGENT) + 1u == gen * 8u) {
#pragma unroll
                    for (int i = 0; i < 8; ++i) __hip_atomic_store(bar + 32 * (9 + i), gen, __ATOMIC_RELEASE, __HIP_MEMORY_SCOPE_AGENT);
                }
            }
            while (__hip_atomic_load(bar + 32 * (9 + x), __ATOMIC_RELAXED, __HIP_MEMORY_SCOPE_AGENT) < gen) __builtin_amdgcn_s_sleep(1);
        } else {
            __hip_atomic_fetch_add(gcnt, 1u, __ATOMIC_RELAXED, __HIP_MEMORY_SCOPE_AGENT);
            while (__hip_atomic_load(gcnt, __ATOMIC_RELAXED, __HIP_MEMORY_SCOPE_AGENT) < gen * G) __builtin_amdgcn_s_sleep(2);
        }
        __builtin_amdgcn_fence(__ATOMIC_ACQUIRE, "agent");
    }
    __syncthreads();
}

__global__ void __launch_bounds__(NTHREADS, 2) fwd_kernel(Params P) {
    extern __shared__ __attribute__((aligned(16))) unsigned char smem[];
    LDSA char* lds = (LDSA char*)smem;
    const int tid = threadIdx.x & (GTHREADS - 1);
    lds += grp_() * GRP_LDS;
    unsigned bar_gen = 0;
    for (int ph = P.ph_lo; ph < P.ph_hi; ++ph) {
        if (ph == 1 || ph == 5 || ph == 18) continue;
        if (ph > P.ph_lo) {
            if (P.ph_lo < 0) cg::this_grid().sync();
            grid_barrier((unsigned*)(P.ws + WS_BAR), ++bar_gen);
        }
        int tid_ = tid; asm volatile("" : "+v"(tid_));
        Params Q = P; { size_t z0 = 0, z1 = 0; asm volatile("" : "+s"(z0), "+s"(z1)); Q.ws = P.ws + z0; Q.out = P.out + z1; }
#ifdef DBG_DRY_PH
        if (ph == DBG_DRY_PH) { Params Q2 = Q; Q2.dry = 1; int t3_ = tid; asm volatile("" : "+v"(t3_)); run_phase(Q2, ph, lds, t3_); __syncthreads(); }
#endif
        run_phase(Q, ph, lds, tid_);
#ifdef DBG_REPEAT_PH
        if (ph == DBG_REPEAT_PH) { __syncthreads(); int t2_ = tid; asm volatile("" : "+v"(t2_)); run_phase(Q, ph, lds, t2_); }
#endif
    }
}

extern "C" void kernel_launch(void* const* d_in, const int* in_sizes, int n_in, void* d_out, int out_size, void* d_ws, size_t ws_size, hipStream_t stream) {
    static int grid = 0;
    if (grid == 0) {
        if (n_in != 15 || ws_size < WS_END) { fprintf(stderr, "kernel_launch: need 15 inputs and %zu bytes of workspace (got %d, %zu)\n", (size_t)WS_END, n_in, ws_size); grid = -1; return; }
        int dev = 0, cus = 0, per_cu = 0;
        hipGetDevice(&dev); hipDeviceGetAttribute(&cus, hipDeviceAttributeMultiprocessorCount, dev);
        if (hipFuncSetAttribute((const void*)fwd_kernel, hipFuncAttributeMaxDynamicSharedMemorySize, LDS_BYTES) != hipSuccess) { fprintf(stderr, "hipFuncSetAttribute failed\n"); grid = -1; return; }
        if (hipOccupancyMaxActiveBlocksPerMultiprocessor(&per_cu, (const void*)fwd_kernel, NTHREADS, LDS_BYTES) != hipSuccess || per_cu < 1) { fprintf(stderr, "occupancy query failed (%d)\n", per_cu); per_cu = 1; }
        if (per_cu > 1) per_cu = 1;
        grid = cus * per_cu;
        fprintf(stderr, "kernel_launch: grid %d (%d CUs x %d)\n", grid, cus, per_cu);
    }
    if (grid < 0) return;
    Params p{};
    p.x = (const float*)d_in[0]; p.rel_bias = (const float*)d_in[1]; p.norm_w = (const float*)d_in[2]; p.final_norm_w = (const float*)d_in[3]; p.ev_w_in = (const float*)d_in[4];
    p.cmp_pos = (const float*)d_in[5]; p.cmp_w1 = (const float*)d_in[6]; p.cmp_w2 = (const float*)d_in[7]; p.ev_w_out = (const float*)d_in[8]; p.od_w_in = (const float*)d_in[9];
    p.q_norm = (const float*)d_in[10]; p.w_qb = (const float*)d_in[11]; p.kv_norm = (const float*)d_in[12]; p.w_kvb = (const float*)d_in[13]; p.od_w_out = (const float*)d_in[14];
    p.out = (float*)d_out; p.ws = (unsigned char*)d_ws;
#if ONE_LAUNCH
    p.ph_lo = 0; p.ph_hi = N_PHASES;
    if (hipMemsetAsync((char*)d_ws + WS_BAR, 0, 4096, stream) != hipSuccess) { fprintf(stderr, "memset failed\n"); return; }
    void* args[] = {&p};
    hipError_t e = hipLaunchCooperativeKernel((const void*)fwd_kernel, dim3(grid), dim3(NTHREADS), args, LDS_BYTES, stream);
    if (e != hipSuccess) fprintf(stderr, "cooperative launch failed: %s (grid %d)\n", hipGetErrorString(e), grid);
#else
    for (int ph = 0; ph < N_PHASES; ++ph) { p.ph_lo = ph; p.ph_hi = ph + 1; hipLaunchKernelGGL(fwd_kernel, dim3(grid), dim3(NTHREADS), LDS_BYTES, stream, p); }
#endif
}
```

```cpp
#include <hip/hip_runtime.h>
#include <hip/hip_cooperative_groups.h>
#include <cstdio>
#include <cstdint>
namespace cg = cooperative_groups;


#ifndef ONE_LAUNCH
#define ONE_LAUNCH 1
#endif

typedef unsigned short bf16_t;
typedef short bf16x8 __attribute__((ext_vector_type(8)));
typedef float f32x16 __attribute__((ext_vector_type(16)));
typedef float f32x4 __attribute__((ext_vector_type(4)));
typedef unsigned u32x4 __attribute__((ext_vector_type(4)));
typedef unsigned u32x2 __attribute__((ext_vector_type(2)));
typedef int v2i __attribute__((ext_vector_type(2)));
typedef int v4i __attribute__((ext_vector_type(4)));
#define LDSA __attribute__((address_space(3)))
#define DEVI __device__ __forceinline__

constexpr int D_MODEL = 2048, BATCH = 8, SEQ = 4096, MTOK = BATCH * SEQ;
constexpr int LDZE = 8960;
constexpr int LDZO = 4352;
constexpr int EC_QA = 0, EC_KC = 1024, EC_VC = 1280, EC_KS = 1536, EC_VS = 1792, EC_KW = 2048, EC_VW = 2304, EC_GATEA = 2560,
              EC_QB = 3584, EC_KB = 5120, EC_VB = 6656, EC_GATEB = 8192, EC_G3 = 8704;
constexpr int OC_CQ = 0, OC_CKV = 1536, OC_GATE = 2048, OC_KPE = 4096;
constexpr float LOG2E = 1.4426950408889634f;
constexpr float NSA_SCALE2 = 0.08838834764831845f * LOG2E;
constexpr float MLA_SCALE2 = 0.07216878364870323f * LOG2E;
constexpr int GRP_LDS = 73728, LDS_BYTES = 2 * GRP_LDS;
constexpr int NTHREADS = 512, GTHREADS = 256;

constexpr size_t MB = 1024 * 1024;
constexpr size_t WS_BIAST = 0;
constexpr size_t WS_BIASD = WS_BIAST + 20 * 4096 * 4;
constexpr size_t WS_COS = 512 * 1024;
constexpr size_t WS_SIN = WS_COS + 512 * 1024;
constexpr size_t WS_POSP = WS_SIN + 512 * 1024;
constexpr size_t WS_BAR = 1920 * 1024;
constexpr size_t WS_KCMP = 2 * MB;
constexpr size_t WS_VCMP = WS_KCMP + 256 * 1024;
constexpr size_t WS_SEL = 3 * MB;
constexpr size_t WS_LSE = 4 * MB;
constexpr size_t WS_CMPP = 6 * MB;
constexpr size_t WS_RSTD = 14 * MB;
constexpr size_t WS_W = 16 * MB;
constexpr size_t SZ_WEVIN = (size_t)LDZE * 2048 * 2, SZ_WEVOUT = (size_t)2048 * 1536 * 2, SZ_WODIN = (size_t)LDZO * 2048 * 2,
                 SZ_WQB = (size_t)3072 * 1536 * 2, SZ_WKVB = (size_t)4096 * 512 * 2, SZ_WODOUT = (size_t)2048 * 2048 * 2, SZ_W1 = (size_t)128 * 8192 * 2;
constexpr size_t WS_WEVIN = WS_W, WS_WEVOUT = WS_WEVIN + 2 * SZ_WEVIN, WS_WODIN = WS_WEVOUT + 2 * SZ_WEVOUT, WS_WQB = WS_WODIN + 2 * SZ_WODIN,
                 WS_WKVB = WS_WQB + 2 * SZ_WQB, WS_WODOUT = WS_WKVB + 2 * SZ_WKVB, WS_W1 = WS_WODOUT + 2 * SZ_WODOUT, WS_WEND = WS_W1 + 4 * SZ_W1;
constexpr size_t WS_R1 = (WS_WEND + 4095) & ~(size_t)4095;
constexpr size_t SZ_R1 = (size_t)MTOK * LDZE * 2;
constexpr size_t WS_KV = WS_R1 + (size_t)MTOK * LDZO * 2;
constexpr size_t WS_H = WS_R1 + SZ_R1;
constexpr size_t WS_DIL = WS_H + (size_t)MTOK * 2048 * 2;
constexpr size_t WS_SSP = WS_DIL + (size_t)3 * MTOK * 512 * 2;
constexpr size_t WS_END = WS_SSP + (size_t)MTOK * 32 * 4;

struct Params {
    const float* x; const float* rel_bias; const float* norm_w; const float* final_norm_w; const float* ev_w_in; const float* cmp_pos;
    const float* cmp_w1; const float* cmp_w2; const float* ev_w_out; const float* od_w_in; const float* q_norm; const float* w_qb;
    const float* kv_norm; const float* w_kvb; const float* od_w_out;
    float* out; unsigned char* ws; int ph_lo, ph_hi; int dry, pad_;
};

DEVI float bf2f(bf16_t h) { return __uint_as_float((unsigned)h << 16); }
typedef __bf16 bf16v2_ __attribute__((ext_vector_type(2)));
typedef float f32v2_ __attribute__((ext_vector_type(2)));
DEVI unsigned pk2(float lo, float hi) { const f32v2_ v = {lo, hi}; return __builtin_bit_cast(unsigned, __builtin_convertvector(v, bf16v2_)); }
DEVI unsigned bfr_(float f) { const unsigned u = __float_as_uint(f); return (u + 0x7fffu + ((u >> 16) & 1u)) >> 16; }
DEVI unsigned pk2s(float lo, float hi) { return pk2(lo, hi); }
DEVI float lo2f(unsigned u) { return __uint_as_float(u << 16); }
DEVI float hi2f(unsigned u) { return __uint_as_float(u & 0xffff0000u); }
DEVI float fexp2(float x) { return __builtin_amdgcn_exp2f(x); }
DEVI float sigmoidf_(float x) { return 1.0f / (1.0f + __expf(-x)); }
DEVI float siluf_(float x) { return x / (1.0f + __expf(-x)); }
DEVI float wave_sum(float v) {
#pragma unroll
    for (int o = 32; o >= 1; o >>= 1) v += __shfl_xor(v, o);
    return v;
}
DEVI int pblock() { const int G = gridDim.x, b = blockIdx.x; return (G % 8 == 0) ? (b % 8) * (G / 8) + b / 8 : b; }
DEVI int grp_() { return __builtin_amdgcn_readfirstlane((int)(threadIdx.x >> 8)); }
DEVI int vgrid() { return (int)gridDim.x * 2; }
DEVI int vblock() { return pblock() * 2 + grp_(); }
template <int OFF> DEVI v2i trr(unsigned a) { v2i r; asm volatile("ds_read_b64_tr_b16 %0, %1 offset:%2" : "=v"(r) : "v"(a), "n"(OFF)); return r; }
DEVI f32x16 mfma32(bf16x8 a, bf16x8 b, f32x16 c) { return __builtin_amdgcn_mfma_f32_32x32x16_bf16(a, b, c, 0, 0, 0); }
DEVI int opq(int t) { asm volatile("" : "+v"(t)); return t; }
DEVI int opqs(int t) { asm volatile("" : "+s"(t)); return t; }
DEVI f32x16 zero16() { f32x16 z; for (int i = 0; i < 16; ++i) z[i] = 0.f; return z; }

template <int DM = 0, class AF, class EF>
DEVI void gemm_tile4(LDSA char* lds, int tid, AF af, const bf16_t* __restrict__ Bt, int ldb, int kt0, int nk, int row0, int col0, EF ef) {
    const int lane = tid & 63, wave = __builtin_amdgcn_readfirstlane(tid >> 6), wm = wave >> 1, wn = wave & 1, n32 = lane & 31, h = lane >> 5;
    f32x16 acc[4][2];
#pragma unroll
    for (int i = 0; i < 4; ++i)
#pragma unroll
        for (int j = 0; j < 2; ++j) acc[i][j] = zero16();
    u32x4 ra[8], rb[4];
    const int cr = tid >> 3, ckc = tid & 7;
#define GLOAD(kt) do { int cr_ = cr; asm volatile("" : "+v"(cr_));   \
        _Pragma("unroll") for (int u = 0; u < 8; ++u) ra[u] = *(const u32x4*)af(row0 + cr_ + 32 * u, (kt) * 64, ckc * 8); \
        _Pragma("unroll") for (int u = 0; u < 4; ++u) rb[u] = *(const u32x4*)(Bt + (size_t)(col0 + cr_ + 32 * u) * ldb + (kt) * 64 + ckc * 8); } while (0)
#define SSTORE() do { LDSA char* sb_ = lds + cr * 144 + ckc * 16; _Pragma("unroll") for (int u = 0; u < 8; ++u) *(LDSA u32x4*)(sb_ + u * 32 * 144) = ra[u]; \
        _Pragma("unroll") for (int u = 0; u < 4; ++u) *(LDSA u32x4*)(sb_ + 36864 + u * 32 * 144) = rb[u]; } while (0)
    GLOAD(kt0);
    LDSA char* As = lds + (wm * 128 + n32) * 144 + h * 16;
    LDSA char* Bs = lds + 36864 + (wn * 64 + n32) * 144 + h * 16;
    for (int i = 0; i < nk; ++i) {
        if (DM != 2 || i == 0) SSTORE();
        __syncthreads();
        if (DM != 2 && i + 1 < nk) GLOAD(kt0 + i + 1);
        if (DM != 1) {
#pragma unroll
            for (int ks = 0; ks < 4; ++ks) {
                const bf16x8 b0 = *(LDSA bf16x8*)(Bs + ks * 32), b1 = *(LDSA bf16x8*)(Bs + 32 * 144 + ks * 32);
#pragma unroll
                for (int ii = 0; ii < 4; ++ii) { const bf16x8 a = *(LDSA bf16x8*)(As + ii * 32 * 144 + ks * 32);
                    acc[ii][0] = mfma32(b0, a, acc[ii][0]); acc[ii][1] = mfma32(b1, a, acc[ii][1]); }
            }
        }
        __syncthreads();
    }
#undef GLOAD
#undef SSTORE
    ef(row0 + wm * 128 + n32, col0 + wn * 64 + 4 * h, acc);
}

struct AFPlain { const bf16_t* A; int lda; DEVI const bf16_t* operator()(int row, int kb, int kin) const { return A + (size_t)row * lda + kb + kin; } };
struct AFEvOut { const bf16_t* z; DEVI const bf16_t* operator()(int row, int kb, int kin) const { const int cb = kb < 1024 ? EC_GATEA + kb : EC_GATEB + (kb - 1024); return z + (size_t)row * LDZE + cb + kin; } };
struct AFCmp { const bf16_t* z; int colbase;
    DEVI const bf16_t* operator()(int R, int kb, int kin) const { const int k = kb + kin; const int b = R >> 7, g = (R >> 6) & 1, n = R & 63, l = k >> 7, d = k & 127;
        return z + (size_t)(b * SEQ + n * 64 + l) * LDZE + colbase + g * 128 + d; } };

struct EpiBf16 { bf16_t* C; int ldc;
    template <int NI> DEVI void operator()(int rbase, int cbase, f32x16 (&acc)[NI][2]) const {
#pragma unroll
        for (int i = 0; i < NI; ++i)
#pragma unroll
            for (int j = 0; j < 2; ++j)
#pragma unroll
                for (int g = 0; g < 4; ++g) { u32x2 w; w.x = pk2s(acc[i][j][4 * g], acc[i][j][4 * g + 1]); w.y = pk2s(acc[i][j][4 * g + 2], acc[i][j][4 * g + 3]);
                    *(u32x2*)(C + (size_t)(rbase + 32 * i) * ldc + cbase + 32 * j + 8 * g) = w; }
    } };
struct EpiResid { const float* xin; float* xout;
    template <int NI> DEVI void operator()(int rbase, int cbase, f32x16 (&acc)[NI][2]) const {
#pragma unroll
        for (int i = 0; i < NI; ++i)
#pragma unroll
            for (int j = 0; j < 2; ++j)
#pragma unroll
                for (int g = 0; g < 4; ++g) { const size_t off = (size_t)(rbase + 32 * i) * D_MODEL + cbase + 32 * j + 8 * g;
                    f32x4 v = *(const f32x4*)(xin + off); v[0] += acc[i][j][4 * g]; v[1] += acc[i][j][4 * g + 1]; v[2] += acc[i][j][4 * g + 2]; v[3] += acc[i][j][4 * g + 3];
                    *(f32x4*)(xout + off) = v; if (g == 3) asm volatile("" ::: "memory"); }
    } };
struct EpiProbe { float* C;
    template <int NI> DEVI void operator()(int rbase, int cbase, f32x16 (&acc)[NI][2]) const { float t = 0.f; for (int i = 0; i < NI; ++i) for (int j = 0; j < 2; ++j) for (int r = 0; r < 16; ++r) t += acc[i][j][r]; if (t == 123456.789f) C[rbase + cbase] = t; } };
struct EpiF32 { float* C; int ldc;
    template <int NI> DEVI void operator()(int rbase, int cbase, f32x16 (&acc)[NI][2]) const {
#pragma unroll
        for (int i = 0; i < NI; ++i)
#pragma unroll
            for (int j = 0; j < 2; ++j)
#pragma unroll
                for (int g = 0; g < 4; ++g) { f32x4 v; v[0] = acc[i][j][4 * g]; v[1] = acc[i][j][4 * g + 1]; v[2] = acc[i][j][4 * g + 2]; v[3] = acc[i][j][4 * g + 3];
                    *(f32x4*)(C + (size_t)(rbase + 32 * i) * ldc + cbase + 32 * j + 8 * g) = v; }
    } };
struct EpiQ { bf16_t* C; const float* cosT; const float* sinT;
    template <int NI> DEVI void operator()(int rbase, int cbase, f32x16 (&acc)[NI][2]) const {
        const int sub = (cbase & ~63) % 192;
        if (sub == 128) {
            const int hoff = cbase & 63;
#pragma unroll
            for (int i = 0; i < NI; ++i) { const int t = (rbase + 32 * i) & (SEQ - 1);
#pragma unroll
                for (int g = 0; g < 4; ++g) { const f32x4 c = *(const f32x4*)(cosT + t * 32 + hoff + 8 * g), s = *(const f32x4*)(sinT + t * 32 + hoff + 8 * g);
#pragma unroll
                    for (int e = 0; e < 4; ++e) { const float x1 = acc[i][0][4 * g + e], x2 = acc[i][1][4 * g + e];
                        acc[i][0][4 * g + e] = x1 * c[e] - x2 * s[e]; acc[i][1][4 * g + e] = x1 * s[e] + x2 * c[e]; }
                    asm volatile("" ::: "memory"); } }
        }
#pragma unroll
        for (int i = 0; i < NI; ++i)
#pragma unroll
            for (int j = 0; j < 2; ++j)
#pragma unroll
                for (int g = 0; g < 4; ++g) { u32x2 w; w.x = pk2(acc[i][j][4 * g] * MLA_SCALE2, acc[i][j][4 * g + 1] * MLA_SCALE2); w.y = pk2(acc[i][j][4 * g + 2] * MLA_SCALE2, acc[i][j][4 * g + 3] * MLA_SCALE2);
                    *(u32x2*)(C + (size_t)(rbase + 32 * i) * 3072 + cbase + 32 * j + 8 * g) = w; }
    } };

DEVI void tile_of(int L, int nM, int nN, int& pm, int& pn) { const int GM = 8, nig = GM * nN, gid = L / nig, fm = gid * GM; const int gsz = (nM - fm) < GM ? (nM - fm) : GM; pm = fm + (L % nig) % gsz; pn = (L % nig) / gsz; }

template <class AF, class EF>
DEVI void gemm_tile8(LDSA char* lds, int tid, AF af, const bf16_t* __restrict__ Bt, int ldb, int nk, int row0, int col0, EF ef) {
    const int lane = tid & 63, wave = __builtin_amdgcn_readfirstlane(tid >> 6), wm = wave >> 2, wn = wave & 3, n32 = lane & 31, h = lane >> 5;
    f32x16 acc[4][2];
#pragma unroll
    for (int i = 0; i < 4; ++i)
#pragma unroll
        for (int j = 0; j < 2; ++j) acc[i][j] = zero16();
    u32x4 ra[4], rb[4];
    const int cr = tid >> 3, ckc = tid & 7;
#define GLOAD(kt) do { int cr_ = cr; asm volatile("" : "+v"(cr_)); \
        _Pragma("unroll") for (int u = 0; u < 4; ++u) { ra[u] = *(const u32x4*)af(row0 + cr_ + 64 * u, (kt) * 64, ckc * 8); \
            rb[u] = *(const u32x4*)(Bt + (size_t)(col0 + cr_ + 64 * u) * ldb + (kt) * 64 + ckc * 8); } } while (0)
#define SSTORE(s) do { LDSA char* sb_ = lds + (s) * GRP_LDS + cr * 144 + ckc * 16; _Pragma("unroll") for (int u = 0; u < 4; ++u) { \
        *(LDSA u32x4*)(sb_ + u * 64 * 144) = ra[u]; *(LDSA u32x4*)(sb_ + 36864 + u * 64 * 144) = rb[u]; } } while (0)
    GLOAD(0); SSTORE(0);
    if (nk > 1) GLOAD(1);
    __syncthreads();
    for (int i = 0; i < nk; ++i) {
        LDSA char* As = lds + (i & 1) * GRP_LDS + (wm * 128 + n32) * 144 + h * 16;
        LDSA char* Bs = lds + (i & 1) * GRP_LDS + 36864 + (wn * 64 + n32) * 144 + h * 16;
#pragma unroll
        for (int ks = 0; ks < 4; ++ks) {
            const bf16x8 b0 = *(LDSA bf16x8*)(Bs + ks * 32), b1 = *(LDSA bf16x8*)(Bs + 32 * 144 + ks * 32);
#pragma unroll
            for (int ii = 0; ii < 4; ++ii) { const bf16x8 a = *(LDSA bf16x8*)(As + ii * 32 * 144 + ks * 32);
                acc[ii][0] = mfma32(b0, a, acc[ii][0]); acc[ii][1] = mfma32(b1, a, acc[ii][1]); }
        }
        if (i + 1 < nk) SSTORE((i + 1) & 1);
        if (i + 2 < nk) GLOAD(i + 2);
        __syncthreads();
    }
#undef GLOAD
#undef SSTORE
    ef(row0 + wm * 128 + n32, col0 + wn * 64 + 4 * h, acc);
}

template <class AF, class EF>
DEVI void gemm_phase(LDSA char* lds_phys, int tid_phys, AF af, const bf16_t* Bt, int ldb, int K, int M, int N, EF ef) {
    const int nM = M / 256, nN = N / 256, nt = nM * nN, G = gridDim.x, v = pblock();
    for (int L = v; L < nt; L += G) { int pm, pn; tile_of(L, nM, nN, pm, pn); gemm_tile8(lds_phys, tid_phys, af, Bt, ldb, K / 64, pm * 256, pn * 256, ef); }
}

namespace pg8 {
#define PG8_LAS __attribute__((address_space(3)))
typedef unsigned short bf16_t;
typedef short bf16x8 __attribute__((ext_vector_type(8)));
typedef float f32x4 __attribute__((ext_vector_type(4)));
typedef unsigned u32x4 __attribute__((ext_vector_type(4)));
constexpr int BM = 256, BK = 64, HALF = 128, HTB = HALF * BK * 2  , STAGE_BYTES = 8 * HTB, NXCD = 8, WGM = 4;

__host__ __device__ __forceinline__ int lds_byte(int r, int c) { const int st = (r >> 4) * 2 + (c >> 5), rr = r & 15, cc = c & 31, ob = rr * 64 + cc * 2; return st * 1024 + (ob ^ (((ob >> 9) & 1) << 5)); }
__host__ __device__ __forceinline__ void stage_rc(int b, int& R, int& C) { const int st = b / 1024, sb = b % 1024, swz = sb ^ (((sb >> 9) & 1) << 5); R = (st >> 1) * 16 + swz / 64; C = (st & 1) * 32 + (swz % 64) / 2; }
__host__ __device__ __forceinline__ int perm32(int rho) { const int n = rho >> 4, i = rho & 15; return 8 * (i >> 2) + 4 * n + (i & 3); }

struct Unit { int pm, pn; };
struct Gemm { const bf16_t* A; const bf16_t* Bt; int M, N, K, lda; };

struct StaticOrder {
    int nM, nN, nwg, G, c;
    __host__ __device__ void init(int M, int N, int G_, int c_) { nM = M / BM; nN = N / BM; nwg = nM * nN; G = G_; c = c_; }
    __host__ __device__ bool next(int i, Unit& u) const {
        const long L = (long)i * G + c; if (L >= nwg) return false;
        int wgid = (int)L; { const int q = nwg / NXCD, r = nwg % NXCD, xcd = wgid % NXCD, off = wgid / NXCD; wgid = (xcd < r ? xcd * (q + 1) : r * (q + 1) + (xcd - r) * q) + off; }
        const int nig = WGM * nN, gid = wgid / nig, fm = gid * WGM, gsz = (nM - fm) < WGM ? (nM - fm) : WGM;
        u.pm = fm + ((wgid % nig) % gsz); u.pn = (wgid % nig) / gsz; return true;
    }
    __device__ __forceinline__ void a_ready(const Unit&) const {}
    __device__ __forceinline__ void done(const Unit&) const {}
};
typedef float f32x4_ __attribute__((ext_vector_type(4)));
template <class Epi, class Sched, bool ALIGN_EPI = false, bool SP2 = false>
__device__ __forceinline__ void gemm_phase(PG8_LAS unsigned char* lds, const Gemm g, const Sched& S, const Epi& E) {
    const int tid = ::opq((int)threadIdx.x), wid = __builtin_amdgcn_readfirstlane(tid >> 6), lane = tid & 63, wr = wid >> 2, wc = wid & 3, fr = lane & 15, fq = lane >> 4;
    const int K = g.K, nt = K / BK;
    unsigned voffA[2], voffB[2];
#pragma unroll
    for (int i = 0; i < 2; ++i) { int R, C; stage_rc(tid * 16 + i * 8192, R, C); const int Rb = Epi::PERM ? ((R & ~31) + perm32(R & 31)) : R;
        voffA[i] = (unsigned)(R * g.lda + C) * 2u; voffB[i] = (unsigned)(Rb * K + C) * 2u; }
    const size_t kstep = (size_t)(BK * 2);
    const size_t hstepB = (size_t)HALF * K * 2, hstepA = (size_t)HALF * g.lda * 2;
    const size_t tstepB = 2 * hstepB, tstepA = 2 * hstepA;
    const unsigned ldsw = (unsigned)wid * 1024u;
    const int aoff = lds_byte(wr * 64 + fr, fq * 8), boff = lds_byte(wc * 32 + fr, fq * 8);
#define PG8_SA(b, h) (((b) * 2 + (h)) * HTB)
#define PG8_SB(b, h) ((4 + (b) * 2 + (h)) * HTB)
#define PG8_STAGE(bufoff, gbase, voff) do { _Pragma("unroll") for (int _i = 0; _i < 2; ++_i) \
        __builtin_amdgcn_global_load_lds((const unsigned*)((const char*)(gbase) + (voff)[_i]), (PG8_LAS unsigned*)(lds + (bufoff) + ldsw + _i * 8192), 16, 0, 0); } while (0)
#define PG8_LDA(dst, b, h) do { _Pragma("unroll") for (int m = 0; m < 4; ++m) _Pragma("unroll") for (int k = 0; k < 2; ++k) dst[m][k] = *(const PG8_LAS bf16x8*)(lds + PG8_SA(b, h) + aoff + m * 2048 + k * 1024); } while (0)
#define PG8_LDB(dst, b, h) do { _Pragma("unroll") for (int n = 0; n < 2; ++n) _Pragma("unroll") for (int k = 0; k < 2; ++k) dst[n][k] = *(const PG8_LAS bf16x8*)(lds + PG8_SB(b, h) + boff + n * 2048 + k * 1024); } while (0)
#define PG8_MMA(ai, bj, At, Bt) do { __builtin_amdgcn_s_setprio(1); _Pragma("unroll") for (int m = 0; m < 4; ++m) _Pragma("unroll") for (int n = 0; n < 2; ++n) _Pragma("unroll") for (int k = 0; k < 2; ++k) \
        acc[ai][bj][m][n] = __builtin_amdgcn_mfma_f32_16x16x32_bf16(Bt[n][k], At[m][k], acc[ai][bj][m][n], 0, 0, 0); __builtin_amdgcn_s_setprio(0); } while (0)
#define PG8_WAIT_V(n) asm volatile("s_waitcnt vmcnt(" #n ")" ::: "memory")
#define PG8_WAIT_L(n) asm volatile("s_waitcnt lgkmcnt(" #n ")" ::: "memory")
#define PG8_BAR __builtin_amdgcn_s_barrier()
#define PG8_SCHED __builtin_amdgcn_sched_barrier(0)
    Unit cur, nxt; int ui = 0;
    if (!S.next(0, cur)) return;
    f32x4 acc[2][2][4][2];
#pragma unroll
    for (int a = 0; a < 2; ++a)
#pragma unroll
        for (int b = 0; b < 2; ++b)
#pragma unroll
            for (int m = 0; m < 4; ++m)
#pragma unroll
                for (int n = 0; n < 2; ++n) acc[a][b][m][n] = (f32x4){0.f, 0.f, 0.f, 0.f};
    bf16x8 At[4][2], B0[2][2], B1[2][2];
    const char* cA = (const char*)g.A + (size_t)cur.pm * tstepA; const char* cB = (const char*)g.Bt + (size_t)cur.pn * tstepB;
    S.a_ready(cur);
    if constexpr (SP2) {
        PG8_STAGE(PG8_SB(0, 0), cB, voffB); PG8_STAGE(PG8_SB(0, 1), cB + hstepB, voffB); PG8_STAGE(PG8_SA(0, 0), cA, voffA); PG8_STAGE(PG8_SA(0, 1), cA + hstepA, voffA);
        if (wr == 1) PG8_BAR;
        PG8_WAIT_V(2); PG8_BAR;
        PG8_STAGE(PG8_SB(1, 0), cB + kstep, voffB); PG8_STAGE(PG8_SA(1, 0), cA + kstep, voffA); PG8_STAGE(PG8_SB(1, 1), cB + hstepB + kstep, voffB);
        PG8_WAIT_V(6); PG8_BAR;
    } else {
        PG8_STAGE(PG8_SB(0, 0), cB, voffB); PG8_STAGE(PG8_SA(0, 0), cA, voffA); PG8_STAGE(PG8_SB(0, 1), cB + hstepB, voffB); PG8_STAGE(PG8_SA(0, 1), cA + hstepA, voffA);
        if (wr == 1) PG8_BAR;
        PG8_WAIT_V(4); PG8_BAR;
        PG8_STAGE(PG8_SB(1, 0), cB + kstep, voffB); PG8_STAGE(PG8_SA(1, 0), cA + kstep, voffA); PG8_STAGE(PG8_SB(1, 1), cB + hstepB + kstep, voffB);
        PG8_WAIT_V(6); PG8_BAR;
    }
    for (;;) {
        const bool has_next = S.next(ui + 1, nxt);
        const char* nA = has_next ? (const char*)g.A + (size_t)nxt.pm * tstepA : cA; const char* nB = has_next ? (const char*)g.Bt + (size_t)nxt.pn * tstepB : cB;
        for (int t = 0; t < nt; t += 2) {
            const bool last = (t == nt - 2);
            const char* a1 = cA + (size_t)(t + 1) * kstep;
            const char* a2 = last ? nA : cA + (size_t)(t + 2) * kstep; const char* b2 = last ? nB : cB + (size_t)(t + 2) * kstep;
            const char* a3 = a2 + kstep; const char* b3 = b2 + kstep;
            if (last && has_next) S.a_ready(nxt);
            if constexpr (SP2) {
            PG8_LDB(B0, 0, 0); PG8_LDB(B1, 0, 1); PG8_SCHED; PG8_LDA(At, 0, 0); PG8_STAGE(PG8_SA(1, 1), a1 + hstepA, voffA);
            PG8_WAIT_V(8); PG8_WAIT_L(0); PG8_BAR; PG8_MMA(0, 0, At, B0); PG8_MMA(0, 1, At, B1); PG8_BAR; PG8_SCHED;
            PG8_LDA(At, 0, 1); PG8_STAGE(PG8_SB(0, 0), b2, voffB); PG8_STAGE(PG8_SB(0, 1), b2 + hstepB, voffB); PG8_STAGE(PG8_SA(0, 0), a2, voffA);
            PG8_WAIT_V(8); PG8_WAIT_L(0); PG8_BAR; PG8_MMA(1, 0, At, B0); PG8_MMA(1, 1, At, B1); PG8_BAR; PG8_SCHED;
            PG8_LDB(B0, 1, 0); PG8_LDB(B1, 1, 1); PG8_SCHED; PG8_LDA(At, 1, 0); PG8_STAGE(PG8_SA(0, 1), a2 + hstepA, voffA);
            PG8_WAIT_V(8); PG8_WAIT_L(0); PG8_BAR; PG8_MMA(0, 0, At, B0); PG8_MMA(0, 1, At, B1); PG8_BAR; PG8_SCHED;
            PG8_LDA(At, 1, 1); PG8_STAGE(PG8_SB(1, 0), b3, voffB); PG8_STAGE(PG8_SB(1, 1), b3 + hstepB, voffB); PG8_STAGE(PG8_SA(1, 0), a3, voffA);
            PG8_WAIT_V(8); PG8_WAIT_L(0); PG8_BAR; PG8_MMA(1, 0, At, B0); PG8_MMA(1, 1, At, B1); PG8_BAR; PG8_SCHED;
            } else {
            PG8_LDB(B0, 0, 0); PG8_SCHED; PG8_LDA(At, 0, 0); PG8_STAGE(PG8_SA(1, 1), a1 + hstepA, voffA);
            PG8_WAIT_L(8); PG8_BAR; PG8_WAIT_L(0); PG8_MMA(0, 0, At, B0); PG8_BAR; PG8_SCHED;
            PG8_LDB(B1, 0, 1); PG8_STAGE(PG8_SB(0, 0), b2, voffB);
            PG8_BAR; PG8_WAIT_L(0); PG8_MMA(0, 1, At, B1); PG8_BAR;
            PG8_LDA(At, 0, 1); PG8_STAGE(PG8_SA(0, 0), a2, voffA);
            PG8_BAR; PG8_WAIT_L(0); PG8_MMA(1, 0, At, B0); PG8_BAR; PG8_SCHED;
            PG8_STAGE(PG8_SB(0, 1), b2 + hstepB, voffB);
            PG8_WAIT_V(6); PG8_BAR; PG8_MMA(1, 1, At, B1); PG8_BAR;
            PG8_LDB(B0, 1, 0); PG8_SCHED; PG8_LDA(At, 1, 0); PG8_STAGE(PG8_SA(0, 1), a2 + hstepA, voffA);
            PG8_WAIT_L(8); PG8_BAR; PG8_WAIT_L(0); PG8_MMA(0, 0, At, B0); PG8_BAR; PG8_SCHED;
            PG8_LDB(B1, 1, 1); PG8_STAGE(PG8_SB(1, 0), b3, voffB);
            PG8_BAR; PG8_WAIT_L(0); PG8_MMA(0, 1, At, B1); PG8_BAR;
            PG8_LDA(At, 1, 1); PG8_STAGE(PG8_SA(1, 0), a3, voffA);
            PG8_BAR; PG8_WAIT_L(0); PG8_MMA(1, 0, At, B0); PG8_BAR; PG8_SCHED;
            PG8_STAGE(PG8_SB(1, 1), b3 + hstepB, voffB);
            PG8_WAIT_V(6); PG8_BAR; PG8_MMA(1, 1, At, B1); PG8_BAR;
            }
        }
        if constexpr (ALIGN_EPI) { if (wr == 0) PG8_BAR; }
        if constexpr (!Epi::AFTER_DRAIN) { E(acc, cur, wr, wc, fr, fq); S.done(cur); }
        if (!has_next) break;
#pragma unroll
        for (int a = 0; a < 2; ++a)
#pragma unroll
            for (int b = 0; b < 2; ++b)
#pragma unroll
                for (int m = 0; m < 4; ++m)
#pragma unroll
                    for (int n = 0; n < 2; ++n) acc[a][b][m][n] = (f32x4){0.f, 0.f, 0.f, 0.f};
        cur = nxt; cA = nA; cB = nB; ++ui;
        if constexpr (ALIGN_EPI) { if (wr == 1) PG8_BAR; }
    }
    PG8_WAIT_V(0);
    if constexpr (!ALIGN_EPI) { if (wr == 0) PG8_BAR; }
    PG8_BAR;
    if constexpr (Epi::AFTER_DRAIN) { E.fused(acc, cur, wr, wc, fr, fq, lds, wid, lane); S.done(cur); }
#undef PG8_SA
#undef PG8_SB
#undef PG8_STAGE
#undef PG8_LDA
#undef PG8_LDB
#undef PG8_MMA
#undef PG8_WAIT_V
#undef PG8_WAIT_L
#undef PG8_BAR
#undef PG8_SCHED
}
}

namespace pg8 {
struct PEpiBf16 { static constexpr bool PERM = true, AFTER_DRAIN = false; bf16_t* O; int ldc;
    __device__ __forceinline__ void operator()(const f32x4 (&acc)[2][2][4][2], const Unit& u, int wr, int wc, int fr, int fq) const {
        const int row0 = u.pm * BM + wr * 64 + fr, col0 = u.pn * BM + wc * 32 + 8 * fq;
#pragma unroll
        for (int ai = 0; ai < 2; ++ai)
#pragma unroll
            for (int m = 0; m < 4; ++m) { bf16_t* rowp = O + (size_t)(row0 + ai * HALF + m * 16) * ldc + col0;
#pragma unroll
                for (int bj = 0; bj < 2; ++bj) { const f32x4 v0 = acc[ai][bj][m][0], v1 = acc[ai][bj][m][1]; u32x4 w;
                    w.x = ::pk2s(v0[0], v0[1]); w.y = ::pk2s(v0[2], v0[3]); w.z = ::pk2s(v1[0], v1[1]); w.w = ::pk2s(v1[2], v1[3]);
                    *(u32x4*)(rowp + bj * HALF) = w; } }
    } };
struct PEpiResid { static constexpr bool PERM = false, AFTER_DRAIN = false; const float* xin; float* xout;
    __device__ __forceinline__ void operator()(const f32x4 (&acc)[2][2][4][2], const Unit& u, int wr, int wc, int fr, int fq) const {
        const int row0 = u.pm * BM + wr * 64 + fr, col0 = u.pn * BM + wc * 32 + 4 * fq;
#pragma unroll
        for (int ai = 0; ai < 2; ++ai)
#pragma unroll
            for (int m = 0; m < 4; ++m) { const size_t off = (size_t)(row0 + ai * HALF + m * 16) * D_MODEL + col0;
#pragma unroll
                for (int bj = 0; bj < 2; ++bj)
#pragma unroll
                    for (int n = 0; n < 2; ++n) { f32x4 v = *(const f32x4*)(xin + off + bj * HALF + n * 16); v += acc[ai][bj][m][n]; *(f32x4*)(xout + off + bj * HALF + n * 16) = v; }
                asm volatile("" ::: "memory"); }
    } };
struct PEpiBf16S { static constexpr bool PERM = true, AFTER_DRAIN = false; bf16_t* O; int ldc; const float* rstd;
    __device__ __forceinline__ void operator()(const f32x4 (&acc)[2][2][4][2], const Unit& u, int wr, int wc, int fr, int fq) const {
        const int row0 = u.pm * BM + wr * 64 + fr, col0 = u.pn * BM + wc * 32 + 8 * fq;
#pragma unroll
        for (int ai = 0; ai < 2; ++ai)
#pragma unroll
            for (int m = 0; m < 4; ++m) { const int row = row0 + ai * HALF + m * 16; const float rs = rstd[row]; bf16_t* rowp = O + (size_t)row * ldc + col0;
#pragma unroll
                for (int bj = 0; bj < 2; ++bj) { const f32x4 v0 = acc[ai][bj][m][0] * rs, v1 = acc[ai][bj][m][1] * rs; u32x4 w;
                    w.x = ::pk2(v0[0], v0[1]); w.y = ::pk2(v0[2], v0[3]); w.z = ::pk2(v1[0], v1[1]); w.w = ::pk2(v1[2], v1[3]);
                    *(u32x4*)(rowp + bj * HALF) = w; } }
    } };
struct PEpiResidX { static constexpr bool PERM = true, AFTER_DRAIN = false; const float* xin; float* xout; bf16_t* xb; float* ssp;
    __device__ __forceinline__ void operator()(const f32x4 (&acc)[2][2][4][2], const Unit& u, int wr, int wc, int fr, int fq) const {
        const int row0 = u.pm * BM + wr * 64 + fr, col0 = u.pn * BM + wc * 32 + 8 * fq;
#pragma unroll
        for (int ai = 0; ai < 2; ++ai)
#pragma unroll
            for (int m = 0; m < 4; ++m) { const int row = row0 + ai * HALF + m * 16; const size_t off = (size_t)row * D_MODEL + col0; float ss = 0.f;
#pragma unroll
                for (int bj = 0; bj < 2; ++bj) { f32x4 v0 = *(const f32x4*)(xin + off + bj * HALF), v1 = *(const f32x4*)(xin + off + bj * HALF + 4);
                    v0 += acc[ai][bj][m][0]; v1 += acc[ai][bj][m][1]; *(f32x4*)(xout + off + bj * HALF) = v0; *(f32x4*)(xout + off + bj * HALF + 4) = v1;
                    ss += ((v0[0] * v0[0] + v0[1] * v0[1]) + (v0[2] * v0[2] + v0[3] * v0[3])) + ((v1[0] * v1[0] + v1[1] * v1[1]) + (v1[2] * v1[2] + v1[3] * v1[3]));
                    u32x4 w; w.x = ::pk2(v0[0], v0[1]); w.y = ::pk2(v0[2], v0[3]); w.z = ::pk2(v1[0], v1[1]); w.w = ::pk2(v1[2], v1[3]); *(u32x4*)(xb + off + bj * HALF) = w; }
                ss += __shfl_xor(ss, 16); ss += __shfl_xor(ss, 32);
                if (fq == 0) ssp[(size_t)row * 32 + u.pn * 4 + wc] = ss;
                asm volatile("" ::: "memory"); }
    } };
template <class Epi> __device__ __forceinline__ void run(LDSA char* lds_phys, const bf16_t* A, int lda, const bf16_t* Bt, int M, int N, int K, const Epi& E) {
    Gemm g{A, Bt, M, N, K, lda}; StaticOrder S; S.init(M, N, (int)gridDim.x, (int)blockIdx.x);
    gemm_phase<Epi, StaticOrder, true, true>((PG8_LAS unsigned char*)lds_phys, g, S, E);
}
}

struct TileDesc { const bf16_t* kp; const bf16_t* vp; const bf16_t* k2p; int kidx0; };
constexpr int ATT_VOFF = 25600, ATT_BOFF = 46080, ATT_VSTR = 320;
constexpr int CMP_POFF = 37888, CMP_PSTR = 68, CMP_LOFF = CMP_POFF + 4 * 32 * CMP_PSTR * 4;

typedef short s16x4 __attribute__((ext_vector_type(4)));
DEVI bf16x8 vfrag(LDSA char* vp) {
    const s16x4 a = __builtin_amdgcn_ds_read_tr16_b64_v4i16((LDSA s16x4*)vp), b = __builtin_amdgcn_ds_read_tr16_b64_v4i16((LDSA s16x4*)(vp + 8 * ATT_VSTR));
    return (bf16x8){a[0], a[1], a[2], a[3], b[0], b[1], b[2], b[3]};
}
template <int C> DEVI void pv_step(LDSA char* vp, f32x16& o, const bf16x8 (&pk)[2][2]) {
    const bf16x8 f00 = vfrag(vp + 64 * C), f01 = vfrag(vp + 16 * ATT_VSTR + 64 * C), f10 = vfrag(vp + 32 * ATT_VSTR + 64 * C), f11 = vfrag(vp + 48 * ATT_VSTR + 64 * C);
    o = mfma32(f00, pk[0][0], o); o = mfma32(f01, pk[0][1], o); o = mfma32(f10, pk[1][0], o); o = mfma32(f11, pk[1][1], o);
}

template <int MODE, class TileFn, class EpiFn>
DEVI void attn_core(LDSA char* lds, int tid, const bf16_t* qrow, int qidx, int qidx0w, int ntiles, int nsync, int kst, int vst, int k2st, TileFn tilefn, const float* btab, int bmax,
                    unsigned long long selm, EpiFn epi) {
    constexpr int DQK = (MODE == 0) ? 192 : 128, KSTR = DQK * 2 + 16, KCH = DQK / 8, NKL = 64 * KCH / 256, NKS = DQK / 16;
    constexpr bool LBIAS = (MODE == 1 || MODE == 2 || MODE == 3);
    const int lane = tid & 63, wave = __builtin_amdgcn_readfirstlane(tid >> 6), n = lane & 31, h = lane >> 5;
    LDSA char* Ks = lds; LDSA char* Vs = lds + (MODE == 4 ? 17408 : ATT_VOFF); LDSA float* Bw = (LDSA float*)(lds + ATT_BOFF) + wave * 96;
    bf16x8 qf[NKS];
#pragma unroll
    for (int ks = 0; ks < NKS; ++ks) qf[ks] = *(const bf16x8*)(qrow + 16 * ks + 8 * h);
    if (MODE == 0) {
        const float* ct = btab + (size_t)qidx * 32 + 8 * h; const float* st = ct + 4096 * 32;
#pragma unroll
        for (int kk = 0; kk < 2; ++kk) { v4i a = __builtin_bit_cast(v4i, qf[8 + kk]), b2 = __builtin_bit_cast(v4i, qf[10 + kk]);
#pragma unroll
            for (int j = 0; j < 4; ++j) { const float c0 = ct[16 * kk + 2 * j], c1 = ct[16 * kk + 2 * j + 1], s0_ = st[16 * kk + 2 * j], s1_ = st[16 * kk + 2 * j + 1];
                const float x10 = lo2f((unsigned)a[j]), x11 = hi2f((unsigned)a[j]), x20 = lo2f((unsigned)b2[j]), x21 = hi2f((unsigned)b2[j]);
                a[j] = (int)pk2(x10 * c0 - x20 * s0_, x11 * c1 - x21 * s1_); b2[j] = (int)pk2(x10 * s0_ + x20 * c0, x11 * s1_ + x21 * c1); }
            qf[8 + kk] = __builtin_bit_cast(bf16x8, a); qf[10 + kk] = __builtin_bit_cast(bf16x8, b2); }
    }
    f32x16 o[4];
#pragma unroll
    for (int c = 0; c < 4; ++c) o[c] = zero16();
    float m = -INFINITY, l = 0.f;
    u32x4 kreg[4], vreg[4]; float breg0 = 0.f, breg1 = 0.f; int next_kidx0 = 0;
    LDSA char* const vp = Vs + (4 * h + ((lane & 15) >> 2)) * ATT_VSTR + (16 * ((lane >> 4) & 1) + 4 * (lane & 3)) * 2;
    const unsigned koff = (unsigned)(tid >> 4) * (unsigned)kst + (tid & 15) * 8, voff = (unsigned)(tid >> 4) * (unsigned)vst + (tid & 15) * 8;
    const unsigned k2off = (unsigned)(tid >> 3) * (unsigned)k2st + (tid & 7) * 8;
    u32x4 k2reg[2];
#define AISSUE(it) do { TileDesc td; tilefn((it), td); next_kidx0 = td.kidx0; \
        _Pragma("unroll") for (int u = 0; u < 4; ++u) kreg[u] = *(const u32x4*)(td.kp + (size_t)(16 * u) * kst + koff); \
        if (MODE == 0) { _Pragma("unroll") for (int u = 0; u < 2; ++u) k2reg[u] = *(const u32x4*)(td.k2p + (size_t)(32 * u) * k2st + k2off); } \
        _Pragma("unroll") for (int u = 0; u < 4; ++u) vreg[u] = *(const u32x4*)(td.vp + (size_t)(16 * u) * vst + voff); \
        if (LBIAS) { const int D0 = qidx0w - td.kidx0; int i0 = D0 + 31 - lane, i1 = D0 + 31 - (lane + 64); \
            breg0 = (i0 >= 0 && i0 <= bmax) ? btab[i0] : 0.f; breg1 = (lane < 32 && i1 >= 0 && i1 <= bmax) ? btab[i1] : 0.f; } } while (0)
    AISSUE(0);
    const int nloop = (MODE == 3) ? nsync : ntiles;
    for (int it = 0; it < nloop; ++it) {
        const int kidx0 = next_kidx0; const bool act = (MODE == 3) ? (it < ntiles) : true;
        __syncthreads();
        if (act) {
#pragma unroll
        for (int u = 0; u < 4; ++u) *(LDSA u32x4*)(Ks + (tid >> 4) * KSTR + (tid & 15) * 16 + u * 16 * KSTR) = kreg[u];
        if (MODE == 0) {
#pragma unroll
            for (int u = 0; u < 2; ++u) *(LDSA u32x4*)(Ks + (tid >> 3) * KSTR + 256 + (tid & 7) * 16 + u * 32 * KSTR) = k2reg[u]; }
#pragma unroll
        for (int u = 0; u < 4; ++u) *(LDSA u32x4*)(Vs + (tid >> 4) * ATT_VSTR + (tid & 15) * 16 + u * 16 * ATT_VSTR) = vreg[u];
        if (LBIAS) { Bw[lane] = breg0; if (lane < 32) Bw[lane + 64] = breg1; }
        }
        __syncthreads();
        if (it + 1 < ntiles) AISSUE(it + 1);
        __builtin_amdgcn_sched_barrier(0);
        const int dlo = qidx0w - (kidx0 + 63);
        const int dhi = qidx0w + 31 - kidx0;
        bool skip = false, full = false; bool selbit = true;
        if (MODE == 0) { skip = dhi < 0; full = dlo >= 0; }
        if (MODE == 1) { skip = dhi < 0 || dlo >= 512; full = dlo >= 0 && dhi < 512; }
        if (MODE == 2) { skip = dhi < 0 || dlo > 128; full = dlo >= 0 && dhi <= 128; }
        if (MODE == 3) { selbit = (selm >> (kidx0 >> 6)) & 1ull; skip = (__ballot(selbit) == 0ull) || dhi < 0; full = false; }
        if (MODE == 4) { skip = false; full = false; }
        if (act && !skip) {
            f32x16 s0 = zero16(), s1 = zero16();
            LDSA char* kb = Ks + n * KSTR + h * 16;
#pragma unroll
            for (int ks = 0; ks < NKS; ++ks) {
                const bf16x8 k0 = *(LDSA bf16x8*)(kb + ks * 32), k1 = *(LDSA bf16x8*)(kb + 32 * KSTR + ks * 32);
                s0 = mfma32(k0, qf[ks], s0); s1 = mfma32(k1, qf[ks], s1);
            }
            const float sc = (MODE == 0) ? 1.0f : NSA_SCALE2;
            int dbase = qidx - kidx0 - 4 * h;
            asm volatile("" : "+v"(dbase));
            float tmax = -INFINITY;
            if (MODE == 3 && dlo >= 0) {
                const float sel_off = selbit ? 0.f : -INFINITY;
#pragma unroll
                for (int mt = 0; mt < 2; ++mt)
#pragma unroll
                    for (int r = 0; r < 16; ++r) {
                        const int ko = 32 * mt + 8 * (r >> 2) + (r & 3);
                        float v = (mt ? s1[r] : s0[r]) * sc + Bw[(31 - n + 4 * h) + ko] + sel_off;
                        if (mt) s1[r] = v; else s0[r] = v;
                        tmax = fmaxf(tmax, v);
                    }
            } else
            if ((MODE == 0 || MODE == 1 || MODE == 2) && full) {
#pragma unroll
                for (int mt = 0; mt < 2; ++mt)
#pragma unroll
                    for (int r = 0; r < 16; ++r) {
                        const int ko = 32 * mt + 8 * (r >> 2) + (r & 3);
                        float v = (mt ? s1[r] : s0[r]) * sc;
                        if (LBIAS) v += Bw[(31 - n + 4 * h) + ko];
                        if (mt) s1[r] = v; else s0[r] = v;
                        tmax = fmaxf(tmax, v);
                    }
            } else {
#pragma unroll
            for (int mt = 0; mt < 2; ++mt)
#pragma unroll
                for (int r = 0; r < 16; ++r) {
                    const int ko = 32 * mt + 8 * (r >> 2) + (r & 3);
                    float v = (mt ? s1[r] : s0[r]) * sc;
                    if (LBIAS) v += Bw[(31 - n + 4 * h) + ko];
                    if (MODE == 4) { const int kidx = kidx0 + 4 * h + ko; const int nvalid = (qidx + 1) >> 6;
                        if (kidx < nvalid) v += btab[qidx - 64 * kidx - 63]; else v = -INFINITY; }
                    else if (!full) { const int dist = dbase - ko; bool ok = dist >= 0;
                        if (MODE == 1) ok = ok && dist < 512;
                        if (MODE == 2) ok = ok && dist <= 128;
                        if (MODE == 3) ok = ok && selbit;
                        if (!ok) v = -INFINITY; }
                    if (mt) s1[r] = v; else s0[r] = v;
                    tmax = fmaxf(tmax, v);
                }
                asm volatile("" ::: "memory");
            }
            tmax = fmaxf(tmax, __shfl_xor(tmax, 32));
            const float mnew = fmaxf(m, tmax), msafe = (mnew == -INFINITY) ? 0.f : mnew;
            const float alpha = fexp2(m - msafe);
            float ps = 0.f;
#pragma unroll
            for (int r = 0; r < 16; ++r) { s0[r] = fexp2(s0[r] - msafe); ps += s0[r]; }
#pragma unroll
            for (int r = 0; r < 16; ++r) { s1[r] = fexp2(s1[r] - msafe); ps += s1[r]; }
            l = l * alpha + ps; m = mnew;
            if (__ballot(alpha != 1.0f) != 0ull) {
#pragma unroll
                for (int c = 0; c < 4; ++c)
#pragma unroll
                    for (int r = 0; r < 16; ++r) o[c][r] *= alpha;
            }
            if (MODE == 4) {
                LDSA float* pb = (LDSA float*)(lds + CMP_POFF) + (wave * 32 + n) * CMP_PSTR + 4 * h;
#pragma unroll
                for (int mt = 0; mt < 2; ++mt)
#pragma unroll
                    for (int g = 0; g < 4; ++g) { f32x4 pv; for (int e = 0; e < 4; ++e) pv[e] = mt ? s1[4 * g + e] : s0[4 * g + e]; *(LDSA f32x4*)(pb + 32 * mt + 8 * g) = pv; }
            }
            bf16x8 pk[2][2];
#pragma unroll
            for (int j = 0; j < 2; ++j) {
                v4i a; a.x = (int)pk2(s0[8 * j], s0[8 * j + 1]); a.y = (int)pk2(s0[8 * j + 2], s0[8 * j + 3]); a.z = (int)pk2(s0[8 * j + 4], s0[8 * j + 5]); a.w = (int)pk2(s0[8 * j + 6], s0[8 * j + 7]);
                pk[0][j] = __builtin_bit_cast(bf16x8, a);
                v4i b; b.x = (int)pk2(s1[8 * j], s1[8 * j + 1]); b.y = (int)pk2(s1[8 * j + 2], s1[8 * j + 3]); b.z = (int)pk2(s1[8 * j + 4], s1[8 * j + 5]); b.w = (int)pk2(s1[8 * j + 6], s1[8 * j + 7]);
                pk[1][j] = __builtin_bit_cast(bf16x8, b);
            }
            pv_step<0>(vp, o[0], pk); pv_step<1>(vp, o[1], pk); pv_step<2>(vp, o[2], pk); pv_step<3>(vp, o[3], pk);
        }
    }
#undef AISSUE
    l += __shfl_xor(l, 32);
    epi(o, l, m);
    __syncthreads();
}

template <int MAP> DEVI int colmap(int n) {
    if (MAP == 1) { if (n < 2560) return n; if (n < 8704) return n + 24; if (n < 8728) return n - 8704 + 2560; return -1; }
    if (MAP == 2) { if (n < 2048) return n; if (n < 4096) return n + 64; if (n < 4160) return n - 4096 + 2048; return -1; }
    return n;
}
template <int MAP>
DEVI void transpose_job(LDSA char* lds, int tid, const float* __restrict__ src, int K, int Nsrc, bf16_t* __restrict__ dst, int Npad, float wscale = 1.0f, const float* __restrict__ kscale = nullptr) {
    LDSA float* T = (LDSA float*)lds;
    const int nKt = K / 64, nNt = Npad / 64, nt = nKt * nNt, G = vgrid();
    for (int t = vblock(); t < nt; t += G) {
        const int kt = t % nKt, ntile = t / nKt, k0 = kt * 64, n0 = ntile * 64;
        const int nl = tid & 63, sc = colmap<MAP>(n0 + nl);
#pragma unroll
        for (int u = 0; u < 16; ++u) { const int kl = (tid >> 6) + 4 * u; T[kl * 65 + nl] = (sc >= 0) ? src[(size_t)(k0 + kl) * Nsrc + sc] * (kscale ? kscale[k0 + kl] : wscale) : 0.f; }
        __syncthreads();
#pragma unroll
        for (int u = 0; u < 2; ++u) { const int c = tid + 256 * u, n2 = c >> 3, kc = c & 7; u32x4 w;
            w.x = pk2(T[(kc * 8 + 0) * 65 + n2], T[(kc * 8 + 1) * 65 + n2]); w.y = pk2(T[(kc * 8 + 2) * 65 + n2], T[(kc * 8 + 3) * 65 + n2]);
            w.z = pk2(T[(kc * 8 + 4) * 65 + n2], T[(kc * 8 + 5) * 65 + n2]); w.w = pk2(T[(kc * 8 + 6) * 65 + n2], T[(kc * 8 + 7) * 65 + n2]);
            *(u32x4*)(dst + (size_t)(n0 + n2) * K + k0 + kc * 8) = w; }
        __syncthreads();
    }
}
DEVI int t5_bucket(int d) { if (d < 16) return d; const float v = __builtin_log2f((float)d * 0.0625f) * (16.0f / 7.0f); int b = 16 + (int)v; return b > 31 ? 31 : b; }

DEVI void phase_prep(const Params& P, LDSA char* lds, int tid) {
    unsigned char* ws = P.ws;
    for (int i = 0; i < 2; ++i) {
        transpose_job<1>(lds, tid, P.ev_w_in + (size_t)i * 2048 * 8728, 2048, 8728, (bf16_t*)(ws + WS_WEVIN + i * SZ_WEVIN), LDZE, 1.0f, P.norm_w + (2 * i) * D_MODEL);
        transpose_job<0>(lds, tid, P.ev_w_out + (size_t)i * 1536 * 2048, 1536, 2048, (bf16_t*)(ws + WS_WEVOUT + i * SZ_WEVOUT), 2048);
        transpose_job<2>(lds, tid, P.od_w_in + (size_t)i * 2048 * 4160, 2048, 4160, (bf16_t*)(ws + WS_WODIN + i * SZ_WODIN), LDZO, 1.0f, P.norm_w + (2 * i + 1) * D_MODEL);
        transpose_job<0>(lds, tid, P.w_qb + (size_t)i * 1536 * 3072, 1536, 3072, (bf16_t*)(ws + WS_WQB + i * SZ_WQB), 3072, MLA_SCALE2);
        transpose_job<0>(lds, tid, P.w_kvb + (size_t)i * 512 * 4096, 512, 4096, (bf16_t*)(ws + WS_WKVB + i * SZ_WKVB), 4096);
        transpose_job<0>(lds, tid, P.od_w_out + (size_t)i * 2048 * 2048, 2048, 2048, (bf16_t*)(ws + WS_WODOUT + i * SZ_WODOUT), 2048);
        for (int kv = 0; kv < 2; ++kv)
            transpose_job<0>(lds, tid, P.cmp_w1 + (size_t)(i * 2 + kv) * 8192 * 128, 8192, 128, (bf16_t*)(ws + WS_W1 + (i * 2 + kv) * SZ_W1), 128);
    }
    const int G = vgrid(), gt = vblock() * GTHREADS + tid, GT = G * GTHREADS;
    float* biasT = (float*)(ws + WS_BIAST); float* biasD = (float*)(ws + WS_BIASD);
    for (int i = gt; i < 20 * 4096; i += GT) { const int hh = i >> 12, d = i & 4095; biasT[i] = P.rel_bias[t5_bucket(d) * 20 + hh] * LOG2E; }
    for (int i = gt; i < 12 * 132; i += GT) { const int gh = i / 132, j = i % 132, g = gh >> 2; const int dd = g == 0 ? 1 : (g == 1 ? 4 : 16);
        biasD[i] = (j <= 128) ? P.rel_bias[t5_bucket(j * dd) * 20 + 8 + gh] * LOG2E : 0.f; }
    float* cosT = (float*)(ws + WS_COS); float* sinT = (float*)(ws + WS_SIN);
    double dz; { int zz = 0; asm volatile("" : "+v"(zz)); dz = (double)zz; }
    for (int i = gt; i < 4096 * 32; i += GT) {
        const int t = i >> 5, fi = i & 31; double f = 1.0; for (int q = 0; q < fi; ++q) f *= 0.7498942093324559;
        const float ang = (float)t * (float)f; const double a = (double)ang; const double kq = __builtin_rint(a * 0.6366197723675814);
        const double r = a - kq * 1.5707963267948966, r2 = r * r;
        const double sn = r * (1.0 + r2 * ((dz - 1.0 / 6) + r2 * ((dz + 1.0 / 120) + r2 * ((dz - 1.0 / 5040) + r2 * ((dz + 1.0 / 362880) + r2 * ((dz - 1.0 / 39916800) + r2 * (dz + 1.0 / 6227020800.0)))))));
        const double cs = 1.0 + r2 * ((dz - 0.5) + r2 * ((dz + 1.0 / 24) + r2 * ((dz - 1.0 / 720) + r2 * ((dz + 1.0 / 40320) + r2 * ((dz - 1.0 / 3628800) + r2 * (dz + 1.0 / 479001600.0))))));
        const int qd = ((int)kq) & 3; double S = sn, C = cs; if (qd == 1) { S = cs; C = -sn; } else if (qd == 2) { S = -sn; C = -cs; } else if (qd == 3) { S = -cs; C = sn; }
        cosT[i] = (float)C; sinT[i] = (float)S;
    }
    float* posp = (float*)(ws + WS_POSP); LDSA float* red = (LDSA float*)lds;
    for (int it = vblock(); it < 32; it += G) {
        const int lkv = it >> 3, part = it & 7, j = tid & 127, half = tid >> 7;
        const float* pos = P.cmp_pos + (size_t)lkv * 8192; const float* w1 = P.cmp_w1 + (size_t)lkv * 8192 * 128;
        float s = 0.f; const int kb = part * 1024 + half * 512;
        for (int k = 0; k < 512; ++k) s += pos[kb + k] * w1[(size_t)(kb + k) * 128 + j];
        __syncthreads(); if (half) red[j] = s; __syncthreads(); if (!half) posp[(lkv * 8 + part) * 128 + j] = s + red[j]; __syncthreads();
    }
}

template <bool OUTF32>
DEVI void phase_rms(const float* __restrict__ x, const float* __restrict__ w, void* outp, int tid) {
    const int lane = tid & 63, wave = __builtin_amdgcn_readfirstlane(tid >> 6), G = vgrid();
    for (int rb = vblock(); rb < MTOK / 4; rb += G) {
        const int row = rb * 4 + wave; const float* xr = x + (size_t)row * D_MODEL;
        f32x4 v[8]; float ss = 0.f;
#pragma unroll
        for (int u = 0; u < 8; ++u) { v[u] = *(const f32x4*)(xr + (u * 64 + lane) * 4); ss += v[u][0] * v[u][0] + v[u][1] * v[u][1] + v[u][2] * v[u][2] + v[u][3] * v[u][3]; }
        ss = wave_sum(ss); const float rstd = rsqrtf(ss * (1.0f / D_MODEL) + 1e-6f);
#pragma unroll
        for (int u = 0; u < 8; ++u) { const f32x4 ww = *(const f32x4*)(w + (u * 64 + lane) * 4); f32x4 y; for (int e = 0; e < 4; ++e) y[e] = v[u][e] * rstd * ww[e];
            if (OUTF32) *(f32x4*)((float*)outp + (size_t)row * D_MODEL + (u * 64 + lane) * 4) = y;
            else { u32x2 pk; pk.x = pk2(y[0], y[1]); pk.y = pk2(y[2], y[3]); *(u32x2*)((bf16_t*)outp + (size_t)row * D_MODEL + (u * 64 + lane) * 4) = pk; } }
    }
}

DEVI void phase_xb(const float* __restrict__ x, bf16_t* xb, float* rstd, int tid) {
    const int lane = tid & 63, wave = __builtin_amdgcn_readfirstlane(tid >> 6), G = vgrid();
    for (int rb = vblock(); rb < MTOK / 4; rb += G) {
        const int row = rb * 4 + wave; const float* xr = x + (size_t)row * D_MODEL;
        f32x4 v[8]; float ss = 0.f;
#pragma unroll
        for (int u = 0; u < 8; ++u) { v[u] = *(const f32x4*)(xr + (u * 64 + lane) * 4); ss += v[u][0] * v[u][0] + v[u][1] * v[u][1] + v[u][2] * v[u][2] + v[u][3] * v[u][3]; }
        ss = wave_sum(ss); if (lane == 0) rstd[row] = rsqrtf(ss * (1.0f / D_MODEL) + 1e-6f);
#pragma unroll
        for (int u = 0; u < 8; ++u) { u32x2 pk; pk.x = pk2(v[u][0], v[u][1]); pk.y = pk2(v[u][2], v[u][3]); *(u32x2*)(xb + (size_t)row * D_MODEL + (u * 64 + lane) * 4) = pk; }
    }
}
DEVI void phase_rstd(const float* __restrict__ ssp, float* rstd, int tid) {
    const int G = vgrid();
    for (int row = vblock() * GTHREADS + tid; row < MTOK; row += G * GTHREADS) {
        const f32x4* p = (const f32x4*)(ssp + (size_t)row * 32); float s = 0.f;
#pragma unroll
        for (int u = 0; u < 8; ++u) { const f32x4 a = p[u]; s += (a[0] + a[1]) + (a[2] + a[3]); }
        rstd[row] = rsqrtf(s * (1.0f / D_MODEL) + 1e-6f);
    }
}

DEVI void phase_norms(bf16_t* z, const float* __restrict__ qn, const float* __restrict__ kvn, const float* cosT, const float* sinT, int tid) {
    const int lane = tid & 63, wave = __builtin_amdgcn_readfirstlane(tid >> 6), G = vgrid();
    for (int rb = vblock(); rb < MTOK / 4; rb += G) {
        const int row = rb * 4 + wave; bf16_t* zr = z + (size_t)row * LDZO;
        u32x4 c[3]; float ss = 0.f;
#pragma unroll
        for (int u = 0; u < 3; ++u) { c[u] = *(const u32x4*)(zr + OC_CQ + (u * 64 + lane) * 8);
#pragma unroll
            for (int e = 0; e < 4; ++e) { const float a = lo2f(c[u][e]), b = hi2f(c[u][e]); ss += a * a + b * b; } }
        ss = wave_sum(ss); float rstd = rsqrtf(ss * (1.0f / 1536) + 1e-6f);
#pragma unroll
        for (int u = 0; u < 3; ++u) { const float* wp = qn + (u * 64 + lane) * 8; u32x4 o;
#pragma unroll
            for (int e = 0; e < 4; ++e) o[e] = pk2(lo2f(c[u][e]) * rstd * wp[2 * e], hi2f(c[u][e]) * rstd * wp[2 * e + 1]);
            *(u32x4*)(zr + OC_CQ + (u * 64 + lane) * 8) = o; }
        u32x4 k = *(const u32x4*)(zr + OC_CKV + lane * 8); ss = 0.f;
#pragma unroll
        for (int e = 0; e < 4; ++e) { const float a = lo2f(k[e]), b = hi2f(k[e]); ss += a * a + b * b; }
        ss = wave_sum(ss); rstd = rsqrtf(ss * (1.0f / 512) + 1e-6f);
        { const float* wp = kvn + lane * 8; u32x4 o;
#pragma unroll
            for (int e = 0; e < 4; ++e) o[e] = pk2(lo2f(k[e]) * rstd * wp[2 * e], hi2f(k[e]) * rstd * wp[2 * e + 1]);
            *(u32x4*)(zr + OC_CKV + lane * 8) = o; }
        const int t = row & (SEQ - 1), i = lane & 31;
        const float x1 = bf2f(zr[OC_KPE + i]), x2 = bf2f(zr[OC_KPE + 32 + i]); const float cs = cosT[t * 32 + i], sn = sinT[t * 32 + i];
        const float r = (lane < 32) ? (x1 * cs - x2 * sn) : (x1 * sn + x2 * cs);
        zr[OC_KPE + lane] = (bf16_t)(pk2(r, r) & 0xffff);
    }
}

DEVI void phase_cmp2(const Params& P, int layer_i, LDSA char* lds, int tid) {
    unsigned char* ws = P.ws; const int G = vgrid(); LDSA float* S = (LDSA float*)lds;
    const float* part = (const float*)(ws + WS_CMPP); const float* posp = (const float*)(ws + WS_POSP);
    for (int it = vblock(); it < 128; it += G) {
        const int kv = it >> 6, r0 = (it & 63) * 16, lkv = layer_i * 2 + kv;
#pragma unroll
        for (int u = 0; u < 8; ++u) { const int e = tid + 256 * u, r = e >> 7, j = e & 127; float s = 0.f;
            for (int sp = 0; sp < 8; ++sp) s += part[((size_t)(kv * 8 + sp) * 1024 + r0 + r) * 128 + j] + posp[(lkv * 8 + sp) * 128 + j];
            S[e] = siluf_(s); }
        __syncthreads();
        const int j = tid & 127, rh = tid >> 7; const float* w2 = P.cmp_w2 + (size_t)lkv * 128 * 128; float acc[8];
#pragma unroll
        for (int r = 0; r < 8; ++r) acc[r] = 0.f;
        for (int k = 0; k < 128; ++k) { const float w = w2[k * 128 + j];
#pragma unroll
            for (int r = 0; r < 8; ++r) acc[r] += S[(rh * 8 + r) * 128 + k] * w; }
        bf16_t* dst = (bf16_t*)(ws + (kv ? WS_VCMP : WS_KCMP));
#pragma unroll
        for (int r = 0; r < 8; ++r) dst[(size_t)(r0 + rh * 8 + r) * 128 + j] = (bf16_t)(pk2(acc[r], acc[r]) & 0xffff);
        __syncthreads();
    }
}

DEVI void item_win(const Params& P, LDSA char* lds, int tid, int item) {
    const bf16_t* z = (const bf16_t*)(P.ws + WS_R1); bf16_t* owin = (bf16_t*)(P.ws + WS_H) + (size_t)MTOK * 1024;
    const int g = item & 1, ch = (item >> 1) & 127, b = item >> 8, t0 = ch * 32, lane = tid & 63, wave = __builtin_amdgcn_readfirstlane(tid >> 6), n = lane & 31, hg = g * 4 + wave;
    const int kfirst = (t0 - 511 > 0 ? t0 - 511 : 0) & ~63, klast = (t0 + 31) & ~63, ntiles = (klast - kfirst) / 64 + 1;
    const bf16_t* zb = z + (size_t)b * SEQ * LDZE;
    auto tilefn = [&](int it, TileDesc& td) { const int k0 = kfirst + it * 64; td.kp = zb + (size_t)k0 * LDZE + EC_KW + g * 128; td.vp = zb + (size_t)k0 * LDZE + EC_VW + g * 128;
        td.k2p = nullptr; td.kidx0 = k0; };
    const size_t row = (size_t)b * SEQ + t0 + n;
    auto epi = [&](f32x16 (&o)[4], float l, float) { const float inv = l > 0.f ? 1.0f / l : 0.f; const int h = lane >> 5;
#pragma unroll
        for (int c = 0; c < 4; ++c)
#pragma unroll
            for (int q = 0; q < 4; ++q) { u32x2 w; w.x = pk2(o[c][4 * q] * inv, o[c][4 * q + 1] * inv); w.y = pk2(o[c][4 * q + 2] * inv, o[c][4 * q + 3] * inv);
                *(u32x2*)(owin + row * 1024 + hg * 128 + 32 * c + 8 * q + 4 * h) = w; } };
    attn_core<1>(lds, tid, zb + (size_t)(t0 + n) * LDZE + EC_QA + hg * 128, t0 + n, t0, ntiles, ntiles, LDZE, LDZE, 0, tilefn, (const float*)(P.ws + WS_BIAST) + hg * 4096, 4095, 0ull, epi);
}

DEVI void item_dil(const Params& P, LDSA char* lds, int tid, int item) {
    const bf16_t* z = (const bf16_t*)(P.ws + WS_R1); bf16_t* dout = (bf16_t*)(P.ws + WS_DIL); float* lse = (float*)(P.ws + WS_LSE);
    const int sub = (item >> 1) & 31, gh = ((item >> 6) % 6) * 2 + (item & 1), b = item / (32 * 12), g = gh >> 2, hh = gh & 3, lane = tid & 63, wave = __builtin_amdgcn_readfirstlane(tid >> 6), n = lane & 31;
    const int dd = g == 0 ? 1 : (g == 1 ? 4 : 16), cpr = 32 / dd  , r = sub / cpr, i0 = (sub % cpr) * 128;
    const int kfirst = i0 >= 128 ? i0 - 128 : 0, ntiles = (i0 + 128 - kfirst) / 64;
    const bf16_t* zb = z + ((size_t)b * SEQ + r) * LDZE;
    const int st = dd * LDZE;
    auto tilefn = [&](int it, TileDesc& td) { const int k0 = kfirst + it * 64; td.kp = zb + (size_t)k0 * st + EC_KB + gh * 128; td.vp = zb + (size_t)k0 * st + EC_VB + gh * 128;
        td.k2p = nullptr; td.kidx0 = k0; };
    const int qi = i0 + 32 * wave + n; const size_t row = (size_t)b * SEQ + r + (size_t)dd * qi;
    auto epi = [&](f32x16 (&o)[4], float l, float m) { const float inv = l > 0.f ? 1.0f / l : 0.f; const int h = lane >> 5;
        bf16_t* op = dout + ((size_t)g * MTOK + row) * 512 + hh * 128;
#pragma unroll
        for (int c = 0; c < 4; ++c)
#pragma unroll
            for (int q = 0; q < 4; ++q) { u32x2 w; w.x = pk2(o[c][4 * q] * inv, o[c][4 * q + 1] * inv); w.y = pk2(o[c][4 * q + 2] * inv, o[c][4 * q + 3] * inv);
                *(u32x2*)(op + 32 * c + 8 * q + 4 * h) = w; }
        if (h == 0) lse[((size_t)g * MTOK + row) * 4 + hh] = m + __builtin_log2f(l); };
    attn_core<2>(lds, tid, zb + (size_t)qi * st + EC_QB + gh * 128, qi, i0 + 32 * wave, ntiles, ntiles, st, st, 0, tilefn, (const float*)(P.ws + WS_BIASD) + gh * 132, 128, 0ull, epi);
}

DEVI void item_cmp1(const Params& P, int layer_i, LDSA char* lds, int tid, int item) {
    const int sp = item & 7, pm = (item >> 3) & 3, kv = item >> 5;
    AFCmp af{(const bf16_t*)(P.ws + WS_R1), kv ? EC_VC : EC_KC};
    EpiF32 ef{(float*)(P.ws + WS_CMPP) + (size_t)(kv * 8 + sp) * 1024 * 128, 128};
    gemm_tile4(lds, tid, af, (const bf16_t*)(P.ws + WS_W1 + (layer_i * 2 + kv) * SZ_W1), 8192, sp * 16, 16, pm * 256, 0, ef);
}

DEVI void item_cmpatt(const Params& P, LDSA char* lds, int tid, int item) {
    const bf16_t* z = (const bf16_t*)(P.ws + WS_R1); bf16_t* ocmp = (bf16_t*)(P.ws + WS_H);
    const int g = item & 1, ch = (item >> 1) & 127, b = item >> 8, t0 = ch * 32, lane = tid & 63, wave = __builtin_amdgcn_readfirstlane(tid >> 6), n = lane & 31, hg = g * 4 + wave;
    const bf16_t* kc = (const bf16_t*)(P.ws + WS_KCMP) + (size_t)(b * 2 + g) * 64 * 128; const bf16_t* vc = (const bf16_t*)(P.ws + WS_VCMP) + (size_t)(b * 2 + g) * 64 * 128;
    auto tilefn = [&](int, TileDesc& td) { td.kp = kc; td.vp = vc; td.k2p = nullptr; td.kidx0 = 0; };
    const size_t row = (size_t)b * SEQ + t0 + n;
    auto epi = [&](f32x16 (&o)[4], float l, float) { const float inv = l > 0.f ? 1.0f / l : 0.f; const int h = lane >> 5;
#pragma unroll
        for (int c = 0; c < 4; ++c)
#pragma unroll
            for (int q = 0; q < 4; ++q) { u32x2 w; w.x = pk2(o[c][4 * q] * inv, o[c][4 * q + 1] * inv); w.y = pk2(o[c][4 * q + 2] * inv, o[c][4 * q + 3] * inv);
                *(u32x2*)(ocmp + row * 1024 + hg * 128 + 32 * c + 8 * q + 4 * h) = w; }
        if (h == 0) ((LDSA float*)(lds + CMP_LOFF))[wave * 32 + n] = inv; };
    attn_core<4>(lds, tid, z + ((size_t)b * SEQ + t0 + n) * LDZE + EC_QA + hg * 128, t0 + n, t0, 1, 1, 128, 128, 0, tilefn, (const float*)(P.ws + WS_BIAST) + hg * 4096, 4095, 0ull, epi);
    LDSA float* pb = (LDSA float*)(lds + CMP_POFF); LDSA float* linv = (LDSA float*)(lds + CMP_LOFF); LDSA float* imp = (LDSA float*)lds;
    const int qi = tid >> 3, part = tid & 7, t = t0 + qi, cur = t >> 6;
#pragma unroll
    for (int e = 0; e < 8; ++e) { const int j = part * 8 + e; float s = 0.f;
#pragma unroll
        for (int w = 0; w < 4; ++w) s += pb[(w * 32 + qi) * CMP_PSTR + j] * linv[w * 32 + qi];
        if (j == 0 || j == cur || j == cur - 1) s = INFINITY;
        imp[qi * 64 + j] = s; }
    __syncthreads();
    unsigned long long bits = 0ull;
#pragma unroll
    for (int e = 0; e < 8; ++e) { const int j = part * 8 + e; const float vj = imp[qi * 64 + j]; int cnt = 0;
        for (int i = 0; i <= cur; ++i) { const float vi = imp[qi * 64 + i]; cnt += (vi > vj || (vi == vj && i < j)) ? 1 : 0; }
        if (j <= cur && cnt < 16) bits |= 1ull << j; }
    bits |= __shfl_xor(bits, 1); bits |= __shfl_xor(bits, 2); bits |= __shfl_xor(bits, 4);
    if (part == 0) ((unsigned long long*)(P.ws + WS_SEL))[(size_t)(b * 2 + g) * SEQ + t] = bits;
    __syncthreads();
}

DEVI void item_slc(const Params& P, LDSA char* lds, int tid, int item) {
    bf16_t* z = (bf16_t*)(P.ws + WS_R1); const bf16_t* ocmp = (const bf16_t*)(P.ws + WS_H); const bf16_t* owin = ocmp + (size_t)MTOK * 1024;
    const int g = item & 1, ch = (item >> 1) & 127, b = item >> 8, t0 = ch * 32, lane = tid & 63, wave = __builtin_amdgcn_readfirstlane(tid >> 6), n = lane & 31, hg = g * 4 + wave;
    const unsigned long long selm = ((const unsigned long long*)(P.ws + WS_SEL))[(size_t)(b * 2 + g) * SEQ + t0 + n];
    unsigned long long U = selm;
#pragma unroll
    for (int o = 16; o >= 1; o >>= 1) U |= __shfl_xor(U, o);
    { const unsigned ulo = __builtin_amdgcn_readfirstlane((unsigned)U), uhi = __builtin_amdgcn_readfirstlane((unsigned)(U >> 32)); U = ((unsigned long long)uhi << 32) | ulo; }
    const int ntiles = __popcll(U); unsigned long long rem = U;
    LDSA int* xw = (LDSA int*)(lds - grp_() * GRP_LDS + LDS_BYTES - 64);
    if (tid == 0) xw[grp_()] = ntiles;
    __syncthreads();
    const int nsync = xw[0] > xw[1] ? xw[0] : xw[1];
    const bf16_t* zb = z + (size_t)b * SEQ * LDZE;
    auto tilefn = [&](int, TileDesc& td) { const int j = __ffsll((long long)rem) - 1; rem &= rem - 1; const int k0 = j * 64;
        td.kp = zb + (size_t)k0 * LDZE + EC_KS + g * 128; td.vp = zb + (size_t)k0 * LDZE + EC_VS + g * 128; td.k2p = nullptr; td.kidx0 = k0; };
    const size_t row = (size_t)b * SEQ + t0 + n;
    auto epi = [&](f32x16 (&o)[4], float l, float) { if (P.dry) return; const float inv = l > 0.f ? 1.0f / l : 0.f;
        const int tq = opq(tid), h = (tq >> 5) & 1, hg = g * 4 + (tq >> 6); const size_t row = (size_t)b * SEQ + t0 + (tq & 31);
        bf16_t* zr = z + row * LDZE;
        const float g0 = sigmoidf_(bf2f(zr[EC_G3 + hg * 3 + 0])), g1 = sigmoidf_(bf2f(zr[EC_G3 + hg * 3 + 1])) * inv, g2 = sigmoidf_(bf2f(zr[EC_G3 + hg * 3 + 2]));
#pragma unroll
        for (int c = 0; c < 4; ++c)
#pragma unroll
            for (int q = 0; q < 4; ++q) { const int dv = hg * 128 + 32 * c + 8 * q + 4 * h;
                const u32x2 oc = *(const u32x2*)(ocmp + row * 1024 + dv), ow = *(const u32x2*)(owin + row * 1024 + dv), gt = *(const u32x2*)(zr + EC_GATEA + dv);
                const float m0 = (g0 * lo2f(oc.x) + g1 * o[c][4 * q] + g2 * lo2f(ow.x)) * siluf_(lo2f(gt.x));
                const float m1 = (g0 * hi2f(oc.x) + g1 * o[c][4 * q + 1] + g2 * hi2f(ow.x)) * siluf_(hi2f(gt.x));
                const float m2 = (g0 * lo2f(oc.y) + g1 * o[c][4 * q + 2] + g2 * lo2f(ow.y)) * siluf_(lo2f(gt.y));
                const float m3 = (g0 * hi2f(oc.y) + g1 * o[c][4 * q + 3] + g2 * hi2f(ow.y)) * siluf_(hi2f(gt.y));
                u32x2 w; w.x = pk2(m0, m1); w.y = pk2(m2, m3); *(u32x2*)(zr + EC_GATEA + dv) = w;
                if (q & 1) { asm volatile("" ::: "memory"); __builtin_amdgcn_sched_barrier(0); } } };
    attn_core<3>(lds, tid, zb + (size_t)(t0 + n) * LDZE + EC_QA + hg * 128, t0 + n, t0, ntiles, nsync, LDZE, LDZE, 0, tilefn, (const float*)(P.ws + WS_BIAST) + hg * 4096, 4095, selm, epi);
}

DEVI void item_mixb(const Params& P, int tid, int item) {
    bf16_t* z = (bf16_t*)(P.ws + WS_R1); const bf16_t* dout = (const bf16_t*)(P.ws + WS_DIL); const float* lse = (const float*)(P.ws + WS_LSE);
    const int lane = tid & 63, wave = __builtin_amdgcn_readfirstlane(tid >> 6), hh = lane >> 4; const size_t row = (size_t)item * 4 + wave;
    const float l0 = lse[row * 4 + hh], l1 = lse[((size_t)MTOK + row) * 4 + hh], l2 = lse[((size_t)2 * MTOK + row) * 4 + hh];
    const float mx = fmaxf(l0, fmaxf(l1, l2)); float a0 = fexp2(l0 - mx), a1 = fexp2(l1 - mx), a2 = fexp2(l2 - mx); const float is = 1.0f / (a0 + a1 + a2); a0 *= is; a1 *= is; a2 *= is;
    const u32x4 o0 = *(const u32x4*)(dout + row * 512 + lane * 8), o1 = *(const u32x4*)(dout + ((size_t)MTOK + row) * 512 + lane * 8), o2 = *(const u32x4*)(dout + ((size_t)2 * MTOK + row) * 512 + lane * 8);
    const u32x4 gt = *(const u32x4*)(z + row * LDZE + EC_GATEB + lane * 8); bf16_t* gp = z + row * LDZE + EC_QB + lane * 8; u32x4 w;
#pragma unroll
    for (int e = 0; e < 4; ++e) { const float lo = (a0 * lo2f(o0[e]) + a1 * lo2f(o1[e]) + a2 * lo2f(o2[e])) * siluf_(lo2f(gt[e]));
        const float hi = (a0 * hi2f(o0[e]) + a1 * hi2f(o1[e]) + a2 * hi2f(o2[e])) * siluf_(hi2f(gt[e])); w[e] = pk2(lo, hi); }
    if (!P.dry) *(u32x4*)gp = w;
}

DEVI void item_mla(const Params& P, LDSA char* lds, int tid, int item) {
    bf16_t* z = (bf16_t*)(P.ws + WS_R1); const bf16_t* kvb = (const bf16_t*)(P.ws + WS_KV); const bf16_t* q = (const bf16_t*)(P.ws + WS_H);
    const int bh = 2 * ((item >> 3) & 63) + (item & 1), r_ = ((item >> 1) & 3) + 4 * (item >> 9), kk_ = r_ >> 2, j_ = r_ & 3;
    const int qb = 31 - ((kk_ & 1) ? 4 * kk_ + 3 - j_ : 4 * kk_ + j_), hd = bh & 15, b = bh >> 4, lane = tid & 63, wave = __builtin_amdgcn_readfirstlane(tid >> 6), n = lane & 31;
    const int q0 = qb * 128, ntiles = (q0 + 128) / 64;
    const bf16_t* kvr = kvb + (size_t)b * SEQ * 4096 + hd * 256; const bf16_t* zb = z + (size_t)b * SEQ * LDZO;
    auto tilefn = [&](int it, TileDesc& td) { const int k0 = it * 64; td.kp = kvr + (size_t)k0 * 4096; td.vp = kvr + (size_t)k0 * 4096 + 128;
        td.k2p = zb + (size_t)k0 * LDZO + OC_KPE; td.kidx0 = k0; };
    const int qi = q0 + 32 * wave + n; const size_t row = (size_t)b * SEQ + qi;
    auto epi = [&](f32x16 (&o)[4], float l, float) { if (P.dry) return; const float inv = l > 0.f ? 1.0f / l : 0.f; const int h = lane >> 5; bf16_t* gp = z + row * LDZO + OC_GATE + hd * 128;
#pragma unroll
        for (int c = 0; c < 4; ++c)
#pragma unroll
            for (int qq = 0; qq < 4; ++qq) { bf16_t* p = gp + 32 * c + 8 * qq + 4 * h; const u32x2 gt = *(const u32x2*)p; u32x2 w;
                w.x = pk2(o[c][4 * qq] * inv * siluf_(lo2f(gt.x)), o[c][4 * qq + 1] * inv * siluf_(hi2f(gt.x)));
                w.y = pk2(o[c][4 * qq + 2] * inv * siluf_(lo2f(gt.y)), o[c][4 * qq + 3] * inv * siluf_(hi2f(gt.y))); *(u32x2*)p = w; } };
    attn_core<0>(lds, tid, q + row * 3072 + hd * 192, qi, q0 + 32 * wave, ntiles, ntiles, 4096, 4096, LDZO, tilefn, (const float*)(P.ws + WS_COS), 0, 0ull, epi);
}


template <class EpiFn>
DEVI void mla_core8(LDSA char* lds, int tid, const bf16_t* qrow, int qidx, int qidx0w, int ntiles, const bf16_t* kvr  , const bf16_t* kpe  ,
                    const float* ctab, EpiFn epi) {
    constexpr int KSTR = 400, STG = 46080, NKS = 12;
    const int lane = tid & 63, n = lane & 31, h = lane >> 5;
    bf16x8 qf[NKS];
#pragma unroll
    for (int ks = 0; ks < NKS; ++ks) qf[ks] = *(const bf16x8*)(qrow + 16 * ks + 8 * h);
    {
        const float* ct = ctab + (size_t)qidx * 32 + 8 * h; const float* st = ct + 4096 * 32;
#pragma unroll
        for (int kk = 0; kk < 2; ++kk) { v4i a = __builtin_bit_cast(v4i, qf[8 + kk]), b2 = __builtin_bit_cast(v4i, qf[10 + kk]);
#pragma unroll
            for (int j = 0; j < 4; ++j) { const float c0 = ct[16 * kk + 2 * j], c1 = ct[16 * kk + 2 * j + 1], s0_ = st[16 * kk + 2 * j], s1_ = st[16 * kk + 2 * j + 1];
                const float x10 = lo2f((unsigned)a[j]), x11 = hi2f((unsigned)a[j]), x20 = lo2f((unsigned)b2[j]), x21 = hi2f((unsigned)b2[j]);
                a[j] = (int)pk2(x10 * c0 - x20 * s0_, x11 * c1 - x21 * s1_); b2[j] = (int)pk2(x10 * s0_ + x20 * c0, x11 * s1_ + x21 * c1); }
            qf[8 + kk] = __builtin_bit_cast(bf16x8, a); qf[10 + kk] = __builtin_bit_cast(bf16x8, b2); }
    }
    f32x16 o[4];
#pragma unroll
    for (int c = 0; c < 4; ++c) o[c] = zero16();
    float m = -INFINITY, l = 0.f;
    u32x4 kreg[2], k2reg, vreg[2];
    const unsigned koff = (unsigned)(tid >> 4) * 4096u + (tid & 15) * 8, k2off = (unsigned)(tid >> 3) * (unsigned)LDZO + (tid & 7) * 8;
    LDSA char* const vp0 = lds + 25600 + (4 * h + ((lane & 15) >> 2)) * ATT_VSTR + (16 * ((lane >> 4) & 1) + 4 * (lane & 3)) * 2;
#define MISSUE(it) do { const bf16_t* kp_ = kvr + (size_t)(it) * 64 * 4096; \
        _Pragma("unroll") for (int u = 0; u < 2; ++u) { kreg[u] = *(const u32x4*)(kp_ + (size_t)(32 * u) * 4096 + koff); vreg[u] = *(const u32x4*)(kp_ + 128 + (size_t)(32 * u) * 4096 + koff); } \
        k2reg = *(const u32x4*)(kpe + (size_t)(it) * 64 * LDZO + k2off); } while (0)
#define MSTORE(s) do { LDSA char* ks_ = lds + (s) * STG; \
        _Pragma("unroll") for (int u = 0; u < 2; ++u) { *(LDSA u32x4*)(ks_ + (tid >> 4) * KSTR + (tid & 15) * 16 + u * 32 * KSTR) = kreg[u]; \
            *(LDSA u32x4*)(ks_ + 25600 + (tid >> 4) * ATT_VSTR + (tid & 15) * 16 + u * 32 * ATT_VSTR) = vreg[u]; } \
        *(LDSA u32x4*)(ks_ + (tid >> 3) * KSTR + 256 + (tid & 7) * 16) = k2reg; } while (0)
    MISSUE(0); MSTORE(0);
    if (ntiles > 1) MISSUE(1);
    __syncthreads();
    for (int it = 0; it < ntiles; ++it) {
        const int kidx0 = it * 64, stg = (it & 1) * STG;
        const int dlo = qidx0w - (kidx0 + 63), dhi = qidx0w + 31 - kidx0;
        const bool skip = dhi < 0, full = dlo >= 0;
        if (!skip) {
            f32x16 s0 = zero16(), s1 = zero16();
            LDSA char* kb = lds + stg + n * KSTR + h * 16;
#pragma unroll
            for (int ks = 0; ks < NKS; ++ks) {
                const bf16x8 k0 = *(LDSA bf16x8*)(kb + ks * 32), k1 = *(LDSA bf16x8*)(kb + 32 * KSTR + ks * 32);
                s0 = mfma32(k0, qf[ks], s0); s1 = mfma32(k1, qf[ks], s1);
            }
            int dbase = qidx - kidx0 - 4 * h;
            asm volatile("" : "+v"(dbase));
            float tmax = -INFINITY;
            if (full) {
#pragma unroll
                for (int r = 0; r < 16; ++r) tmax = fmaxf(tmax, fmaxf(s0[r], s1[r]));
            } else {
#pragma unroll
                for (int mt = 0; mt < 2; ++mt)
#pragma unroll
                    for (int r = 0; r < 16; ++r) {
                        const int ko = 32 * mt + 8 * (r >> 2) + (r & 3);
                        float v = mt ? s1[r] : s0[r];
                        if (dbase - ko < 0) v = -INFINITY;
                        if (mt) s1[r] = v; else s0[r] = v;
                        tmax = fmaxf(tmax, v);
                    }
                asm volatile("" ::: "memory");
            }
            tmax = fmaxf(tmax, __shfl_xor(tmax, 32));
            const float mnew = fmaxf(m, tmax), msafe = (mnew == -INFINITY) ? 0.f : mnew;
            const float alpha = fexp2(m - msafe);
            float ps = 0.f;
#pragma unroll
            for (int r = 0; r < 16; ++r) { s0[r] = fexp2(s0[r] - msafe); ps += s0[r]; }
#pragma unroll
            for (int r = 0; r < 16; ++r) { s1[r] = fexp2(s1[r] - msafe); ps += s1[r]; }
            l = l * alpha + ps; m = mnew;
            if (__ballot(alpha != 1.0f) != 0ull) {
#pragma unroll
                for (int c = 0; c < 4; ++c)
#pragma unroll
                    for (int r = 0; r < 16; ++r) o[c][r] *= alpha;
            }
            bf16x8 pk[2][2];
#pragma unroll
            for (int j = 0; j < 2; ++j) {
                v4i a; a.x = (int)pk2(s0[8 * j], s0[8 * j + 1]); a.y = (int)pk2(s0[8 * j + 2], s0[8 * j + 3]); a.z = (int)pk2(s0[8 * j + 4], s0[8 * j + 5]); a.w = (int)pk2(s0[8 * j + 6], s0[8 * j + 7]);
                pk[0][j] = __builtin_bit_cast(bf16x8, a);
                v4i b; b.x = (int)pk2(s1[8 * j], s1[8 * j + 1]); b.y = (int)pk2(s1[8 * j + 2], s1[8 * j + 3]); b.z = (int)pk2(s1[8 * j + 4], s1[8 * j + 5]); b.w = (int)pk2(s1[8 * j + 6], s1[8 * j + 7]);
                pk[1][j] = __builtin_bit_cast(bf16x8, b);
            }
            LDSA char* const vp = vp0 + stg;
            pv_step<0>(vp, o[0], pk); pv_step<1>(vp, o[1], pk); pv_step<2>(vp, o[2], pk); pv_step<3>(vp, o[3], pk);
        }
        if (it + 1 < ntiles) MSTORE((it + 1) & 1);
        if (it + 2 < ntiles) MISSUE(it + 2);
        __syncthreads();
    }
#undef MISSUE
#undef MSTORE
    l += __shfl_xor(l, 32);
    epi(o, l, m);
}

DEVI void item_mla8(const Params& P, LDSA char* lds, int tid, int item) {
    bf16_t* z = (bf16_t*)(P.ws + WS_R1); const bf16_t* kvb = (const bf16_t*)(P.ws + WS_KV); const bf16_t* q = (const bf16_t*)(P.ws + WS_H);
    const int bh = (item >> 1) & 127, kk_ = item >> 8, j_ = item & 1, qb = 15 - ((kk_ & 1) ? 2 * kk_ + 1 - j_ : 2 * kk_ + j_), hd = bh & 15, b = bh >> 4;
    const int lane = tid & 63, wave = __builtin_amdgcn_readfirstlane(tid >> 6), n = lane & 31, q0 = qb * 256, ntiles = (q0 + 256) / 64;
    const bf16_t* kvr = kvb + (size_t)b * SEQ * 4096 + hd * 256; const bf16_t* kpe = z + (size_t)b * SEQ * LDZO + OC_KPE;
    const int qi = q0 + 32 * wave + n; const size_t row = (size_t)b * SEQ + qi;
    auto epi = [&](f32x16 (&o)[4], float l, float) { if (P.dry) return; const float inv = l > 0.f ? 1.0f / l : 0.f; const int h = lane >> 5; bf16_t* gp = z + row * LDZO + OC_GATE + hd * 128;
#pragma unroll
        for (int c = 0; c < 4; ++c)
#pragma unroll
            for (int qq = 0; qq < 4; ++qq) { bf16_t* p = gp + 32 * c + 8 * qq + 4 * h; const u32x2 gt = *(const u32x2*)p; u32x2 w;
                w.x = pk2(o[c][4 * qq] * inv * siluf_(lo2f(gt.x)), o[c][4 * qq + 1] * inv * siluf_(hi2f(gt.x)));
                w.y = pk2(o[c][4 * qq + 2] * inv * siluf_(lo2f(gt.y)), o[c][4 * qq + 3] * inv * siluf_(hi2f(gt.y))); *(u32x2*)p = w; } };
    mla_core8(lds, tid, q + row * 3072 + hd * 192, qi, q0 + 32 * wave, ntiles, kvr, kpe, (const float*)(P.ws + WS_COS), epi);
}

constexpr int N_PHASES = 28;
DEVI void run_phase(const Params& P, int ph, LDSA char* lds, int tid) {
    unsigned char* ws = P.ws; const int G = vgrid(), v = vblock();
    bf16_t* hbuf = (bf16_t*)(ws + WS_H); bf16_t* zbuf = (bf16_t*)(ws + WS_R1);
    if (ph == 0) { phase_prep(P, lds, opq(tid)); phase_xb(P.x, hbuf, (float*)(ws + WS_RSTD), opq(tid)); return; }
    if (ph == 27) { phase_rms<true>(P.out, P.final_norm_w, P.out, opq(tid)); return; }
    int layer, sub; { const int q = ph - 1; if (q < 7) { layer = 0; sub = q; } else if (q < 13) { layer = 1; sub = q - 7; } else if (q < 20) { layer = 2; sub = q - 13; } else { layer = 3; sub = q - 20; } }
    const int li = layer >> 1; const float* xin = (layer == 0) ? P.x : P.out;
#ifdef DBG_LAYERS
    if (!((DBG_LAYERS >> layer) & 1)) {
        if (layer == 0 && sub == 6) { for (size_t i = (size_t)blockIdx.x * NTHREADS + tid; i < (size_t)MTOK * D_MODEL / 4; i += (size_t)G * NTHREADS) ((f32x4*)P.out)[i] = ((const f32x4*)P.x)[i]; }
        return;
    }
#endif
#ifdef DBG_SKIP_SUB
    if ((DBG_SKIP_SUB >> sub) & 1) return;
#endif
    if (sub == 0) { if (layer != 0) phase_rstd((const float*)(ws + WS_SSP), (float*)(ws + WS_RSTD), opq(tid)); return; }
    if ((layer & 1) == 0) {
        if (sub == 1) {
            pg8::run(lds - grp_() * GRP_LDS, hbuf, 2048, (const bf16_t*)(ws + WS_WEVIN + li * SZ_WEVIN), MTOK, LDZE, 2048, pg8::PEpiBf16S{zbuf, LDZE, (const float*)(ws + WS_RSTD)}); return; }
        if (sub == 2) { const int nwin = 2048, ndil = 3072, ncmp = 64, nt = nwin + ndil + ncmp;
            (void)nt;
            if (G == 512) {
                const int kmax = v < 64 ? 4 : 6;
                for (int k = 0; k < kmax; ++k) item_dil(P, lds, opq(tid), v + 512 * k);
                if (v >= 64 && v < 192) { const int i = v - 64; item_dil(P, lds, opq(tid), i < 64 ? i + 2048 : i - 64 + 2560); }
            } else
            for (int it = v; it < ndil; it += G) item_dil(P, lds, opq(tid), it);
            (void)nwin;
            { int t_ = tid; asm volatile("" : "+v"(t_)); for (int it = v; it < ncmp; it += G) item_cmp1(P, li, lds, t_, it); }
            return; }
        if (sub == 3) { phase_cmp2(P, li, lds, opq(tid)); return; }
        if (sub == 4) return;
        if (sub == 5) {
            for (int it = v; it < 2048; it += G) { const int item = it ^ (((it >> 9) & 1) ? 0 : 254);
                item_cmpatt(P, lds, opq(tid), item); item_win(P, lds, opq(tid), item); item_slc(P, lds, opq(tid), item); }
            { int t_ = tid; asm volatile("" : "+v"(t_)); for (int it = v; it < MTOK / 4; it += G) item_mixb(P, t_, it); }
            return; }
        if (sub == 6) { pg8::run(lds - grp_() * GRP_LDS, zbuf + EC_GATEA, LDZE, (const bf16_t*)(ws + WS_WEVOUT + li * SZ_WEVOUT), MTOK, 2048, 1536, pg8::PEpiResidX{xin, P.out, hbuf, (float*)(ws + WS_SSP)}); return; }
    } else {
        if (sub == 1) { pg8::run(lds - grp_() * GRP_LDS, hbuf, 2048, (const bf16_t*)(ws + WS_WODIN + li * SZ_WODIN), MTOK, LDZO, 2048, pg8::PEpiBf16S{zbuf, LDZO, (const float*)(ws + WS_RSTD)}); return; }
        if (sub == 2) { phase_norms(zbuf, P.q_norm + li * 1536, P.kv_norm + li * 512, (const float*)(ws + WS_COS), (const float*)(ws + WS_SIN), opq(tid)); return; }
        if (sub == 3) {
            pg8::run(lds - grp_() * GRP_LDS, zbuf + OC_CQ, LDZO, (const bf16_t*)(ws + WS_WQB + li * SZ_WQB), MTOK, 3072, 1536, pg8::PEpiBf16{hbuf, 3072});
            pg8::run(lds - grp_() * GRP_LDS, zbuf + OC_CKV, LDZO, (const bf16_t*)(ws + WS_WKVB + li * SZ_WKVB), MTOK, 4096, 512, pg8::PEpiBf16{(bf16_t*)(ws + WS_KV), 4096}); return; }
        if (sub == 4) { for (int it = pblock(); it < 2048; it += (int)gridDim.x) item_mla8(P, lds - grp_() * GRP_LDS, opq((int)threadIdx.x), it); return; }
        if (sub == 5) { pg8::run(lds - grp_() * GRP_LDS, zbuf + OC_GATE, LDZO, (const bf16_t*)(ws + WS_WODOUT + li * SZ_WODOUT), MTOK, 2048, 2048, pg8::PEpiResidX{xin, P.out, hbuf, (float*)(ws + WS_SSP)}); return; }
    }
}

DEVI void grid_barrier(unsigned* bar, unsigned gen) {
    __syncthreads();
    if (threadIdx.x == 0) {
        const unsigned G = gridDim.x, x = blockIdx.x & 7u;
        unsigned* gcnt = bar + 32 * 8;
        __builtin_amdgcn_fence(__ATOMIC_RELEASE, "agent");
        if ((G & 7u) == 0u) {
            if (__hip_atomic_fetch_add(bar + 32 * x, 1u, __ATOMIC_ACQ_REL, __HIP_MEMORY_SCOPE_AGENT) + 1u == gen * (G >> 3)) {
                if (__hip_atomic_fetch_add(gcnt, 1u, __ATOMIC_ACQ_REL, __HIP_MEMORY_SCOPE_AGENT) + 1u == gen * 8u) {
#pragma unroll
                    for (int i = 0; i < 8; ++i) __hip_atomic_store(bar + 32 * (9 + i), gen, __ATOMIC_RELEASE, __HIP_MEMORY_SCOPE_AGENT);
                }
            }
            while (__hip_atomic_load(bar + 32 * (9 + x), __ATOMIC_RELAXED, __HIP_MEMORY_SCOPE_AGENT) < gen) __builtin_amdgcn_s_sleep(1);
        } else {
            __hip_atomic_fetch_add(gcnt, 1u, __ATOMIC_RELAXED, __HIP_MEMORY_SCOPE_AGENT);
            while (__hip_atomic_load(gcnt, __ATOMIC_RELAXED, __HIP_MEMORY_SCOPE_AGENT) < gen * G) __builtin_amdgcn_s_sleep(2);
        }
        __builtin_amdgcn_fence(__ATOMIC_ACQUIRE, "agent");
    }
    __syncthreads();
}

__global__ void __launch_bounds__(NTHREADS, 2) fwd_kernel(Params P) {
    extern __shared__ __attribute__((aligned(16))) unsigned char smem[];
    LDSA char* lds = (LDSA char*)smem;
    const int tid = threadIdx.x & (GTHREADS - 1);
    lds += grp_() * GRP_LDS;
    unsigned bar_gen = 0;
    for (int ph = P.ph_lo; ph < P.ph_hi; ++ph) {
        if (ph == 1 || ph == 5 || ph == 18) continue;
        if (ph > P.ph_lo) {
            if (P.ph_lo < 0) cg::this_grid().sync();
            grid_barrier((unsigned*)(P.ws + WS_BAR), ++bar_gen);
        }
        int tid_ = tid; asm volatile("" : "+v"(tid_));
        Params Q = P; { size_t z0 = 0, z1 = 0; asm volatile("" : "+s"(z0), "+s"(z1)); Q.ws = P.ws + z0; Q.out = P.out + z1; }
#ifdef DBG_DRY_PH
        if (ph == DBG_DRY_PH) { Params Q2 = Q; Q2.dry = 1; int t3_ = tid; asm volatile("" : "+v"(t3_)); run_phase(Q2, ph, lds, t3_); __syncthreads(); }
#endif
        run_phase(Q, ph, lds, tid_);
#ifdef DBG_REPEAT_PH
        if (ph == DBG_REPEAT_PH) { __syncthreads(); int t2_ = tid; asm volatile("" : "+v"(t2_)); run_phase(Q, ph, lds, t2_); }
#endif
    }
}

extern "C" void kernel_launch(void* const* d_in, const int* in_sizes, int n_in, void* d_out, int out_size, void* d_ws, size_t ws_size, hipStream_t stream) {
    static int grid = 0;
    if (grid == 0) {
        if (n_in != 15 || ws_size < WS_END) { fprintf(stderr, "kernel_launch: need 15 inputs and %zu bytes of workspace (got %d, %zu)\n", (size_t)WS_END, n_in, ws_size); grid = -1; return; }
        int dev = 0, cus = 0, per_cu = 0;
        hipGetDevice(&dev); hipDeviceGetAttribute(&cus, hipDeviceAttributeMultiprocessorCount, dev);
        if (hipFuncSetAttribute((const void*)fwd_kernel, hipFuncAttributeMaxDynamicSharedMemorySize, LDS_BYTES) != hipSuccess) { fprintf(stderr, "hipFuncSetAttribute failed\n"); grid = -1; return; }
        if (hipOccupancyMaxActiveBlocksPerMultiprocessor(&per_cu, (const void*)fwd_kernel, NTHREADS, LDS_BYTES) != hipSuccess || per_cu < 1) { fprintf(stderr, "occupancy query failed (%d)\n", per_cu); per_cu = 1; }
        if (per_cu > 1) per_cu = 1;
        grid = cus * per_cu;
        fprintf(stderr, "kernel_launch: grid %d (%d CUs x %d)\n", grid, cus, per_cu);
    }
    if (grid < 0) return;
    Params p{};
    p.x = (const float*)d_in[0]; p.rel_bias = (const float*)d_in[1]; p.norm_w = (const float*)d_in[2]; p.final_norm_w = (const float*)d_in[3]; p.ev_w_in = (const float*)d_in[4];
    p.cmp_pos = (const float*)d_in[5]; p.cmp_w1 = (const float*)d_in[6]; p.cmp_w2 = (const float*)d_in[7]; p.ev_w_out = (const float*)d_in[8]; p.od_w_in = (const float*)d_in[9];
    p.q_norm = (const float*)d_in[10]; p.w_qb = (const float*)d_in[11]; p.kv_norm = (const float*)d_in[12]; p.w_kvb = (const float*)d_in[13]; p.od_w_out = (const float*)d_in[14];
    p.out = (float*)d_out; p.ws = (unsigned char*)d_ws;
#if ONE_LAUNCH
    p.ph_lo = 0; p.ph_hi = N_PHASES;
    if (hipMemsetAsync((char*)d_ws + WS_BAR, 0, 4096, stream) != hipSuccess) { fprintf(stderr, "memset failed\n"); return; }
    void* args[] = {&p};
    hipError_t e = hipLaunchCooperativeKernel((const void*)fwd_kernel, dim3(grid), dim3(NTHREADS), args, LDS_BYTES, stream);
    if (e != hipSuccess) fprintf(stderr, "cooperative launch failed: %s (grid %d)\n", hipGetErrorString(e), grid);
#else
    for (int ph = 0; ph < N_PHASES; ++ph) { p.ph_lo = ph; p.ph_hi = ph + 1; hipLaunchKernelGGL(fwd_kernel, dim3(grid), dim3(NTHREADS), LDS_BYTES, stream, p); }
#endif
}
```

```cpp
#include <hip/hip_runtime.h>
#include <hip/hip_cooperative_groups.h>
#include <cstdio>
#include <cstdint>
namespace cg = cooperative_groups;


#ifndef ONE_LAUNCH
#define ONE_LAUNCH 1
#endif

typedef unsigned short bf16_t;
typedef short bf16x8 __attribute__((ext_vector_type(8)));
typedef float f32x16 __attribute__((ext_vector_type(16)));
typedef float f32x4 __attribute__((ext_vector_type(4)));
typedef unsigned u32x4 __attribute__((ext_vector_type(4)));
typedef unsigned u32x2 __attribute__((ext_vector_type(2)));
typedef int v2i __attribute__((ext_vector_type(2)));
typedef int v4i __attribute__((ext_vector_type(4)));
#define LDSA __attribute__((address_space(3)))
#define DEVI __device__ __forceinline__

constexpr int D_MODEL = 2048, BATCH = 8, SEQ = 4096, MTOK = BATCH * SEQ;
constexpr int LDZE = 8960;
constexpr int LDZO = 4352;
constexpr int EC_QA = 0, EC_KC = 1024, EC_VC = 1280, EC_KS = 1536, EC_VS = 1792, EC_KW = 2048, EC_VW = 2304, EC_GATEA = 2560,
              EC_QB = 3584, EC_KB = 5120, EC_VB = 6656, EC_GATEB = 8192, EC_G3 = 8704;
constexpr int OC_CQ = 0, OC_CKV = 1536, OC_GATE = 2048, OC_KPE = 4096;
constexpr float LOG2E = 1.4426950408889634f;
constexpr float NSA_SCALE2 = 0.08838834764831845f * LOG2E;
constexpr float MLA_SCALE2 = 0.07216878364870323f * LOG2E;
constexpr int GRP_LDS = 73728, LDS_BYTES = 2 * GRP_LDS;
constexpr int NTHREADS = 512, GTHREADS = 256;

constexpr size_t MB = 1024 * 1024;
constexpr size_t WS_BIAST = 0;
constexpr size_t WS_BIASD = WS_BIAST + 20 * 4096 * 4;
constexpr size_t WS_COS = 512 * 1024;
constexpr size_t WS_SIN = WS_COS + 512 * 1024;
constexpr size_t WS_POSP = WS_SIN + 512 * 1024;
constexpr size_t WS_BAR = 1920 * 1024;
constexpr size_t WS_KCMP = 2 * MB;
constexpr size_t WS_VCMP = WS_KCMP + 256 * 1024;
constexpr size_t WS_SEL = 3 * MB;
constexpr size_t WS_LSE = 4 * MB;
constexpr size_t WS_CMPP = 6 * MB;
constexpr size_t WS_RSTD = 14 * MB;
constexpr size_t WS_W = 16 * MB;
constexpr size_t SZ_WEVIN = (size_t)LDZE * 2048 * 2, SZ_WEVOUT = (size_t)2048 * 1536 * 2, SZ_WODIN = (size_t)LDZO * 2048 * 2,
                 SZ_WQB = (size_t)3072 * 1536 * 2, SZ_WKVB = (size_t)4096 * 512 * 2, SZ_WODOUT = (size_t)2048 * 2048 * 2, SZ_W1 = (size_t)128 * 8192 * 2;
constexpr size_t WS_WEVIN = WS_W, WS_WEVOUT = WS_WEVIN + 2 * SZ_WEVIN, WS_WODIN = WS_WEVOUT + 2 * SZ_WEVOUT, WS_WQB = WS_WODIN + 2 * SZ_WODIN,
                 WS_WKVB = WS_WQB + 2 * SZ_WQB, WS_WODOUT = WS_WKVB + 2 * SZ_WKVB, WS_W1 = WS_WODOUT + 2 * SZ_WODOUT, WS_WEND = WS_W1 + 4 * SZ_W1;
constexpr size_t WS_R1 = (WS_WEND + 4095) & ~(size_t)4095;
constexpr size_t SZ_R1 = (size_t)MTOK * LDZE * 2;
constexpr size_t WS_KV = WS_R1 + (size_t)MTOK * LDZO * 2;
constexpr size_t WS_H = WS_R1 + SZ_R1;
constexpr size_t WS_DIL = WS_H + (size_t)MTOK * 2048 * 2;
constexpr size_t WS_SSP = WS_DIL + (size_t)3 * MTOK * 512 * 2;
constexpr size_t WS_END = WS_SSP + (size_t)MTOK * 32 * 4;

struct Params {
    const float* x; const float* rel_bias; const float* norm_w; const float* final_norm_w; const float* ev_w_in; const float* cmp_pos;
    const float* cmp_w1; const float* cmp_w2; const float* ev_w_out; const float* od_w_in; const float* q_norm; const float* w_qb;
    const float* kv_norm; const float* w_kvb; const float* od_w_out;
    float* out; unsigned char* ws; int ph_lo, ph_hi; int dry, pad_;
};

DEVI float bf2f(bf16_t h) { return __uint_as_float((unsigned)h << 16); }
typedef __bf16 bf16v2_ __attribute__((ext_vector_type(2)));
typedef float f32v2_ __attribute__((ext_vector_type(2)));
DEVI unsigned pk2(float lo, float hi) { const f32v2_ v = {lo, hi}; return __builtin_bit_cast(unsigned, __builtin_convertvector(v, bf16v2_)); }
DEVI unsigned bfr_(float f) { const unsigned u = __float_as_uint(f); return (u + 0x7fffu + ((u >> 16) & 1u)) >> 16; }
DEVI unsigned pk2s(float lo, float hi) { return pk2(lo, hi); }
DEVI float lo2f(unsigned u) { return __uint_as_float(u << 16); }
DEVI float hi2f(unsigned u) { return __uint_as_float(u & 0xffff0000u); }
DEVI float fexp2(float x) { return __builtin_amdgcn_exp2f(x); }
DEVI float sigmoidf_(float x) { return 1.0f / (1.0f + __expf(-x)); }
DEVI float siluf_(float x) { return x / (1.0f + __expf(-x)); }
DEVI float wave_sum(float v) {
#pragma unroll
    for (int o = 32; o >= 1; o >>= 1) v += __shfl_xor(v, o);
    return v;
}
DEVI int pblock() { const int G = gridDim.x, b = blockIdx.x; return (G % 8 == 0) ? (b % 8) * (G / 8) + b / 8 : b; }
DEVI int grp_() { return __builtin_amdgcn_readfirstlane((int)(threadIdx.x >> 8)); }
DEVI int vgrid() { return (int)gridDim.x * 2; }
DEVI int vblock() { return pblock() * 2 + grp_(); }
template <int OFF> DEVI v2i trr(unsigned a) { v2i r; asm volatile("ds_read_b64_tr_b16 %0, %1 offset:%2" : "=v"(r) : "v"(a), "n"(OFF)); return r; }
DEVI f32x16 mfma32(bf16x8 a, bf16x8 b, f32x16 c) { return __builtin_amdgcn_mfma_f32_32x32x16_bf16(a, b, c, 0, 0, 0); }
DEVI int opq(int t) { asm volatile("" : "+v"(t)); return t; }
DEVI int opqs(int t) { asm volatile("" : "+s"(t)); return t; }
DEVI f32x16 zero16() { f32x16 z; for (int i = 0; i < 16; ++i) z[i] = 0.f; return z; }

template <int DM = 0, class AF, class EF>
DEVI void gemm_tile4(LDSA char* lds, int tid, AF af, const bf16_t* __restrict__ Bt, int ldb, int kt0, int nk, int row0, int col0, EF ef) {
    const int lane = tid & 63, wave = __builtin_amdgcn_readfirstlane(tid >> 6), wm = wave >> 1, wn = wave & 1, n32 = lane & 31, h = lane >> 5;
    f32x16 acc[4][2];
#pragma unroll
    for (int i = 0; i < 4; ++i)
#pragma unroll
        for (int j = 0; j < 2; ++j) acc[i][j] = zero16();
    u32x4 ra[8], rb[4];
    const int cr = tid >> 3, ckc = tid & 7;
#define GLOAD(kt) do { int cr_ = cr; asm volatile("" : "+v"(cr_));   \
        _Pragma("unroll") for (int u = 0; u < 8; ++u) ra[u] = *(const u32x4*)af(row0 + cr_ + 32 * u, (kt) * 64, ckc * 8); \
        _Pragma("unroll") for (int u = 0; u < 4; ++u) rb[u] = *(const u32x4*)(Bt + (size_t)(col0 + cr_ + 32 * u) * ldb + (kt) * 64 + ckc * 8); } while (0)
#define SSTORE() do { LDSA char* sb_ = lds + cr * 144 + ckc * 16; _Pragma("unroll") for (int u = 0; u < 8; ++u) *(LDSA u32x4*)(sb_ + u * 32 * 144) = ra[u]; \
        _Pragma("unroll") for (int u = 0; u < 4; ++u) *(LDSA u32x4*)(sb_ + 36864 + u * 32 * 144) = rb[u]; } while (0)
    GLOAD(kt0);
    LDSA char* As = lds + (wm * 128 + n32) * 144 + h * 16;
    LDSA char* Bs = lds + 36864 + (wn * 64 + n32) * 144 + h * 16;
    for (int i = 0; i < nk; ++i) {
        if (DM != 2 || i == 0) SSTORE();
        __syncthreads();
        if (DM != 2 && i + 1 < nk) GLOAD(kt0 + i + 1);
        if (DM != 1) {
#pragma unroll
            for (int ks = 0; ks < 4; ++ks) {
                const bf16x8 b0 = *(LDSA bf16x8*)(Bs + ks * 32), b1 = *(LDSA bf16x8*)(Bs + 32 * 144 + ks * 32);
#pragma unroll
                for (int ii = 0; ii < 4; ++ii) { const bf16x8 a = *(LDSA bf16x8*)(As + ii * 32 * 144 + ks * 32);
                    acc[ii][0] = mfma32(b0, a, acc[ii][0]); acc[ii][1] = mfma32(b1, a, acc[ii][1]); }
            }
        }
        __syncthreads();
    }
#undef GLOAD
#undef SSTORE
    ef(row0 + wm * 128 + n32, col0 + wn * 64 + 4 * h, acc);
}

struct AFPlain { const bf16_t* A; int lda; DEVI const bf16_t* operator()(int row, int kb, int kin) const { return A + (size_t)row * lda + kb + kin; } };
struct AFEvOut { const bf16_t* z; DEVI const bf16_t* operator()(int row, int kb, int kin) const { const int cb = kb < 1024 ? EC_GATEA + kb : EC_GATEB + (kb - 1024); return z + (size_t)row * LDZE + cb + kin; } };
struct AFCmp { const bf16_t* z; int colbase;
    DEVI const bf16_t* operator()(int R, int kb, int kin) const { const int k = kb + kin; const int b = R >> 7, g = (R >> 6) & 1, n = R & 63, l = k >> 7, d = k & 127;
        return z + (size_t)(b * SEQ + n * 64 + l) * LDZE + colbase + g * 128 + d; } };

struct EpiBf16 { bf16_t* C; int ldc;
    template <int NI> DEVI void operator()(int rbase, int cbase, f32x16 (&acc)[NI][2]) const {
#pragma unroll
        for (int i = 0; i < NI; ++i)
#pragma unroll
            for (int j = 0; j < 2; ++j)
#pragma unroll
                for (int g = 0; g < 4; ++g) { u32x2 w; w.x = pk2s(acc[i][j][4 * g], acc[i][j][4 * g + 1]); w.y = pk2s(acc[i][j][4 * g + 2], acc[i][j][4 * g + 3]);
                    *(u32x2*)(C + (size_t)(rbase + 32 * i) * ldc + cbase + 32 * j + 8 * g) = w; }
    } };
struct EpiResid { const float* xin; float* xout;
    template <int NI> DEVI void operator()(int rbase, int cbase, f32x16 (&acc)[NI][2]) const {
#pragma unroll
        for (int i = 0; i < NI; ++i)
#pragma unroll
            for (int j = 0; j < 2; ++j)
#pragma unroll
                for (int g = 0; g < 4; ++g) { const size_t off = (size_t)(rbase + 32 * i) * D_MODEL + cbase + 32 * j + 8 * g;
                    f32x4 v = *(const f32x4*)(xin + off); v[0] += acc[i][j][4 * g]; v[1] += acc[i][j][4 * g + 1]; v[2] += acc[i][j][4 * g + 2]; v[3] += acc[i][j][4 * g + 3];
                    *(f32x4*)(xout + off) = v; if (g == 3) asm volatile("" ::: "memory"); }
    } };
struct EpiProbe { float* C;
    template <int NI> DEVI void operator()(int rbase, int cbase, f32x16 (&acc)[NI][2]) const { float t = 0.f; for (int i = 0; i < NI; ++i) for (int j = 0; j < 2; ++j) for (int r = 0; r < 16; ++r) t += acc[i][j][r]; if (t == 123456.789f) C[rbase + cbase] = t; } };
struct EpiF32 { float* C; int ldc;
    template <int NI> DEVI void operator()(int rbase, int cbase, f32x16 (&acc)[NI][2]) const {
#pragma unroll
        for (int i = 0; i < NI; ++i)
#pragma unroll
            for (int j = 0; j < 2; ++j)
#pragma unroll
                for (int g = 0; g < 4; ++g) { f32x4 v; v[0] = acc[i][j][4 * g]; v[1] = acc[i][j][4 * g + 1]; v[2] = acc[i][j][4 * g + 2]; v[3] = acc[i][j][4 * g + 3];
                    *(f32x4*)(C + (size_t)(rbase + 32 * i) * ldc + cbase + 32 * j + 8 * g) = v; }
    } };
struct EpiQ { bf16_t* C; const float* cosT; const float* sinT;
    template <int NI> DEVI void operator()(int rbase, int cbase, f32x16 (&acc)[NI][2]) const {
        const int sub = (cbase & ~63) % 192;
        if (sub == 128) {
            const int hoff = cbase & 63;
#pragma unroll
            for (int i = 0; i < NI; ++i) { const int t = (rbase + 32 * i) & (SEQ - 1);
#pragma unroll
                for (int g = 0; g < 4; ++g) { const f32x4 c = *(const f32x4*)(cosT + t * 32 + hoff + 8 * g), s = *(const f32x4*)(sinT + t * 32 + hoff + 8 * g);
#pragma unroll
                    for (int e = 0; e < 4; ++e) { const float x1 = acc[i][0][4 * g + e], x2 = acc[i][1][4 * g + e];
                        acc[i][0][4 * g + e] = x1 * c[e] - x2 * s[e]; acc[i][1][4 * g + e] = x1 * s[e] + x2 * c[e]; }
                    asm volatile("" ::: "memory"); } }
        }
#pragma unroll
        for (int i = 0; i < NI; ++i)
#pragma unroll
            for (int j = 0; j < 2; ++j)
#pragma unroll
                for (int g = 0; g < 4; ++g) { u32x2 w; w.x = pk2(acc[i][j][4 * g] * MLA_SCALE2, acc[i][j][4 * g + 1] * MLA_SCALE2); w.y = pk2(acc[i][j][4 * g + 2] * MLA_SCALE2, acc[i][j][4 * g + 3] * MLA_SCALE2);
                    *(u32x2*)(C + (size_t)(rbase + 32 * i) * 3072 + cbase + 32 * j + 8 * g) = w; }
    } };

DEVI void tile_of(int L, int nM, int nN, int& pm, int& pn) { const int GM = 8, nig = GM * nN, gid = L / nig, fm = gid * GM; const int gsz = (nM - fm) < GM ? (nM - fm) : GM; pm = fm + (L % nig) % gsz; pn = (L % nig) / gsz; }

template <class AF, class EF>
DEVI void gemm_tile8(LDSA char* lds, int tid, AF af, const bf16_t* __restrict__ Bt, int ldb, int nk, int row0, int col0, EF ef) {
    const int lane = tid & 63, wave = __builtin_amdgcn_readfirstlane(tid >> 6), wm = wave >> 2, wn = wave & 3, n32 = lane & 31, h = lane >> 5;
    f32x16 acc[4][2];
#pragma unroll
    for (int i = 0; i < 4; ++i)
#pragma unroll
        for (int j = 0; j < 2; ++j) acc[i][j] = zero16();
    u32x4 ra[4], rb[4];
    const int cr = tid >> 3, ckc = tid & 7;
#define GLOAD(kt) do { int cr_ = cr; asm volatile("" : "+v"(cr_)); \
        _Pragma("unroll") for (int u = 0; u < 4; ++u) { ra[u] = *(const u32x4*)af(row0 + cr_ + 64 * u, (kt) * 64, ckc * 8); \
            rb[u] = *(const u32x4*)(Bt + (size_t)(col0 + cr_ + 64 * u) * ldb + (kt) * 64 + ckc * 8); } } while (0)
#define SSTORE(s) do { LDSA char* sb_ = lds + (s) * GRP_LDS + cr * 144 + ckc * 16; _Pragma("unroll") for (int u = 0; u < 4; ++u) { \
        *(LDSA u32x4*)(sb_ + u * 64 * 144) = ra[u]; *(LDSA u32x4*)(sb_ + 36864 + u * 64 * 144) = rb[u]; } } while (0)
    GLOAD(0); SSTORE(0);
    if (nk > 1) GLOAD(1);
    __syncthreads();
    for (int i = 0; i < nk; ++i) {
        LDSA char* As = lds + (i & 1) * GRP_LDS + (wm * 128 + n32) * 144 + h * 16;
        LDSA char* Bs = lds + (i & 1) * GRP_LDS + 36864 + (wn * 64 + n32) * 144 + h * 16;
#pragma unroll
        for (int ks = 0; ks < 4; ++ks) {
            const bf16x8 b0 = *(LDSA bf16x8*)(Bs + ks * 32), b1 = *(LDSA bf16x8*)(Bs + 32 * 144 + ks * 32);
#pragma unroll
            for (int ii = 0; ii < 4; ++ii) { const bf16x8 a = *(LDSA bf16x8*)(As + ii * 32 * 144 + ks * 32);
                acc[ii][0] = mfma32(b0, a, acc[ii][0]); acc[ii][1] = mfma32(b1, a, acc[ii][1]); }
        }
        if (i + 1 < nk) SSTORE((i + 1) & 1);
        if (i + 2 < nk) GLOAD(i + 2);
        __syncthreads();
    }
#undef GLOAD
#undef SSTORE
    ef(row0 + wm * 128 + n32, col0 + wn * 64 + 4 * h, acc);
}

template <class AF, class EF>
DEVI void gemm_phase(LDSA char* lds_phys, int tid_phys, AF af, const bf16_t* Bt, int ldb, int K, int M, int N, EF ef) {
    const int nM = M / 256, nN = N / 256, nt = nM * nN, G = gridDim.x, v = pblock();
    for (int L = v; L < nt; L += G) { int pm, pn; tile_of(L, nM, nN, pm, pn); gemm_tile8(lds_phys, tid_phys, af, Bt, ldb, K / 64, pm * 256, pn * 256, ef); }
}

namespace pg8 {
#define PG8_LAS __attribute__((address_space(3)))
typedef unsigned short bf16_t;
typedef short bf16x8 __attribute__((ext_vector_type(8)));
typedef float f32x4 __attribute__((ext_vector_type(4)));
typedef unsigned u32x4 __attribute__((ext_vector_type(4)));
constexpr int BM = 256, BK = 64, HALF = 128, HTB = HALF * BK * 2  , STAGE_BYTES = 8 * HTB, NXCD = 8, WGM = 4;

__host__ __device__ __forceinline__ int lds_byte(int r, int c) { const int st = (r >> 4) * 2 + (c >> 5), rr = r & 15, cc = c & 31, ob = rr * 64 + cc * 2; return st * 1024 + (ob ^ (((ob >> 9) & 1) << 5)); }
__host__ __device__ __forceinline__ void stage_rc(int b, int& R, int& C) { const int st = b / 1024, sb = b % 1024, swz = sb ^ (((sb >> 9) & 1) << 5); R = (st >> 1) * 16 + swz / 64; C = (st & 1) * 32 + (swz % 64) / 2; }
__host__ __device__ __forceinline__ int perm32(int rho) { const int n = rho >> 4, i = rho & 15; return 8 * (i >> 2) + 4 * n + (i & 3); }

struct Unit { int pm, pn; };
struct Gemm { const bf16_t* A; const bf16_t* Bt; int M, N, K, lda; };

struct StaticOrder {
    int nM, nN, nwg, G, c;
    __host__ __device__ void init(int M, int N, int G_, int c_) { nM = M / BM; nN = N / BM; nwg = nM * nN; G = G_; c = c_; }
    __host__ __device__ bool next(int i, Unit& u) const {
        const long L = (long)i * G + c; if (L >= nwg) return false;
        int wgid = (int)L; { const int q = nwg / NXCD, r = nwg % NXCD, xcd = wgid % NXCD, off = wgid / NXCD; wgid = (xcd < r ? xcd * (q + 1) : r * (q + 1) + (xcd - r) * q) + off; }
        const int nig = WGM * nN, gid = wgid / nig, fm = gid * WGM, gsz = (nM - fm) < WGM ? (nM - fm) : WGM;
        u.pm = fm + ((wgid % nig) % gsz); u.pn = (wgid % nig) / gsz; return true;
    }
    __device__ __forceinline__ void a_ready(const Unit&) const {}
    __device__ __forceinline__ void done(const Unit&) const {}
};
typedef float f32x4_ __attribute__((ext_vector_type(4)));
template <class Epi, class Sched, bool ALIGN_EPI = false, bool SP2 = false>
__device__ __forceinline__ void gemm_phase(PG8_LAS unsigned char* lds, const Gemm g, const Sched& S, const Epi& E) {
    const int tid = ::opq((int)threadIdx.x), wid = __builtin_amdgcn_readfirstlane(tid >> 6), lane = tid & 63, wr = wid >> 2, wc = wid & 3, fr = lane & 15, fq = lane >> 4;
    const int K = g.K, nt = K / BK;
    unsigned voffA[2], voffB[2];
#pragma unroll
    for (int i = 0; i < 2; ++i) { int R, C; stage_rc(tid * 16 + i * 8192, R, C); const int Rb = Epi::PERM ? ((R & ~31) + perm32(R & 31)) : R;
        voffA[i] = (unsigned)(R * g.lda + C) * 2u; voffB[i] = (unsigned)(Rb * K + C) * 2u; }
    const size_t kstep = (size_t)(BK * 2);
    const size_t hstepB = (size_t)HALF * K * 2, hstepA = (size_t)HALF * g.lda * 2;
    const size_t tstepB = 2 * hstepB, tstepA = 2 * hstepA;
    const unsigned ldsw = (unsigned)wid * 1024u;
    const int aoff = lds_byte(wr * 64 + fr, fq * 8), boff = lds_byte(wc * 32 + fr, fq * 8);
#define PG8_SA(b, h) (((b) * 2 + (h)) * HTB)
#define PG8_SB(b, h) ((4 + (b) * 2 + (h)) * HTB)
#define PG8_STAGE(bufoff, gbase, voff) do { _Pragma("unroll") for (int _i = 0; _i < 2; ++_i) \
        __builtin_amdgcn_global_load_lds((const unsigned*)((const char*)(gbase) + (voff)[_i]), (PG8_LAS unsigned*)(lds + (bufoff) + ldsw + _i * 8192), 16, 0, 0); } while (0)
#define PG8_LDA(dst, b, h) do { _Pragma("unroll") for (int m = 0; m < 4; ++m) _Pragma("unroll") for (int k = 0; k < 2; ++k) dst[m][k] = *(const PG8_LAS bf16x8*)(lds + PG8_SA(b, h) + aoff + m * 2048 + k * 1024); } while (0)
#define PG8_LDB(dst, b, h) do { _Pragma("unroll") for (int n = 0; n < 2; ++n) _Pragma("unroll") for (int k = 0; k < 2; ++k) dst[n][k] = *(const PG8_LAS bf16x8*)(lds + PG8_SB(b, h) + boff + n * 2048 + k * 1024); } while (0)
#define PG8_MMA(ai, bj, At, Bt) do { __builtin_amdgcn_s_setprio(1); _Pragma("unroll") for (int m = 0; m < 4; ++m) _Pragma("unroll") for (int n = 0; n < 2; ++n) _Pragma("unroll") for (int k = 0; k < 2; ++k) \
        acc[ai][bj][m][n] = __builtin_amdgcn_mfma_f32_16x16x32_bf16(Bt[n][k], At[m][k], acc[ai][bj][m][n], 0, 0, 0); __builtin_amdgcn_s_setprio(0); } while (0)
#define PG8_WAIT_V(n) asm volatile("s_waitcnt vmcnt(" #n ")" ::: "memory")
#define PG8_WAIT_L(n) asm volatile("s_waitcnt lgkmcnt(" #n ")" ::: "memory")
#define PG8_BAR __builtin_amdgcn_s_barrier()
#define PG8_SCHED __builtin_amdgcn_sched_barrier(0)
    Unit cur, nxt; int ui = 0;
    if (!S.next(0, cur)) return;
    f32x4 acc[2][2][4][2];
#pragma unroll
    for (int a = 0; a < 2; ++a)
#pragma unroll
        for (int b = 0; b < 2; ++b)
#pragma unroll
            for (int m = 0; m < 4; ++m)
#pragma unroll
                for (int n = 0; n < 2; ++n) acc[a][b][m][n] = (f32x4){0.f, 0.f, 0.f, 0.f};
    bf16x8 At[4][2], B0[2][2], B1[2][2];
    const char* cA = (const char*)g.A + (size_t)cur.pm * tstepA; const char* cB = (const char*)g.Bt + (size_t)cur.pn * tstepB;
    S.a_ready(cur);
    if constexpr (SP2) {
        PG8_STAGE(PG8_SB(0, 0), cB, voffB); PG8_STAGE(PG8_SB(0, 1), cB + hstepB, voffB); PG8_STAGE(PG8_SA(0, 0), cA, voffA); PG8_STAGE(PG8_SA(0, 1), cA + hstepA, voffA);
        if (wr == 1) PG8_BAR;
        PG8_WAIT_V(2); PG8_BAR;
        PG8_STAGE(PG8_SB(1, 0), cB + kstep, voffB); PG8_STAGE(PG8_SA(1, 0), cA + kstep, voffA); PG8_STAGE(PG8_SB(1, 1), cB + hstepB + kstep, voffB);
        PG8_WAIT_V(6); PG8_BAR;
    } else {
        PG8_STAGE(PG8_SB(0, 0), cB, voffB); PG8_STAGE(PG8_SA(0, 0), cA, voffA); PG8_STAGE(PG8_SB(0, 1), cB + hstepB, voffB); PG8_STAGE(PG8_SA(0, 1), cA + hstepA, voffA);
        if (wr == 1) PG8_BAR;
        PG8_WAIT_V(4); PG8_BAR;
        PG8_STAGE(PG8_SB(1, 0), cB + kstep, voffB); PG8_STAGE(PG8_SA(1, 0), cA + kstep, voffA); PG8_STAGE(PG8_SB(1, 1), cB + hstepB + kstep, voffB);
        PG8_WAIT_V(6); PG8_BAR;
    }
    for (;;) {
        const bool has_next = S.next(ui + 1, nxt);
        const char* nA = has_next ? (const char*)g.A + (size_t)nxt.pm * tstepA : cA; const char* nB = has_next ? (const char*)g.Bt + (size_t)nxt.pn * tstepB : cB;
        for (int t = 0; t < nt; t += 2) {
            const bool last = (t == nt - 2);
            const char* a1 = cA + (size_t)(t + 1) * kstep;
            const char* a2 = last ? nA : cA + (size_t)(t + 2) * kstep; const char* b2 = last ? nB : cB + (size_t)(t + 2) * kstep;
            const char* a3 = a2 + kstep; const char* b3 = b2 + kstep;
            if (last && has_next) S.a_ready(nxt);
            if constexpr (SP2) {
            PG8_LDB(B0, 0, 0); PG8_LDB(B1, 0, 1); PG8_SCHED; PG8_LDA(At, 0, 0); PG8_STAGE(PG8_SA(1, 1), a1 + hstepA, voffA);
            PG8_WAIT_V(8); PG8_WAIT_L(0); PG8_BAR; PG8_MMA(0, 0, At, B0); PG8_MMA(0, 1, At, B1); PG8_BAR; PG8_SCHED;
            PG8_LDA(At, 0, 1); PG8_STAGE(PG8_SB(0, 0), b2, voffB); PG8_STAGE(PG8_SB(0, 1), b2 + hstepB, voffB); PG8_STAGE(PG8_SA(0, 0), a2, voffA);
            PG8_WAIT_V(8); PG8_WAIT_L(0); PG8_BAR; PG8_MMA(1, 0, At, B0); PG8_MMA(1, 1, At, B1); PG8_BAR; PG8_SCHED;
            PG8_LDB(B0, 1, 0); PG8_LDB(B1, 1, 1); PG8_SCHED; PG8_LDA(At, 1, 0); PG8_STAGE(PG8_SA(0, 1), a2 + hstepA, voffA);
            PG8_WAIT_V(8); PG8_WAIT_L(0); PG8_BAR; PG8_MMA(0, 0, At, B0); PG8_MMA(0, 1, At, B1); PG8_BAR; PG8_SCHED;
            PG8_LDA(At, 1, 1); PG8_STAGE(PG8_SB(1, 0), b3, voffB); PG8_STAGE(PG8_SB(1, 1), b3 + hstepB, voffB); PG8_STAGE(PG8_SA(1, 0), a3, voffA);
            PG8_WAIT_V(8); PG8_WAIT_L(0); PG8_BAR; PG8_MMA(1, 0, At, B0); PG8_MMA(1, 1, At, B1); PG8_BAR; PG8_SCHED;
            } else {
            PG8_LDB(B0, 0, 0); PG8_SCHED; PG8_LDA(At, 0, 0); PG8_STAGE(PG8_SA(1, 1), a1 + hstepA, voffA);
            PG8_WAIT_L(8); PG8_BAR; PG8_WAIT_L(0); PG8_MMA(0, 0, At, B0); PG8_BAR; PG8_SCHED;
            PG8_LDB(B1, 0, 1); PG8_STAGE(PG8_SB(0, 0), b2, voffB);
            PG8_BAR; PG8_WAIT_L(0); PG8_MMA(0, 1, At, B1); PG8_BAR;
            PG8_LDA(At, 0, 1); PG8_STAGE(PG8_SA(0, 0), a2, voffA);
            PG8_BAR; PG8_WAIT_L(0); PG8_MMA(1, 0, At, B0); PG8_BAR; PG8_SCHED;
            PG8_STAGE(PG8_SB(0, 1), b2 + hstepB, voffB);
            PG8_WAIT_V(6); PG8_BAR; PG8_MMA(1, 1, At, B1); PG8_BAR;
            PG8_LDB(B0, 1, 0); PG8_SCHED; PG8_LDA(At, 1, 0); PG8_STAGE(PG8_SA(0, 1), a2 + hstepA, voffA);
            PG8_WAIT_L(8); PG8_BAR; PG8_WAIT_L(0); PG8_MMA(0, 0, At, B0); PG8_BAR; PG8_SCHED;
            PG8_LDB(B1, 1, 1); PG8_STAGE(PG8_SB(1, 0), b3, voffB);
            PG8_BAR; PG8_WAIT_L(0); PG8_MMA(0, 1, At, B1); PG8_BAR;
            PG8_LDA(At, 1, 1); PG8_STAGE(PG8_SA(1, 0), a3, voffA);
            PG8_BAR; PG8_WAIT_L(0); PG8_MMA(1, 0, At, B0); PG8_BAR; PG8_SCHED;
            PG8_STAGE(PG8_SB(1, 1), b3 + hstepB, voffB);
            PG8_WAIT_V(6); PG8_BAR; PG8_MMA(1, 1, At, B1); PG8_BAR;
            }
        }
        if constexpr (ALIGN_EPI) { if (wr == 0) PG8_BAR; }
        if constexpr (!Epi::AFTER_DRAIN) { E(acc, cur, wr, wc, fr, fq); S.done(cur); }
        if (!has_next) break;
#pragma unroll
        for (int a = 0; a < 2; ++a)
#pragma unroll
            for (int b = 0; b < 2; ++b)
#pragma unroll
                for (int m = 0; m < 4; ++m)
#pragma unroll
                    for (int n = 0; n < 2; ++n) acc[a][b][m][n] = (f32x4){0.f, 0.f, 0.f, 0.f};
        cur = nxt; cA = nA; cB = nB; ++ui;
        if constexpr (ALIGN_EPI) { if (wr == 1) PG8_BAR; }
    }
    PG8_WAIT_V(0);
    if constexpr (!ALIGN_EPI) { if (wr == 0) PG8_BAR; }
    PG8_BAR;
    if constexpr (Epi::AFTER_DRAIN) { E.fused(acc, cur, wr, wc, fr, fq, lds, wid, lane); S.done(cur); }
#undef PG8_SA
#undef PG8_SB
#undef PG8_STAGE
#undef PG8_LDA
#undef PG8_LDB
#undef PG8_MMA
#undef PG8_WAIT_V
#undef PG8_WAIT_L
#undef PG8_BAR
#undef PG8_SCHED
}
}

namespace pg8 {
struct PEpiBf16 { static constexpr bool PERM = true, AFTER_DRAIN = false; bf16_t* O; int ldc;
    __device__ __forceinline__ void operator()(const f32x4 (&acc)[2][2][4][2], const Unit& u, int wr, int wc, int fr, int fq) const {
        const int row0 = u.pm * BM + wr * 64 + fr, col0 = u.pn * BM + wc * 32 + 8 * fq;
#pragma unroll
        for (int ai = 0; ai < 2; ++ai)
#pragma unroll
            for (int m = 0; m < 4; ++m) { bf16_t* rowp = O + (size_t)(row0 + ai * HALF + m * 16) * ldc + col0;
#pragma unroll
                for (int bj = 0; bj < 2; ++bj) { const f32x4 v0 = acc[ai][bj][m][0], v1 = acc[ai][bj][m][1]; u32x4 w;
                    w.x = ::pk2s(v0[0], v0[1]); w.y = ::pk2s(v0[2], v0[3]); w.z = ::pk2s(v1[0], v1[1]); w.w = ::pk2s(v1[2], v1[3]);
                    *(u32x4*)(rowp + bj * HALF) = w; } }
    } };
struct PEpiResid { static constexpr bool PERM = false, AFTER_DRAIN = false; const float* xin; float* xout;
    __device__ __forceinline__ void operator()(const f32x4 (&acc)[2][2][4][2], const Unit& u, int wr, int wc, int fr, int fq) const {
        const int row0 = u.pm * BM + wr * 64 + fr, col0 = u.pn * BM + wc * 32 + 4 * fq;
#pragma unroll
        for (int ai = 0; ai < 2; ++ai)
#pragma unroll
            for (int m = 0; m < 4; ++m) { const size_t off = (size_t)(row0 + ai * HALF + m * 16) * D_MODEL + col0;
#pragma unroll
                for (int bj = 0; bj < 2; ++bj)
#pragma unroll
                    for (int n = 0; n < 2; ++n) { f32x4 v = *(const f32x4*)(xin + off + bj * HALF + n * 16); v += acc[ai][bj][m][n]; *(f32x4*)(xout + off + bj * HALF + n * 16) = v; }
                asm volatile("" ::: "memory"); }
    } };
struct PEpiBf16S { static constexpr bool PERM = true, AFTER_DRAIN = false; bf16_t* O; int ldc; const float* rstd;
    __device__ __forceinline__ void operator()(const f32x4 (&acc)[2][2][4][2], const Unit& u, int wr, int wc, int fr, int fq) const {
        const int row0 = u.pm * BM + wr * 64 + fr, col0 = u.pn * BM + wc * 32 + 8 * fq;
#pragma unroll
        for (int ai = 0; ai < 2; ++ai)
#pragma unroll
            for (int m = 0; m < 4; ++m) { const int row = row0 + ai * HALF + m * 16; const float rs = rstd[row]; bf16_t* rowp = O + (size_t)row * ldc + col0;
#pragma unroll
                for (int bj = 0; bj < 2; ++bj) { const f32x4 v0 = acc[ai][bj][m][0] * rs, v1 = acc[ai][bj][m][1] * rs; u32x4 w;
                    w.x = ::pk2(v0[0], v0[1]); w.y = ::pk2(v0[2], v0[3]); w.z = ::pk2(v1[0], v1[1]); w.w = ::pk2(v1[2], v1[3]);
                    *(u32x4*)(rowp + bj * HALF) = w; } }
    } };
struct PEpiResidX { static constexpr bool PERM = true, AFTER_DRAIN = false; const float* xin; float* xout; bf16_t* xb; float* ssp;
    __device__ __forceinline__ void operator()(const f32x4 (&acc)[2][2][4][2], const Unit& u, int wr, int wc, int fr, int fq) const {
        const int row0 = u.pm * BM + wr * 64 + fr, col0 = u.pn * BM + wc * 32 + 8 * fq;
#pragma unroll
        for (int ai = 0; ai < 2; ++ai)
#pragma unroll
            for (int m = 0; m < 4; ++m) { const int row = row0 + ai * HALF + m * 16; const size_t off = (size_t)row * D_MODEL + col0; float ss = 0.f;
#pragma unroll
                for (int bj = 0; bj < 2; ++bj) { f32x4 v0 = *(const f32x4*)(xin + off + bj * HALF), v1 = *(const f32x4*)(xin + off + bj * HALF + 4);
                    v0 += acc[ai][bj][m][0]; v1 += acc[ai][bj][m][1]; *(f32x4*)(xout + off + bj * HALF) = v0; *(f32x4*)(xout + off + bj * HALF + 4) = v1;
                    ss += ((v0[0] * v0[0] + v0[1] * v0[1]) + (v0[2] * v0[2] + v0[3] * v0[3])) + ((v1[0] * v1[0] + v1[1] * v1[1]) + (v1[2] * v1[2] + v1[3] * v1[3]));
                    u32x4 w; w.x = ::pk2(v0[0], v0[1]); w.y = ::pk2(v0[2], v0[3]); w.z = ::pk2(v1[0], v1[1]); w.w = ::pk2(v1[2], v1[3]); *(u32x4*)(xb + off + bj * HALF) = w; }
                ss += __shfl_xor(ss, 16); ss += __shfl_xor(ss, 32);
                if (fq == 0) ssp[(size_t)row * 32 + u.pn * 4 + wc] = ss;
                asm volatile("" ::: "memory"); }
    } };
template <class Epi> __device__ __forceinline__ void run(LDSA char* lds_phys, const bf16_t* A, int lda, const bf16_t* Bt, int M, int N, int K, const Epi& E) {
    Gemm g{A, Bt, M, N, K, lda}; StaticOrder S; S.init(M, N, (int)gridDim.x, (int)blockIdx.x);
    gemm_phase<Epi, StaticOrder, true, true>((PG8_LAS unsigned char*)lds_phys, g, S, E);
}
}

struct TileDesc { const bf16_t* kp; const bf16_t* vp; const bf16_t* k2p; int kidx0; };
constexpr int ATT_VOFF = 25600, ATT_BOFF = 46080, ATT_VSTR = 320;
constexpr int CMP_POFF = 37888, CMP_PSTR = 68, CMP_LOFF = CMP_POFF + 4 * 32 * CMP_PSTR * 4;

typedef short s16x4 __attribute__((ext_vector_type(4)));
DEVI bf16x8 vfrag(LDSA char* vp) {
    const s16x4 a = __builtin_amdgcn_ds_read_tr16_b64_v4i16((LDSA s16x4*)vp), b = __builtin_amdgcn_ds_read_tr16_b64_v4i16((LDSA s16x4*)(vp + 8 * ATT_VSTR));
    return (bf16x8){a[0], a[1], a[2], a[3], b[0], b[1], b[2], b[3]};
}
template <int C> DEVI void pv_step(LDSA char* vp, f32x16& o, const bf16x8 (&pk)[2][2]) {
    const bf16x8 f00 = vfrag(vp + 64 * C), f01 = vfrag(vp + 16 * ATT_VSTR + 64 * C), f10 = vfrag(vp + 32 * ATT_VSTR + 64 * C), f11 = vfrag(vp + 48 * ATT_VSTR + 64 * C);
    o = mfma32(f00, pk[0][0], o); o = mfma32(f01, pk[0][1], o); o = mfma32(f10, pk[1][0], o); o = mfma32(f11, pk[1][1], o);
}

template <int MODE, class TileFn, class EpiFn>
DEVI void attn_core(LDSA char* lds, int tid, const bf16_t* qrow, int qidx, int qidx0w, int ntiles, int nsync, int kst, int vst, int k2st, TileFn tilefn, const float* btab, int bmax,
                    unsigned long long selm, EpiFn epi) {
    constexpr int DQK = (MODE == 0) ? 192 : 128, KSTR = DQK * 2 + 16, KCH = DQK / 8, NKL = 64 * KCH / 256, NKS = DQK / 16;
    constexpr bool LBIAS = (MODE == 1 || MODE == 2 || MODE == 3);
    const int lane = tid & 63, wave = __builtin_amdgcn_readfirstlane(tid >> 6), n = lane & 31, h = lane >> 5;
    LDSA char* Ks = lds; LDSA char* Vs = lds + (MODE == 4 ? 17408 : ATT_VOFF); LDSA float* Bw = (LDSA float*)(lds + ATT_BOFF) + wave * 96;
    bf16x8 qf[NKS];
#pragma unroll
    for (int ks = 0; ks < NKS; ++ks) qf[ks] = *(const bf16x8*)(qrow + 16 * ks + 8 * h);
    if (MODE == 0) {
        const float* ct = btab + (size_t)qidx * 32 + 8 * h; const float* st = ct + 4096 * 32;
#pragma unroll
        for (int kk = 0; kk < 2; ++kk) { v4i a = __builtin_bit_cast(v4i, qf[8 + kk]), b2 = __builtin_bit_cast(v4i, qf[10 + kk]);
#pragma unroll
            for (int j = 0; j < 4; ++j) { const float c0 = ct[16 * kk + 2 * j], c1 = ct[16 * kk + 2 * j + 1], s0_ = st[16 * kk + 2 * j], s1_ = st[16 * kk + 2 * j + 1];
                const float x10 = lo2f((unsigned)a[j]), x11 = hi2f((unsigned)a[j]), x20 = lo2f((unsigned)b2[j]), x21 = hi2f((unsigned)b2[j]);
                a[j] = (int)pk2(x10 * c0 - x20 * s0_, x11 * c1 - x21 * s1_); b2[j] = (int)pk2(x10 * s0_ + x20 * c0, x11 * s1_ + x21 * c1); }
            qf[8 + kk] = __builtin_bit_cast(bf16x8, a); qf[10 + kk] = __builtin_bit_cast(bf16x8, b2); }
    }
    f32x16 o[4];
#pragma unroll
    for (int c = 0; c < 4; ++c) o[c] = zero16();
    float m = -INFINITY, l = 0.f;
    u32x4 kreg[4], vreg[4]; float breg0 = 0.f, breg1 = 0.f; int next_kidx0 = 0;
    LDSA char* const vp = Vs + (4 * h + ((lane & 15) >> 2)) * ATT_VSTR + (16 * ((lane >> 4) & 1) + 4 * (lane & 3)) * 2;
    const unsigned koff = (unsigned)(tid >> 4) * (unsigned)kst + (tid & 15) * 8, voff = (unsigned)(tid >> 4) * (unsigned)vst + (tid & 15) * 8;
    const unsigned k2off = (unsigned)(tid >> 3) * (unsigned)k2st + (tid & 7) * 8;
    u32x4 k2reg[2];
#define AISSUE(it) do { TileDesc td; tilefn((it), td); next_kidx0 = td.kidx0; \
        _Pragma("unroll") for (int u = 0; u < 4; ++u) kreg[u] = *(const u32x4*)(td.kp + (size_t)(16 * u) * kst + koff); \
        if (MODE == 0) { _Pragma("unroll") for (int u = 0; u < 2; ++u) k2reg[u] = *(const u32x4*)(td.k2p + (size_t)(32 * u) * k2st + k2off); } \
        _Pragma("unroll") for (int u = 0; u < 4; ++u) vreg[u] = *(const u32x4*)(td.vp + (size_t)(16 * u) * vst + voff); \
        if (LBIAS) { const int D0 = qidx0w - td.kidx0; int i0 = D0 + 31 - lane, i1 = D0 + 31 - (lane + 64); \
            breg0 = (i0 >= 0 && i0 <= bmax) ? btab[i0] : 0.f; breg1 = (lane < 32 && i1 >= 0 && i1 <= bmax) ? btab[i1] : 0.f; } } while (0)
    AISSUE(0);
    const int nloop = (MODE == 3) ? nsync : ntiles;
    for (int it = 0; it < nloop; ++it) {
        const int kidx0 = next_kidx0; const bool act = (MODE == 3) ? (it < ntiles) : true;
        __syncthreads();
        if (act) {
#pragma unroll
        for (int u = 0; u < 4; ++u) *(LDSA u32x4*)(Ks + (tid >> 4) * KSTR + (tid & 15) * 16 + u * 16 * KSTR) = kreg[u];
        if (MODE == 0) {
#pragma unroll
            for (int u = 0; u < 2; ++u) *(LDSA u32x4*)(Ks + (tid >> 3) * KSTR + 256 + (tid & 7) * 16 + u * 32 * KSTR) = k2reg[u]; }
#pragma unroll
        for (int u = 0; u < 4; ++u) *(LDSA u32x4*)(Vs + (tid >> 4) * ATT_VSTR + (tid & 15) * 16 + u * 16 * ATT_VSTR) = vreg[u];
        if (LBIAS) { Bw[lane] = breg0; if (lane < 32) Bw[lane + 64] = breg1; }
        }
        __syncthreads();
        if (it + 1 < ntiles) AISSUE(it + 1);
        __builtin_amdgcn_sched_barrier(0);
        const int dlo = qidx0w - (kidx0 + 63);
        const int dhi = qidx0w + 31 - kidx0;
        bool skip = false, full = false; bool selbit = true;
        if (MODE == 0) { skip = dhi < 0; full = dlo >= 0; }
        if (MODE == 1) { skip = dhi < 0 || dlo >= 512; full = dlo >= 0 && dhi < 512; }
        if (MODE == 2) { skip = dhi < 0 || dlo > 128; full = dlo >= 0 && dhi <= 128; }
        if (MODE == 3) { selbit = (selm >> (kidx0 >> 6)) & 1ull; skip = (__ballot(selbit) == 0ull) || dhi < 0; full = false; }
        if (MODE == 4) { skip = false; full = false; }
        if (act && !skip) {
            f32x16 s0 = zero16(), s1 = zero16();
            LDSA char* kb = Ks + n * KSTR + h * 16;
#pragma unroll
            for (int ks = 0; ks < NKS; ++ks) {
                const bf16x8 k0 = *(LDSA bf16x8*)(kb + ks * 32), k1 = *(LDSA bf16x8*)(kb + 32 * KSTR + ks * 32);
                s0 = mfma32(k0, qf[ks], s0); s1 = mfma32(k1, qf[ks], s1);
            }
            const float sc = (MODE == 0) ? 1.0f : NSA_SCALE2;
            int dbase = qidx - kidx0 - 4 * h;
            asm volatile("" : "+v"(dbase));
            float tmax = -INFINITY;
            if (MODE == 3 && dlo >= 0) {
                const float sel_off = selbit ? 0.f : -INFINITY;
#pragma unroll
                for (int mt = 0; mt < 2; ++mt)
#pragma unroll
                    for (int r = 0; r < 16; ++r) {
                        const int ko = 32 * mt + 8 * (r >> 2) + (r & 3);
                        float v = (mt ? s1[r] : s0[r]) * sc + Bw[(31 - n + 4 * h) + ko] + sel_off;
                        if (mt) s1[r] = v; else s0[r] = v;
                        tmax = fmaxf(tmax, v);
                    }
            } else
            if ((MODE == 0 || MODE == 1 || MODE == 2) && full) {
#pragma unroll
                for (int mt = 0; mt < 2; ++mt)
#pragma unroll
                    for (int r = 0; r < 16; ++r) {
                        const int ko = 32 * mt + 8 * (r >> 2) + (r & 3);
                        float v = (mt ? s1[r] : s0[r]) * sc;
                        if (LBIAS) v += Bw[(31 - n + 4 * h) + ko];
                        if (mt) s1[r] = v; else s0[r] = v;
                        tmax = fmaxf(tmax, v);
                    }
            } else {
#pragma unroll
            for (int mt = 0; mt < 2; ++mt)
#pragma unroll
                for (int r = 0; r < 16; ++r) {
                    const int ko = 32 * mt + 8 * (r >> 2) + (r & 3);
                    float v = (mt ? s1[r] : s0[r]) * sc;
                    if (LBIAS) v += Bw[(31 - n + 4 * h) + ko];
                    if (MODE == 4) { const int kidx = kidx0 + 4 * h + ko; const int nvalid = (qidx + 1) >> 6;
                        if (kidx < nvalid) v += btab[qidx - 64 * kidx - 63]; else v = -INFINITY; }
                    else if (!full) { const int dist = dbase - ko; bool ok = dist >= 0;
                        if (MODE == 1) ok = ok && dist < 512;
                        if (MODE == 2) ok = ok && dist <= 128;
                        if (MODE == 3) ok = ok && selbit;
                        if (!ok) v = -INFINITY; }
                    if (mt) s1[r] = v; else s0[r] = v;
                    tmax = fmaxf(tmax, v);
                }
                asm volatile("" ::: "memory");
            }
            tmax = fmaxf(tmax, __shfl_xor(tmax, 32));
            const float mnew = fmaxf(m, tmax), msafe = (mnew == -INFINITY) ? 0.f : mnew;
            const float alpha = fexp2(m - msafe);
            float ps = 0.f;
#pragma unroll
            for (int r = 0; r < 16; ++r) { s0[r] = fexp2(s0[r] - msafe); ps += s0[r]; }
#pragma unroll
            for (int r = 0; r < 16; ++r) { s1[r] = fexp2(s1[r] - msafe); ps += s1[r]; }
            l = l * alpha + ps; m = mnew;
            if (__ballot(alpha != 1.0f) != 0ull) {
#pragma unroll
                for (int c = 0; c < 4; ++c)
#pragma unroll
                    for (int r = 0; r < 16; ++r) o[c][r] *= alpha;
            }
            if (MODE == 4) {
                LDSA float* pb = (LDSA float*)(lds + CMP_POFF) + (wave * 32 + n) * CMP_PSTR + 4 * h;
#pragma unroll
                for (int mt = 0; mt < 2; ++mt)
#pragma unroll
                    for (int g = 0; g < 4; ++g) { f32x4 pv; for (int e = 0; e < 4; ++e) pv[e] = mt ? s1[4 * g + e] : s0[4 * g + e]; *(LDSA f32x4*)(pb + 32 * mt + 8 * g) = pv; }
            }
            bf16x8 pk[2][2];
#pragma unroll
            for (int j = 0; j < 2; ++j) {
                v4i a; a.x = (int)pk2(s0[8 * j], s0[8 * j + 1]); a.y = (int)pk2(s0[8 * j + 2], s0[8 * j + 3]); a.z = (int)pk2(s0[8 * j + 4], s0[8 * j + 5]); a.w = (int)pk2(s0[8 * j + 6], s0[8 * j + 7]);
                pk[0][j] = __builtin_bit_cast(bf16x8, a);
                v4i b; b.x = (int)pk2(s1[8 * j], s1[8 * j + 1]); b.y = (int)pk2(s1[8 * j + 2], s1[8 * j + 3]); b.z = (int)pk2(s1[8 * j + 4], s1[8 * j + 5]); b.w = (int)pk2(s1[8 * j + 6], s1[8 * j + 7]);
                pk[1][j] = __builtin_bit_cast(bf16x8, b);
            }
            pv_step<0>(vp, o[0], pk); pv_step<1>(vp, o[1], pk); pv_step<2>(vp, o[2], pk); pv_step<3>(vp, o[3], pk);
        }
    }
#undef AISSUE
    l += __shfl_xor(l, 32);
    epi(o, l, m);
    __syncthreads();
}

template <int MAP> DEVI int colmap(int n) {
    if (MAP == 1) { if (n < 2560) return n; if (n < 8704) return n + 24; if (n < 8728) return n - 8704 + 2560; return -1; }
    if (MAP == 2) { if (n < 2048) return n; if (n < 4096) return n + 64; if (n < 4160) return n - 4096 + 2048; return -1; }
    return n;
}
template <int MAP>
DEVI void transpose_job(LDSA char* lds, int tid, const float* __restrict__ src, int K, int Nsrc, bf16_t* __restrict__ dst, int Npad, float wscale = 1.0f, const float* __restrict__ kscale = nullptr) {
    LDSA float* T = (LDSA float*)lds;
    const int nKt = K / 64, nNt = Npad / 64, nt = nKt * nNt, G = vgrid();
    for (int t = vblock(); t < nt; t += G) {
        const int kt = t % nKt, ntile = t / nKt, k0 = kt * 64, n0 = ntile * 64;
        const int nl = tid & 63, sc = colmap<MAP>(n0 + nl);
#pragma unroll
        for (int u = 0; u < 16; ++u) { const int kl = (tid >> 6) + 4 * u; T[kl * 65 + nl] = (sc >= 0) ? src[(size_t)(k0 + kl) * Nsrc + sc] * (kscale ? kscale[k0 + kl] : wscale) : 0.f; }
        __syncthreads();
#pragma unroll
        for (int u = 0; u < 2; ++u) { const int c = tid + 256 * u, n2 = c >> 3, kc = c & 7; u32x4 w;
            w.x = pk2(T[(kc * 8 + 0) * 65 + n2], T[(kc * 8 + 1) * 65 + n2]); w.y = pk2(T[(kc * 8 + 2) * 65 + n2], T[(kc * 8 + 3) * 65 + n2]);
            w.z = pk2(T[(kc * 8 + 4) * 65 + n2], T[(kc * 8 + 5) * 65 + n2]); w.w = pk2(T[(kc * 8 + 6) * 65 + n2], T[(kc * 8 + 7) * 65 + n2]);
            *(u32x4*)(dst + (size_t)(n0 + n2) * K + k0 + kc * 8) = w; }
        __syncthreads();
    }
}
DEVI int t5_bucket(int d) { if (d < 16) return d; const float v = __builtin_log2f((float)d * 0.0625f) * (16.0f / 7.0f); int b = 16 + (int)v; return b > 31 ? 31 : b; }

DEVI void phase_prep(const Params& P, LDSA char* lds, int tid) {
    unsigned char* ws = P.ws;
    for (int i = 0; i < 2; ++i) {
        transpose_job<1>(lds, tid, P.ev_w_in + (size_t)i * 2048 * 8728, 2048, 8728, (bf16_t*)(ws + WS_WEVIN + i * SZ_WEVIN), LDZE, 1.0f, P.norm_w + (2 * i) * D_MODEL);
        transpose_job<0>(lds, tid, P.ev_w_out + (size_t)i * 1536 * 2048, 1536, 2048, (bf16_t*)(ws + WS_WEVOUT + i * SZ_WEVOUT), 2048);
        transpose_job<2>(lds, tid, P.od_w_in + (size_t)i * 2048 * 4160, 2048, 4160, (bf16_t*)(ws + WS_WODIN + i * SZ_WODIN), LDZO, 1.0f, P.norm_w + (2 * i + 1) * D_MODEL);
        transpose_job<0>(lds, tid, P.w_qb + (size_t)i * 1536 * 3072, 1536, 3072, (bf16_t*)(ws + WS_WQB + i * SZ_WQB), 3072, MLA_SCALE2);
        transpose_job<0>(lds, tid, P.w_kvb + (size_t)i * 512 * 4096, 512, 4096, (bf16_t*)(ws + WS_WKVB + i * SZ_WKVB), 4096);
        transpose_job<0>(lds, tid, P.od_w_out + (size_t)i * 2048 * 2048, 2048, 2048, (bf16_t*)(ws + WS_WODOUT + i * SZ_WODOUT), 2048);
        for (int kv = 0; kv < 2; ++kv)
            transpose_job<0>(lds, tid, P.cmp_w1 + (size_t)(i * 2 + kv) * 8192 * 128, 8192, 128, (bf16_t*)(ws + WS_W1 + (i * 2 + kv) * SZ_W1), 128);
    }
    const int G = vgrid(), gt = vblock() * GTHREADS + tid, GT = G * GTHREADS;
    float* biasT = (float*)(ws + WS_BIAST); float* biasD = (float*)(ws + WS_BIASD);
    for (int i = gt; i < 20 * 4096; i += GT) { const int hh = i >> 12, d = i & 4095; biasT[i] = P.rel_bias[t5_bucket(d) * 20 + hh] * LOG2E; }
    for (int i = gt; i < 12 * 132; i += GT) { const int gh = i / 132, j = i % 132, g = gh >> 2; const int dd = g == 0 ? 1 : (g == 1 ? 4 : 16);
        biasD[i] = (j <= 128) ? P.rel_bias[t5_bucket(j * dd) * 20 + 8 + gh] * LOG2E : 0.f; }
    float* cosT = (float*)(ws + WS_COS); float* sinT = (float*)(ws + WS_SIN);
    double dz; { int zz = 0; asm volatile("" : "+v"(zz)); dz = (double)zz; }
    for (int i = gt; i < 4096 * 32; i += GT) {
        const int t = i >> 5, fi = i & 31; double f = 1.0; for (int q = 0; q < fi; ++q) f *= 0.7498942093324559;
        const float ang = (float)t * (float)f; const double a = (double)ang; const double kq = __builtin_rint(a * 0.6366197723675814);
        const double r = a - kq * 1.5707963267948966, r2 = r * r;
        const double sn = r * (1.0 + r2 * ((dz - 1.0 / 6) + r2 * ((dz + 1.0 / 120) + r2 * ((dz - 1.0 / 5040) + r2 * ((dz + 1.0 / 362880) + r2 * ((dz - 1.0 / 39916800) + r2 * (dz + 1.0 / 6227020800.0)))))));
        const double cs = 1.0 + r2 * ((dz - 0.5) + r2 * ((dz + 1.0 / 24) + r2 * ((dz - 1.0 / 720) + r2 * ((dz + 1.0 / 40320) + r2 * ((dz - 1.0 / 3628800) + r2 * (dz + 1.0 / 479001600.0))))));
        const int qd = ((int)kq) & 3; double S = sn, C = cs; if (qd == 1) { S = cs; C = -sn; } else if (qd == 2) { S = -sn; C = -cs; } else if (qd == 3) { S = -cs; C = sn; }
        cosT[i] = (float)C; sinT[i] = (float)S;
    }
    float* posp = (float*)(ws + WS_POSP); LDSA float* red = (LDSA float*)lds;
    for (int it = vblock(); it < 32; it += G) {
        const int lkv = it >> 3, part = it & 7, j = tid & 127, half = tid >> 7;
        const float* pos = P.cmp_pos + (size_t)lkv * 8192; const float* w1 = P.cmp_w1 + (size_t)lkv * 8192 * 128;
        float s = 0.f; const int kb = part * 1024 + half * 512;
        for (int k = 0; k < 512; ++k) s += pos[kb + k] * w1[(size_t)(kb + k) * 128 + j];
        __syncthreads(); if (half) red[j] = s; __syncthreads(); if (!half) posp[(lkv * 8 + part) * 128 + j] = s + red[j]; __syncthreads();
    }
}

template <bool OUTF32>
DEVI void phase_rms(const float* __restrict__ x, const float* __restrict__ w, void* outp, int tid) {
    const int lane = tid & 63, wave = __builtin_amdgcn_readfirstlane(tid >> 6), G = vgrid();
    for (int rb = vblock(); rb < MTOK / 4; rb += G) {
        const int row = rb * 4 + wave; const float* xr = x + (size_t)row * D_MODEL;
        f32x4 v[8]; float ss = 0.f;
#pragma unroll
        for (int u = 0; u < 8; ++u) { v[u] = *(const f32x4*)(xr + (u * 64 + lane) * 4); ss += v[u][0] * v[u][0] + v[u][1] * v[u][1] + v[u][2] * v[u][2] + v[u][3] * v[u][3]; }
        ss = wave_sum(ss); const float rstd = rsqrtf(ss * (1.0f / D_MODEL) + 1e-6f);
#pragma unroll
        for (int u = 0; u < 8; ++u) { const f32x4 ww = *(const f32x4*)(w + (u * 64 + lane) * 4); f32x4 y; for (int e = 0; e < 4; ++e) y[e] = v[u][e] * rstd * ww[e];
            if (OUTF32) *(f32x4*)((float*)outp + (size_t)row * D_MODEL + (u * 64 + lane) * 4) = y;
            else { u32x2 pk; pk.x = pk2(y[0], y[1]); pk.y = pk2(y[2], y[3]); *(u32x2*)((bf16_t*)outp + (size_t)row * D_MODEL + (u * 64 + lane) * 4) = pk; } }
    }
}

DEVI void phase_xb(const float* __restrict__ x, bf16_t* xb, float* rstd, int tid) {
    const int lane = tid & 63, wave = __builtin_amdgcn_readfirstlane(tid >> 6), G = vgrid();
    for (int rb = vblock(); rb < MTOK / 4; rb += G) {
        const int row = rb * 4 + wave; const float* xr = x + (size_t)row * D_MODEL;
        f32x4 v[8]; float ss = 0.f;
#pragma unroll
        for (int u = 0; u < 8; ++u) { v[u] = *(const f32x4*)(xr + (u * 64 + lane) * 4); ss += v[u][0] * v[u][0] + v[u][1] * v[u][1] + v[u][2] * v[u][2] + v[u][3] * v[u][3]; }
        ss = wave_sum(ss); if (lane == 0) rstd[row] = rsqrtf(ss * (1.0f / D_MODEL) + 1e-6f);
#pragma unroll
        for (int u = 0; u < 8; ++u) { u32x2 pk; pk.x = pk2(v[u][0], v[u][1]); pk.y = pk2(v[u][2], v[u][3]); *(u32x2*)(xb + (size_t)row * D_MODEL + (u * 64 + lane) * 4) = pk; }
    }
}
DEVI void phase_rstd(const float* __restrict__ ssp, float* rstd, int tid) {
    const int G = vgrid();
    for (int row = vblock() * GTHREADS + tid; row < MTOK; row += G * GTHREADS) {
        const f32x4* p = (const f32x4*)(ssp + (size_t)row * 32); float s = 0.f;
#pragma unroll
        for (int u = 0; u < 8; ++u) { const f32x4 a = p[u]; s += (a[0] + a[1]) + (a[2] + a[3]); }
        rstd[row] = rsqrtf(s * (1.0f / D_MODEL) + 1e-6f);
    }
}

DEVI void phase_norms(bf16_t* z, const float* __restrict__ qn, const float* __restrict__ kvn, const float* cosT, const float* sinT, int tid) {
    const int lane = tid & 63, wave = __builtin_amdgcn_readfirstlane(tid >> 6), G = vgrid();
    for (int rb = vblock(); rb < MTOK / 4; rb += G) {
        const int row = rb * 4 + wave; bf16_t* zr = z + (size_t)row * LDZO;
        u32x4 c[3]; float ss = 0.f;
#pragma unroll
        for (int u = 0; u < 3; ++u) { c[u] = *(const u32x4*)(zr + OC_CQ + (u * 64 + lane) * 8);
#pragma unroll
            for (int e = 0; e < 4; ++e) { const float a = lo2f(c[u][e]), b = hi2f(c[u][e]); ss += a * a + b * b; } }
        ss = wave_sum(ss); float rstd = rsqrtf(ss * (1.0f / 1536) + 1e-6f);
#pragma unroll
        for (int u = 0; u < 3; ++u) { const float* wp = qn + (u * 64 + lane) * 8; u32x4 o;
#pragma unroll
            for (int e = 0; e < 4; ++e) o[e] = pk2(lo2f(c[u][e]) * rstd * wp[2 * e], hi2f(c[u][e]) * rstd * wp[2 * e + 1]);
            *(u32x4*)(zr + OC_CQ + (u * 64 + lane) * 8) = o; }
        u32x4 k = *(const u32x4*)(zr + OC_CKV + lane * 8); ss = 0.f;
#pragma unroll
        for (int e = 0; e < 4; ++e) { const float a = lo2f(k[e]), b = hi2f(k[e]); ss += a * a + b * b; }
        ss = wave_sum(ss); rstd = rsqrtf(ss * (1.0f / 512) + 1e-6f);
        { const float* wp = kvn + lane * 8; u32x4 o;
#pragma unroll
            for (int e = 0; e < 4; ++e) o[e] = pk2(lo2f(k[e]) * rstd * wp[2 * e], hi2f(k[e]) * rstd * wp[2 * e + 1]);
            *(u32x4*)(zr + OC_CKV + lane * 8) = o; }
        const int t = row & (SEQ - 1), i = lane & 31;
        const float x1 = bf2f(zr[OC_KPE + i]), x2 = bf2f(zr[OC_KPE + 32 + i]); const float cs = cosT[t * 32 + i], sn = sinT[t * 32 + i];
        const float r = (lane < 32) ? (x1 * cs - x2 * sn) : (x1 * sn + x2 * cs);
        zr[OC_KPE + lane] = (bf16_t)(pk2(r, r) & 0xffff);
    }
}

DEVI void phase_cmp2(const Params& P, int layer_i, LDSA char* lds, int tid) {
    unsigned char* ws = P.ws; const int G = vgrid(); LDSA float* S = (LDSA float*)lds;
    const float* part = (const float*)(ws + WS_CMPP); const float* posp = (const float*)(ws + WS_POSP);
    for (int it = vblock(); it < 128; it += G) {
        const int kv = it >> 6, r0 = (it & 63) * 16, lkv = layer_i * 2 + kv;
#pragma unroll
        for (int u = 0; u < 8; ++u) { const int e = tid + 256 * u, r = e >> 7, j = e & 127; float s = 0.f;
            for (int sp = 0; sp < 8; ++sp) s += part[((size_t)(kv * 8 + sp) * 1024 + r0 + r) * 128 + j] + posp[(lkv * 8 + sp) * 128 + j];
            S[e] = siluf_(s); }
        __syncthreads();
        const int j = tid & 127, rh = tid >> 7; const float* w2 = P.cmp_w2 + (size_t)lkv * 128 * 128; float acc[8];
#pragma unroll
        for (int r = 0; r < 8; ++r) acc[r] = 0.f;
        for (int k = 0; k < 128; ++k) { const float w = w2[k * 128 + j];
#pragma unroll
            for (int r = 0; r < 8; ++r) acc[r] += S[(rh * 8 + r) * 128 + k] * w; }
        bf16_t* dst = (bf16_t*)(ws + (kv ? WS_VCMP : WS_KCMP));
#pragma unroll
        for (int r = 0; r < 8; ++r) dst[(size_t)(r0 + rh * 8 + r) * 128 + j] = (bf16_t)(pk2(acc[r], acc[r]) & 0xffff);
        __syncthreads();
    }
}

DEVI void item_win(const Params& P, LDSA char* lds, int tid, int item) {
    const bf16_t* z = (const bf16_t*)(P.ws + WS_R1); bf16_t* owin = (bf16_t*)(P.ws + WS_H) + (size_t)MTOK * 1024;
    const int g = item & 1, ch = (item >> 1) & 127, b = item >> 8, t0 = ch * 32, lane = tid & 63, wave = __builtin_amdgcn_readfirstlane(tid >> 6), n = lane & 31, hg = g * 4 + wave;
    const int kfirst = (t0 - 511 > 0 ? t0 - 511 : 0) & ~63, klast = (t0 + 31) & ~63, ntiles = (klast - kfirst) / 64 + 1;
    const bf16_t* zb = z + (size_t)b * SEQ * LDZE;
    auto tilefn = [&](int it, TileDesc& td) { const int k0 = kfirst + it * 64; td.kp = zb + (size_t)k0 * LDZE + EC_KW + g * 128; td.vp = zb + (size_t)k0 * LDZE + EC_VW + g * 128;
        td.k2p = nullptr; td.kidx0 = k0; };
    const size_t row = (size_t)b * SEQ + t0 + n;
    auto epi = [&](f32x16 (&o)[4], float l, float) { const float inv = l > 0.f ? 1.0f / l : 0.f; const int h = lane >> 5;
#pragma unroll
        for (int c = 0; c < 4; ++c)
#pragma unroll
            for (int q = 0; q < 4; ++q) { u32x2 w; w.x = pk2(o[c][4 * q] * inv, o[c][4 * q + 1] * inv); w.y = pk2(o[c][4 * q + 2] * inv, o[c][4 * q + 3] * inv);
                *(u32x2*)(owin + row * 1024 + hg * 128 + 32 * c + 8 * q + 4 * h) = w; } };
    attn_core<1>(lds, tid, zb + (size_t)(t0 + n) * LDZE + EC_QA + hg * 128, t0 + n, t0, ntiles, ntiles, LDZE, LDZE, 0, tilefn, (const float*)(P.ws + WS_BIAST) + hg * 4096, 4095, 0ull, epi);
}

DEVI void item_dil(const Params& P, LDSA char* lds, int tid, int item) {
    const bf16_t* z = (const bf16_t*)(P.ws + WS_R1); bf16_t* dout = (bf16_t*)(P.ws + WS_DIL); float* lse = (float*)(P.ws + WS_LSE);
    const int sub = (item >> 1) & 31, gh = ((item >> 6) % 6) * 2 + (item & 1), b = item / (32 * 12), g = gh >> 2, hh = gh & 3, lane = tid & 63, wave = __builtin_amdgcn_readfirstlane(tid >> 6), n = lane & 31;
    const int dd = g == 0 ? 1 : (g == 1 ? 4 : 16), cpr = 32 / dd  , r = sub / cpr, i0 = (sub % cpr) * 128;
    const int kfirst = i0 >= 128 ? i0 - 128 : 0, ntiles = (i0 + 128 - kfirst) / 64;
    const bf16_t* zb = z + ((size_t)b * SEQ + r) * LDZE;
    const int st = dd * LDZE;
    auto tilefn = [&](int it, TileDesc& td) { const int k0 = kfirst + it * 64; td.kp = zb + (size_t)k0 * st + EC_KB + gh * 128; td.vp = zb + (size_t)k0 * st + EC_VB + gh * 128;
        td.k2p = nullptr; td.kidx0 = k0; };
    const int qi = i0 + 32 * wave + n; const size_t row = (size_t)b * SEQ + r + (size_t)dd * qi;
    auto epi = [&](f32x16 (&o)[4], float l, float m) { const float inv = l > 0.f ? 1.0f / l : 0.f; const int h = lane >> 5;
        bf16_t* op = dout + ((size_t)g * MTOK + row) * 512 + hh * 128;
#pragma unroll
        for (int c = 0; c < 4; ++c)
#pragma unroll
            for (int q = 0; q < 4; ++q) { u32x2 w; w.x = pk2(o[c][4 * q] * inv, o[c][4 * q + 1] * inv); w.y = pk2(o[c][4 * q + 2] * inv, o[c][4 * q + 3] * inv);
                *(u32x2*)(op + 32 * c + 8 * q + 4 * h) = w; }
        if (h == 0) lse[((size_t)g * MTOK + row) * 4 + hh] = m + __builtin_log2f(l); };
    attn_core<2>(lds, tid, zb + (size_t)qi * st + EC_QB + gh * 128, qi, i0 + 32 * wave, ntiles, ntiles, st, st, 0, tilefn, (const float*)(P.ws + WS_BIASD) + gh * 132, 128, 0ull, epi);
}

DEVI void item_cmp1(const Params& P, int layer_i, LDSA char* lds, int tid, int item) {
    const int sp = item & 7, pm = (item >> 3) & 3, kv = item >> 5;
    AFCmp af{(const bf16_t*)(P.ws + WS_R1), kv ? EC_VC : EC_KC};
    EpiF32 ef{(float*)(P.ws + WS_CMPP) + (size_t)(kv * 8 + sp) * 1024 * 128, 128};
    gemm_tile4(lds, tid, af, (const bf16_t*)(P.ws + WS_W1 + (layer_i * 2 + kv) * SZ_W1), 8192, sp * 16, 16, pm * 256, 0, ef);
}

DEVI void item_cmpatt(const Params& P, LDSA char* lds, int tid, int item) {
    const bf16_t* z = (const bf16_t*)(P.ws + WS_R1); bf16_t* ocmp = (bf16_t*)(P.ws + WS_H);
    const int g = item & 1, ch = (item >> 1) & 127, b = item >> 8, t0 = ch * 32, lane = tid & 63, wave = __builtin_amdgcn_readfirstlane(tid >> 6), n = lane & 31, hg = g * 4 + wave;
    const bf16_t* kc = (const bf16_t*)(P.ws + WS_KCMP) + (size_t)(b * 2 + g) * 64 * 128; const bf16_t* vc = (const bf16_t*)(P.ws + WS_VCMP) + (size_t)(b * 2 + g) * 64 * 128;
    auto tilefn = [&](int, TileDesc& td) { td.kp = kc; td.vp = vc; td.k2p = nullptr; td.kidx0 = 0; };
    const size_t row = (size_t)b * SEQ + t0 + n;
    auto epi = [&](f32x16 (&o)[4], float l, float) { const float inv = l > 0.f ? 1.0f / l : 0.f; const int h = lane >> 5;
#pragma unroll
        for (int c = 0; c < 4; ++c)
#pragma unroll
            for (int q = 0; q < 4; ++q) { u32x2 w; w.x = pk2(o[c][4 * q] * inv, o[c][4 * q + 1] * inv); w.y = pk2(o[c][4 * q + 2] * inv, o[c][4 * q + 3] * inv);
                *(u32x2*)(ocmp + row * 1024 + hg * 128 + 32 * c + 8 * q + 4 * h) = w; }
        if (h == 0) ((LDSA float*)(lds + CMP_LOFF))[wave * 32 + n] = inv; };
    attn_core<4>(lds, tid, z + ((size_t)b * SEQ + t0 + n) * LDZE + EC_QA + hg * 128, t0 + n, t0, 1, 1, 128, 128, 0, tilefn, (const float*)(P.ws + WS_BIAST) + hg * 4096, 4095, 0ull, epi);
    LDSA float* pb = (LDSA float*)(lds + CMP_POFF); LDSA float* linv = (LDSA float*)(lds + CMP_LOFF); LDSA float* imp = (LDSA float*)lds;
    const int qi = tid >> 3, part = tid & 7, t = t0 + qi, cur = t >> 6;
#pragma unroll
    for (int e = 0; e < 8; ++e) { const int j = part * 8 + e; float s = 0.f;
#pragma unroll
        for (int w = 0; w < 4; ++w) s += pb[(w * 32 + qi) * CMP_PSTR + j] * linv[w * 32 + qi];
        if (j == 0 || j == cur || j == cur - 1) s = INFINITY;
        imp[qi * 64 + j] = s; }
    __syncthreads();
    unsigned long long bits = 0ull;
#pragma unroll
    for (int e = 0; e < 8; ++e) { const int j = part * 8 + e; const float vj = imp[qi * 64 + j]; int cnt = 0;
        for (int i = 0; i <= cur; ++i) { const float vi = imp[qi * 64 + i]; cnt += (vi > vj || (vi == vj && i < j)) ? 1 : 0; }
        if (j <= cur && cnt < 16) bits |= 1ull << j; }
    bits |= __shfl_xor(bits, 1); bits |= __shfl_xor(bits, 2); bits |= __shfl_xor(bits, 4);
    if (part == 0) ((unsigned long long*)(P.ws + WS_SEL))[(size_t)(b * 2 + g) * SEQ + t] = bits;
    __syncthreads();
}

DEVI void item_slc(const Params& P, LDSA char* lds, int tid, int item) {
    bf16_t* z = (bf16_t*)(P.ws + WS_R1); const bf16_t* ocmp = (const bf16_t*)(P.ws + WS_H); const bf16_t* owin = ocmp + (size_t)MTOK * 1024;
    const int g = item & 1, ch = (item >> 1) & 127, b = item >> 8, t0 = ch * 32, lane = tid & 63, wave = __builtin_amdgcn_readfirstlane(tid >> 6), n = lane & 31, hg = g * 4 + wave;
    const unsigned long long selm = ((const unsigned long long*)(P.ws + WS_SEL))[(size_t)(b * 2 + g) * SEQ + t0 + n];
    unsigned long long U = selm;
#pragma unroll
    for (int o = 16; o >= 1; o >>= 1) U |= __shfl_xor(U, o);
    { const unsigned ulo = __builtin_amdgcn_readfirstlane((unsigned)U), uhi = __builtin_amdgcn_readfirstlane((unsigned)(U >> 32)); U = ((unsigned long long)uhi << 32) | ulo; }
    const int ntiles = __popcll(U); unsigned long long rem = U;
    LDSA int* xw = (LDSA int*)(lds - grp_() * GRP_LDS + LDS_BYTES - 64);
    if (tid == 0) xw[grp_()] = ntiles;
    __syncthreads();
    const int nsync = xw[0] > xw[1] ? xw[0] : xw[1];
    const bf16_t* zb = z + (size_t)b * SEQ * LDZE;
    auto tilefn = [&](int, TileDesc& td) { const int j = __ffsll((long long)rem) - 1; rem &= rem - 1; const int k0 = j * 64;
        td.kp = zb + (size_t)k0 * LDZE + EC_KS + g * 128; td.vp = zb + (size_t)k0 * LDZE + EC_VS + g * 128; td.k2p = nullptr; td.kidx0 = k0; };
    const size_t row = (size_t)b * SEQ + t0 + n;
    auto epi = [&](f32x16 (&o)[4], float l, float) { if (P.dry) return; const float inv = l > 0.f ? 1.0f / l : 0.f;
        const int tq = opq(tid), h = (tq >> 5) & 1, hg = g * 4 + (tq >> 6); const size_t row = (size_t)b * SEQ + t0 + (tq & 31);
        bf16_t* zr = z + row * LDZE;
        const float g0 = sigmoidf_(bf2f(zr[EC_G3 + hg * 3 + 0])), g1 = sigmoidf_(bf2f(zr[EC_G3 + hg * 3 + 1])) * inv, g2 = sigmoidf_(bf2f(zr[EC_G3 + hg * 3 + 2]));
#pragma unroll
        for (int c = 0; c < 4; ++c)
#pragma unroll
            for (int q = 0; q < 4; ++q) { const int dv = hg * 128 + 32 * c + 8 * q + 4 * h;
                const u32x2 oc = *(const u32x2*)(ocmp + row * 1024 + dv), ow = *(const u32x2*)(owin + row * 1024 + dv), gt = *(const u32x2*)(zr + EC_GATEA + dv);
                const float m0 = (g0 * lo2f(oc.x) + g1 * o[c][4 * q] + g2 * lo2f(ow.x)) * siluf_(lo2f(gt.x));
                const float m1 = (g0 * hi2f(oc.x) + g1 * o[c][4 * q + 1] + g2 * hi2f(ow.x)) * siluf_(hi2f(gt.x));
                const float m2 = (g0 * lo2f(oc.y) + g1 * o[c][4 * q + 2] + g2 * lo2f(ow.y)) * siluf_(lo2f(gt.y));
                const float m3 = (g0 * hi2f(oc.y) + g1 * o[c][4 * q + 3] + g2 * hi2f(ow.y)) * siluf_(hi2f(gt.y));
                u32x2 w; w.x = pk2(m0, m1); w.y = pk2(m2, m3); *(u32x2*)(zr + EC_GATEA + dv) = w;
                if (q & 1) { asm volatile("" ::: "memory"); __builtin_amdgcn_sched_barrier(0); } } };
    attn_core<3>(lds, tid, zb + (size_t)(t0 + n) * LDZE + EC_QA + hg * 128, t0 + n, t0, ntiles, nsync, LDZE, LDZE, 0, tilefn, (const float*)(P.ws + WS_BIAST) + hg * 4096, 4095, selm, epi);
}

DEVI void item_mixb(const Params& P, int tid, int item) {
    bf16_t* z = (bf16_t*)(P.ws + WS_R1); const bf16_t* dout = (const bf16_t*)(P.ws + WS_DIL); const float* lse = (const float*)(P.ws + WS_LSE);
    const int lane = tid & 63, wave = __builtin_amdgcn_readfirstlane(tid >> 6), hh = lane >> 4; const size_t row = (size_t)item * 4 + wave;
    const float l0 = lse[row * 4 + hh], l1 = lse[((size_t)MTOK + row) * 4 + hh], l2 = lse[((size_t)2 * MTOK + row) * 4 + hh];
    const float mx = fmaxf(l0, fmaxf(l1, l2)); float a0 = fexp2(l0 - mx), a1 = fexp2(l1 - mx), a2 = fexp2(l2 - mx); const float is = 1.0f / (a0 + a1 + a2); a0 *= is; a1 *= is; a2 *= is;
    const u32x4 o0 = *(const u32x4*)(dout + row * 512 + lane * 8), o1 = *(const u32x4*)(dout + ((size_t)MTOK + row) * 512 + lane * 8), o2 = *(const u32x4*)(dout + ((size_t)2 * MTOK + row) * 512 + lane * 8);
    const u32x4 gt = *(const u32x4*)(z + row * LDZE + EC_GATEB + lane * 8); bf16_t* gp = z + row * LDZE + EC_QB + lane * 8; u32x4 w;
#pragma unroll
    for (int e = 0; e < 4; ++e) { const float lo = (a0 * lo2f(o0[e]) + a1 * lo2f(o1[e]) + a2 * lo2f(o2[e])) * siluf_(lo2f(gt[e]));
        const float hi = (a0 * hi2f(o0[e]) + a1 * hi2f(o1[e]) + a2 * hi2f(o2[e])) * siluf_(hi2f(gt[e])); w[e] = pk2(lo, hi); }
    if (!P.dry) *(u32x4*)gp = w;
}

DEVI void item_mla(const Params& P, LDSA char* lds, int tid, int item) {
    bf16_t* z = (bf16_t*)(P.ws + WS_R1); const bf16_t* kvb = (const bf16_t*)(P.ws + WS_KV); const bf16_t* q = (const bf16_t*)(P.ws + WS_H);
    const int bh = 2 * ((item >> 3) & 63) + (item & 1), r_ = ((item >> 1) & 3) + 4 * (item >> 9), kk_ = r_ >> 2, j_ = r_ & 3;
    const int qb = 31 - ((kk_ & 1) ? 4 * kk_ + 3 - j_ : 4 * kk_ + j_), hd = bh & 15, b = bh >> 4, lane = tid & 63, wave = __builtin_amdgcn_readfirstlane(tid >> 6), n = lane & 31;
    const int q0 = qb * 128, ntiles = (q0 + 128) / 64;
    const bf16_t* kvr = kvb + (size_t)b * SEQ * 4096 + hd * 256; const bf16_t* zb = z + (size_t)b * SEQ * LDZO;
    auto tilefn = [&](int it, TileDesc& td) { const int k0 = it * 64; td.kp = kvr + (size_t)k0 * 4096; td.vp = kvr + (size_t)k0 * 4096 + 128;
        td.k2p = zb + (size_t)k0 * LDZO + OC_KPE; td.kidx0 = k0; };
    const int qi = q0 + 32 * wave + n; const size_t row = (size_t)b * SEQ + qi;
    auto epi = [&](f32x16 (&o)[4], float l, float) { if (P.dry) return; const float inv = l > 0.f ? 1.0f / l : 0.f; const int h = lane >> 5; bf16_t* gp = z + row * LDZO + OC_GATE + hd * 128;
#pragma unroll
        for (int c = 0; c < 4; ++c)
#pragma unroll
            for (int qq = 0; qq < 4; ++qq) { bf16_t* p = gp + 32 * c + 8 * qq + 4 * h; const u32x2 gt = *(const u32x2*)p; u32x2 w;
                w.x = pk2(o[c][4 * qq] * inv * siluf_(lo2f(gt.x)), o[c][4 * qq + 1] * inv * siluf_(hi2f(gt.x)));
                w.y = pk2(o[c][4 * qq + 2] * inv * siluf_(lo2f(gt.y)), o[c][4 * qq + 3] * inv * siluf_(hi2f(gt.y))); *(u32x2*)p = w; } };
    attn_core<0>(lds, tid, q + row * 3072 + hd * 192, qi, q0 + 32 * wave, ntiles, ntiles, 4096, 4096, LDZO, tilefn, (const float*)(P.ws + WS_COS), 0, 0ull, epi);
}


template <class EpiFn>
DEVI void mla_core8(LDSA char* lds, int tid, const bf16_t* qrow, int qidx, int qidx0w, int ntiles, const bf16_t* kvr  , const bf16_t* kpe  ,
                    const float* ctab, EpiFn epi) {
    constexpr int KSTR = 400, STG = 46080, NKS = 12;
    const int lane = tid & 63, n = lane & 31, h = lane >> 5;
    bf16x8 qf[NKS];
#pragma unroll
    for (int ks = 0; ks < NKS; ++ks) qf[ks] = *(const bf16x8*)(qrow + 16 * ks + 8 * h);
    {
        const float* ct = ctab + (size_t)qidx * 32 + 8 * h; const float* st = ct + 4096 * 32;
#pragma unroll
        for (int kk = 0; kk < 2; ++kk) { v4i a = __builtin_bit_cast(v4i, qf[8 + kk]), b2 = __builtin_bit_cast(v4i, qf[10 + kk]);
#pragma unroll
            for (int j = 0; j < 4; ++j) { const float c0 = ct[16 * kk + 2 * j], c1 = ct[16 * kk + 2 * j + 1], s0_ = st[16 * kk + 2 * j], s1_ = st[16 * kk + 2 * j + 1];
                const float x10 = lo2f((unsigned)a[j]), x11 = hi2f((unsigned)a[j]), x20 = lo2f((unsigned)b2[j]), x21 = hi2f((unsigned)b2[j]);
                a[j] = (int)pk2(x10 * c0 - x20 * s0_, x11 * c1 - x21 * s1_); b2[j] = (int)pk2(x10 * s0_ + x20 * c0, x11 * s1_ + x21 * c1); }
            qf[8 + kk] = __builtin_bit_cast(bf16x8, a); qf[10 + kk] = __builtin_bit_cast(bf16x8, b2); }
    }
    f32x16 o[4];
#pragma unroll
    for (int c = 0; c < 4; ++c) o[c] = zero16();
    float m = -INFINITY, l = 0.f;
    u32x4 kreg[2], k2reg, vreg[2];
    const unsigned koff = (unsigned)(tid >> 4) * 4096u + (tid & 15) * 8, k2off = (unsigned)(tid >> 3) * (unsigned)LDZO + (tid & 7) * 8;
    LDSA char* const vp0 = lds + 25600 + (4 * h + ((lane & 15) >> 2)) * ATT_VSTR + (16 * ((lane >> 4) & 1) + 4 * (lane & 3)) * 2;
#define MISSUE(it) do { const bf16_t* kp_ = kvr + (size_t)(it) * 64 * 4096; \
        _Pragma("unroll") for (int u = 0; u < 2; ++u) { kreg[u] = *(const u32x4*)(kp_ + (size_t)(32 * u) * 4096 + koff); vreg[u] = *(const u32x4*)(kp_ + 128 + (size_t)(32 * u) * 4096 + koff); } \
        k2reg = *(const u32x4*)(kpe + (size_t)(it) * 64 * LDZO + k2off); } while (0)
#define MSTORE(s) do { LDSA char* ks_ = lds + (s) * STG; \
        _Pragma("unroll") for (int u = 0; u < 2; ++u) { *(LDSA u32x4*)(ks_ + (tid >> 4) * KSTR + (tid & 15) * 16 + u * 32 * KSTR) = kreg[u]; \
            *(LDSA u32x4*)(ks_ + 25600 + (tid >> 4) * ATT_VSTR + (tid & 15) * 16 + u * 32 * ATT_VSTR) = vreg[u]; } \
        *(LDSA u32x4*)(ks_ + (tid >> 3) * KSTR + 256 + (tid & 7) * 16) = k2reg; } while (0)
    MISSUE(0); MSTORE(0);
    if (ntiles > 1) MISSUE(1);
    __syncthreads();
    for (int it = 0; it < ntiles; ++it) {
        const int kidx0 = it * 64, stg = (it & 1) * STG;
        const int dlo = qidx0w - (kidx0 + 63), dhi = qidx0w + 31 - kidx0;
        const bool skip = dhi < 0, full = dlo >= 0;
        if (!skip) {
            f32x16 s0 = zero16(), s1 = zero16();
            LDSA char* kb = lds + stg + n * KSTR + h * 16;
#pragma unroll
            for (int ks = 0; ks < NKS; ++ks) {
                const bf16x8 k0 = *(LDSA bf16x8*)(kb + ks * 32), k1 = *(LDSA bf16x8*)(kb + 32 * KSTR + ks * 32);
                s0 = mfma32(k0, qf[ks], s0); s1 = mfma32(k1, qf[ks], s1);
            }
            int dbase = qidx - kidx0 - 4 * h;
            asm volatile("" : "+v"(dbase));
            float tmax = -INFINITY;
            if (full) {
#pragma unroll
                for (int r = 0; r < 16; ++r) tmax = fmaxf(tmax, fmaxf(s0[r], s1[r]));
            } else {
#pragma unroll
                for (int mt = 0; mt < 2; ++mt)
#pragma unroll
                    for (int r = 0; r < 16; ++r) {
                        const int ko = 32 * mt + 8 * (r >> 2) + (r & 3);
                        float v = mt ? s1[r] : s0[r];
                        if (dbase - ko < 0) v = -INFINITY;
                        if (mt) s1[r] = v; else s0[r] = v;
                        tmax = fmaxf(tmax, v);
                    }
                asm volatile("" ::: "memory");
            }
            tmax = fmaxf(tmax, __shfl_xor(tmax, 32));
            const float mnew = fmaxf(m, tmax), msafe = (mnew == -INFINITY) ? 0.f : mnew;
            const float alpha = fexp2(m - msafe);
            float ps = 0.f;
#pragma unroll
            for (int r = 0; r < 16; ++r) { s0[r] = fexp2(s0[r] - msafe); ps += s0[r]; }
#pragma unroll
            for (int r = 0; r < 16; ++r) { s1[r] = fexp2(s1[r] - msafe); ps += s1[r]; }
            l = l * alpha + ps; m = mnew;
            if (__ballot(alpha != 1.0f) != 0ull) {
#pragma unroll
                for (int c = 0; c < 4; ++c)
#pragma unroll
                    for (int r = 0; r < 16; ++r) o[c][r] *= alpha;
            }
            bf16x8 pk[2][2];
#pragma unroll
            for (int j = 0; j < 2; ++j) {
                v4i a; a.x = (int)pk2(s0[8 * j], s0[8 * j + 1]); a.y = (int)pk2(s0[8 * j + 2], s0[8 * j + 3]); a.z = (int)pk2(s0[8 * j + 4], s0[8 * j + 5]); a.w = (int)pk2(s0[8 * j + 6], s0[8 * j + 7]);
                pk[0][j] = __builtin_bit_cast(bf16x8, a);
                v4i b; b.x = (int)pk2(s1[8 * j], s1[8 * j + 1]); b.y = (int)pk2(s1[8 * j + 2], s1[8 * j + 3]); b.z = (int)pk2(s1[8 * j + 4], s1[8 * j + 5]); b.w = (int)pk2(s1[8 * j + 6], s1[8 * j + 7]);
                pk[1][j] = __builtin_bit_cast(bf16x8, b);
            }
            LDSA char* const vp = vp0 + stg;
            pv_step<0>(vp, o[0], pk); pv_step<1>(vp, o[1], pk); pv_step<2>(vp, o[2], pk); pv_step<3>(vp, o[3], pk);
        }
        if (it + 1 < ntiles) MSTORE((it + 1) & 1);
        if (it + 2 < ntiles) MISSUE(it + 2);
        __syncthreads();
    }
#undef MISSUE
#undef MSTORE
    l += __shfl_xor(l, 32);
    epi(o, l, m);
}

DEVI void item_mla8(const Params& P, LDSA char* lds, int tid, int item) {
    bf16_t* z = (bf16_t*)(P.ws + WS_R1); const bf16_t* kvb = (const bf16_t*)(P.ws + WS_KV); const bf16_t* q = (const bf16_t*)(P.ws + WS_H);
    const int bh = (item >> 1) & 127, kk_ = item >> 8, j_ = item & 1, qb = 15 - ((kk_ & 1) ? 2 * kk_ + 1 - j_ : 2 * kk_ + j_), hd = bh & 15, b = bh >> 4;
    const int lane = tid & 63, wave = __builtin_amdgcn_readfirstlane(tid >> 6), n = lane & 31, q0 = qb * 256, ntiles = (q0 + 256) / 64;
    const bf16_t* kvr = kvb + (size_t)b * SEQ * 4096 + hd * 256; const bf16_t* kpe = z + (size_t)b * SEQ * LDZO + OC_KPE;
    const int qi = q0 + 32 * wave + n; const size_t row = (size_t)b * SEQ + qi;
    auto epi = [&](f32x16 (&o)[4], float l, float) { if (P.dry) return; const float inv = l > 0.f ? 1.0f / l : 0.f; const int h = lane >> 5; bf16_t* gp = z + row * LDZO + OC_GATE + hd * 128;
#pragma unroll
        for (int c = 0; c < 4; ++c)
#pragma unroll
            for (int qq = 0; qq < 4; ++qq) { bf16_t* p = gp + 32 * c + 8 * qq + 4 * h; const u32x2 gt = *(const u32x2*)p; u32x2 w;
                w.x = pk2(o[c][4 * qq] * inv * siluf_(lo2f(gt.x)), o[c][4 * qq + 1] * inv * siluf_(hi2f(gt.x)));
                w.y = pk2(o[c][4 * qq + 2] * inv * siluf_(lo2f(gt.y)), o[c][4 * qq + 3] * inv * siluf_(hi2f(gt.y))); *(u32x2*)p = w; } };
    mla_core8(lds, tid, q + row * 3072 + hd * 192, qi, q0 + 32 * wave, ntiles, kvr, kpe, (const float*)(P.ws + WS_COS), epi);
}

constexpr int N_PHASES = 28;
DEVI void run_phase(const Params& P, int ph, LDSA char* lds, int tid) {
    unsigned char* ws = P.ws; const int G = vgrid(), v = vblock();
    bf16_t* hbuf = (bf16_t*)(ws + WS_H); bf16_t* zbuf = (bf16_t*)(ws + WS_R1);
    if (ph == 0) { phase_prep(P, lds, opq(tid)); phase_xb(P.x, hbuf, (float*)(ws + WS_RSTD), opq(tid)); return; }
    if (ph == 27) { phase_rms<true>(P.out, P.final_norm_w, P.out, opq(tid)); return; }
    int layer, sub; { const int q = ph - 1; if (q < 7) { layer = 0; sub = q; } else if (q < 13) { layer = 1; sub = q - 7; } else if (q < 20) { layer = 2; sub = q - 13; } else { layer = 3; sub = q - 20; } }
    const int li = layer >> 1; const float* xin = (layer == 0) ? P.x : P.out;
#ifdef DBG_LAYERS
    if (!((DBG_LAYERS >> layer) & 1)) {
        if (layer == 0 && sub == 6) { for (size_t i = (size_t)blockIdx.x * NTHREADS + tid; i < (size_t)MTOK * D_MODEL / 4; i += (size_t)G * NTHREADS) ((f32x4*)P.out)[i] = ((const f32x4*)P.x)[i]; }
        return;
    }
#endif
#ifdef DBG_SKIP_SUB
    if ((DBG_SKIP_SUB >> sub) & 1) return;
#endif
    if (sub == 0) { if (layer != 0) phase_rstd((const float*)(ws + WS_SSP), (float*)(ws + WS_RSTD), opq(tid)); return; }
    if ((layer & 1) == 0) {
        if (sub == 1) {
            pg8::run(lds - grp_() * GRP_LDS, hbuf, 2048, (const bf16_t*)(ws + WS_WEVIN + li * SZ_WEVIN), MTOK, LDZE, 2048, pg8::PEpiBf16S{zbuf, LDZE, (const float*)(ws + WS_RSTD)}); return; }
        if (sub == 2) { const int nwin = 2048, ndil = 3072, ncmp = 64, nt = nwin + ndil + ncmp;
            (void)nt;
            if (G == 512) {
                const int cls = v & 14;
                const int kmax = cls == 0 ? 4 : 6;
                for (int k = 0; k < kmax; ++k) item_dil(P, lds, opq(tid), v + 512 * k);
                if (cls == 2) item_dil(P, lds, opq(tid), (v - 2) + 2048);
                if (cls == 4) item_dil(P, lds, opq(tid), (v - 4) + 2560);
                if (cls == 0) item_cmp1(P, li, lds, opq(tid), (v >> 4) * 2 + (v & 1));
            } else {
                for (int it = v; it < ndil; it += G) item_dil(P, lds, opq(tid), it);
                for (int it = v; it < ncmp; it += G) item_cmp1(P, li, lds, opq(tid), it);
            }
            (void)nwin;
            return; }
        if (sub == 3) { phase_cmp2(P, li, lds, opq(tid)); return; }
        if (sub == 4) return;
        if (sub == 5) {
            for (int it = v; it < 2048; it += G) { const int item = it ^ (((it >> 9) & 1) ? 0 : 254);
                item_cmpatt(P, lds, opq(tid), item); item_win(P, lds, opq(tid), item); item_slc(P, lds, opq(tid), item); }
            { int t_ = tid; asm volatile("" : "+v"(t_)); for (int it = v; it < MTOK / 4; it += G) item_mixb(P, t_, it); }
            return; }
        if (sub == 6) { pg8::run(lds - grp_() * GRP_LDS, zbuf + EC_GATEA, LDZE, (const bf16_t*)(ws + WS_WEVOUT + li * SZ_WEVOUT), MTOK, 2048, 1536, pg8::PEpiResidX{xin, P.out, hbuf, (float*)(ws + WS_SSP)}); return; }
    } else {
        if (sub == 1) { pg8::run(lds - grp_() * GRP_LDS, hbuf, 2048, (const bf16_t*)(ws + WS_WODIN + li * SZ_WODIN), MTOK, LDZO, 2048, pg8::PEpiBf16S{zbuf, LDZO, (const float*)(ws + WS_RSTD)}); return; }
        if (sub == 2) { phase_norms(zbuf, P.q_norm + li * 1536, P.kv_norm + li * 512, (const float*)(ws + WS_COS), (const float*)(ws + WS_SIN), opq(tid)); return; }
        if (sub == 3) {
            pg8::run(lds - grp_() * GRP_LDS, zbuf + OC_CQ, LDZO, (const bf16_t*)(ws + WS_WQB + li * SZ_WQB), MTOK, 3072, 1536, pg8::PEpiBf16{hbuf, 3072});
            pg8::run(lds - grp_() * GRP_LDS, zbuf + OC_CKV, LDZO, (const bf16_t*)(ws + WS_WKVB + li * SZ_WKVB), MTOK, 4096, 512, pg8::PEpiBf16{(bf16_t*)(ws + WS_KV), 4096}); return; }
        if (sub == 4) { for (int it = pblock(); it < 2048; it += (int)gridDim.x) item_mla8(P, lds - grp_() * GRP_LDS, opq((int)threadIdx.x), it); return; }
        if (sub == 5) { pg8::run(lds - grp_() * GRP_LDS, zbuf + OC_GATE, LDZO, (const bf16_t*)(ws + WS_WODOUT + li * SZ_WODOUT), MTOK, 2048, 2048, pg8::PEpiResidX{xin, P.out, hbuf, (float*)(ws + WS_SSP)}); return; }
    }
}

DEVI void grid_barrier(unsigned* bar, unsigned gen) {
    __syncthreads();
    if (threadIdx.x == 0) {
        const unsigned G = gridDim.x, x = blockIdx.x & 7u;
        unsigned* gcnt = bar + 32 * 8;
        __builtin_amdgcn_fence(__ATOMIC_RELEASE, "agent");
        if ((G & 7u) == 0u) {
            if (__hip_atomic_fetch_add(bar + 32 * x, 1u, __ATOMIC_ACQ_REL, __HIP_MEMORY_SCOPE_AGENT) + 1u == gen * (G >> 3)) {
                if (__hip_atomic_fetch_add(gcnt, 1u, __ATOMIC_ACQ_REL, __HIP_MEMORY_SCOPE_AGENT) + 1u == gen * 8u) {
#pragma unroll
                    for (int i = 0; i < 8; ++i) __hip_atomic_store(bar + 32 * (9 + i), gen, __ATOMIC_RELEASE, __HIP_MEMORY_SCOPE_AGENT);
                }
            }
            while (__hip_atomic_load(bar + 32 * (9 + x), __ATOMIC_RELAXED, __HIP_MEMORY_SCOPE_AGENT) < gen) __builtin_amdgcn_s_sleep(1);
        } else {
            __hip_atomic_fetch_add(gcnt, 1u, __ATOMIC_RELAXED, __HIP_MEMORY_SCOPE_AGENT);
            while (__hip_atomic_load(gcnt, __ATOMIC_RELAXED, __HIP_MEMORY_SCOPE_AGENT) < gen * G) __builtin_amdgcn_s_sleep(2);
        }
        __builtin_amdgcn_fence(__ATOMIC_ACQUIRE, "agent");
    }
    __syncthreads();
}

__global__ void __launch_bounds__(NTHREADS, 2) fwd_kernel(Params P) {
    extern __shared__ __attribute__((aligned(16))) unsigned char smem[];
    LDSA char* lds = (LDSA char*)smem;
    const int tid = threadIdx.x & (GTHREADS - 1);
    lds += grp_() * GRP_LDS;
    unsigned bar_gen = 0;
    for (int ph = P.ph_lo; ph < P.ph_hi; ++ph) {
        if (ph == 1 || ph == 5 || ph == 18) continue;
        if (ph > P.ph_lo) {
            if (P.ph_lo < 0) cg::this_grid().sync();
            grid_barrier((unsigned*)(P.ws + WS_BAR), ++bar_gen);
        }
        int tid_ = tid; asm volatile("" : "+v"(tid_));
        Params Q = P; { size_t z0 = 0, z1 = 0; asm volatile("" : "+s"(z0), "+s"(z1)); Q.ws = P.ws + z0; Q.out = P.out + z1; }
#ifdef DBG_DRY_PH
        if (ph == DBG_DRY_PH) { Params Q2 = Q; Q2.dry = 1; int t3_ = tid; asm volatile("" : "+v"(t3_)); run_phase(Q2, ph, lds, t3_); __syncthreads(); }
#endif
        run_phase(Q, ph, lds, tid_);
#ifdef DBG_REPEAT_PH
        if (ph == DBG_REPEAT_PH) { __syncthreads(); int t2_ = tid; asm volatile("" : "+v"(t2_)); run_phase(Q, ph, lds, t2_); }
#endif
    }
}

extern "C" void kernel_launch(void* const* d_in, const int* in_sizes, int n_in, void* d_out, int out_size, void* d_ws, size_t ws_size, hipStream_t stream) {
    static int grid = 0;
    if (grid == 0) {
        if (n_in != 15 || ws_size < WS_END) { fprintf(stderr, "kernel_launch: need 15 inputs and %zu bytes of workspace (got %d, %zu)\n", (size_t)WS_END, n_in, ws_size); grid = -1; return; }
        int dev = 0, cus = 0, per_cu = 0;
        hipGetDevice(&dev); hipDeviceGetAttribute(&cus, hipDeviceAttributeMultiprocessorCount, dev);
        if (hipFuncSetAttribute((const void*)fwd_kernel, hipFuncAttributeMaxDynamicSharedMemorySize, LDS_BYTES) != hipSuccess) { fprintf(stderr, "hipFuncSetAttribute failed\n"); grid = -1; return; }
        if (hipOccupancyMaxActiveBlocksPerMultiprocessor(&per_cu, (const void*)fwd_kernel, NTHREADS, LDS_BYTES) != hipSuccess || per_cu < 1) { fprintf(stderr, "occupancy query failed (%d)\n", per_cu); per_cu = 1; }
        if (per_cu > 1) per_cu = 1;
        grid = cus * per_cu;
        fprintf(stderr, "kernel_launch: grid %d (%d CUs x %d)\n", grid, cus, per_cu);
    }
    if (grid < 0) return;
    Params p{};
    p.x = (const float*)d_in[0]; p.rel_bias = (const float*)d_in[1]; p.norm_w = (const float*)d_in[2]; p.final_norm_w = (const float*)d_in[3]; p.ev_w_in = (const float*)d_in[4];
    p.cmp_pos = (const float*)d_in[5]; p.cmp_w1 = (const float*)d_in[6]; p.cmp_w2 = (const float*)d_in[7]; p.ev_w_out = (const float*)d_in[8]; p.od_w_in = (const float*)d_in[9];
    p.q_norm = (const float*)d_in[10]; p.w_qb = (const float*)d_in[11]; p.kv_norm = (const float*)d_in[12]; p.w_kvb = (const float*)d_in[13]; p.od_w_out = (const float*)d_in[14];
    p.out = (float*)d_out; p.ws = (unsigned char*)d_ws;
#if ONE_LAUNCH
    p.ph_lo = 0; p.ph_hi = N_PHASES;
    if (hipMemsetAsync((char*)d_ws + WS_BAR, 0, 4096, stream) != hipSuccess) { fprintf(stderr, "memset failed\n"); return; }
    void* args[] = {&p};
    hipError_t e = hipLaunchCooperativeKernel((const void*)fwd_kernel, dim3(grid), dim3(NTHREADS), args, LDS_BYTES, stream);
    if (e != hipSuccess) fprintf(stderr, "cooperative launch failed: %s (grid %d)\n", hipGetErrorString(e), grid);
#else
    for (int ph = 0; ph < N_PHASES; ++ph) { p.ph_lo = ph; p.ph_hi = ph + 1; hipLaunchKernelGGL(fwd_kernel, dim3(grid), dim3(NTHREADS), LDS_BYTES, stream, p); }
#endif
}
```

```cpp
#include <hip/hip_runtime.h>
#include <hip/hip_cooperative_groups.h>
#include <cstdio>
#include <cstdint>
namespace cg = cooperative_groups;


#ifndef ONE_LAUNCH
#define ONE_LAUNCH 1
#endif

typedef unsigned short bf16_t;
typedef short bf16x8 __attribute__((ext_vector_type(8)));
typedef float f32x16 __attribute__((ext_vector_type(16)));
typedef float f32x4 __attribute__((ext_vector_type(4)));
typedef unsigned u32x4 __attribute__((ext_vector_type(4)));
typedef unsigned u32x2 __attribute__((ext_vector_type(2)));
typedef int v2i __attribute__((ext_vector_type(2)));
typedef int v4i __attribute__((ext_vector_type(4)));
#define LDSA __attribute__((address_space(3)))
#define DEVI __device__ __forceinline__

constexpr int D_MODEL = 2048, BATCH = 8, SEQ = 4096, MTOK = BATCH * SEQ;
constexpr int LDZE = 8960;
constexpr int LDZO = 4352;
constexpr int EC_QA = 0, EC_KC = 1024, EC_VC = 1280, EC_KS = 1536, EC_VS = 1792, EC_KW = 2048, EC_VW = 2304, EC_GATEA = 2560,
              EC_QB = 3584, EC_KB = 5120, EC_VB = 6656, EC_GATEB = 8192, EC_G3 = 8704;
constexpr int OC_CQ = 0, OC_CKV = 1536, OC_GATE = 2048, OC_KPE = 4096;
constexpr float LOG2E = 1.4426950408889634f;
constexpr float NSA_SCALE2 = 0.08838834764831845f * LOG2E;
constexpr float MLA_SCALE2 = 0.07216878364870323f * LOG2E;
constexpr int GRP_LDS = 73728, LDS_BYTES = 2 * GRP_LDS;
constexpr int NTHREADS = 512, GTHREADS = 256;

constexpr size_t MB = 1024 * 1024;
constexpr size_t WS_BIAST = 0;
constexpr size_t WS_BIASD = WS_BIAST + 20 * 4096 * 4;
constexpr size_t WS_COS = 512 * 1024;
constexpr size_t WS_SIN = WS_COS + 512 * 1024;
constexpr size_t WS_POSP = WS_SIN + 512 * 1024;
constexpr size_t WS_BAR = 1920 * 1024;
constexpr size_t WS_KCMP = 2 * MB;
constexpr size_t WS_VCMP = WS_KCMP + 256 * 1024;
constexpr size_t WS_SEL = 3 * MB;
constexpr size_t WS_LSE = 4 * MB;
constexpr size_t WS_CMPP = 6 * MB;
constexpr size_t WS_RSTD = 14 * MB;
constexpr size_t WS_W = 16 * MB;
constexpr size_t SZ_WEVIN = (size_t)LDZE * 2048 * 2, SZ_WEVOUT = (size_t)2048 * 1536 * 2, SZ_WODIN = (size_t)LDZO * 2048 * 2,
                 SZ_WQB = (size_t)3072 * 1536 * 2, SZ_WKVB = (size_t)4096 * 512 * 2, SZ_WODOUT = (size_t)2048 * 2048 * 2, SZ_W1 = (size_t)128 * 8192 * 2;
constexpr size_t WS_WEVIN = WS_W, WS_WEVOUT = WS_WEVIN + 2 * SZ_WEVIN, WS_WODIN = WS_WEVOUT + 2 * SZ_WEVOUT, WS_WQB = WS_WODIN + 2 * SZ_WODIN,
                 WS_WKVB = WS_WQB + 2 * SZ_WQB, WS_WODOUT = WS_WKVB + 2 * SZ_WKVB, WS_W1 = WS_WODOUT + 2 * SZ_WODOUT, WS_WEND = WS_W1 + 4 * SZ_W1;
constexpr size_t WS_R1 = (WS_WEND + 4095) & ~(size_t)4095;
constexpr size_t SZ_R1 = (size_t)MTOK * LDZE * 2;
constexpr size_t WS_KV = WS_R1 + (size_t)MTOK * LDZO * 2;
constexpr size_t WS_H = WS_R1 + SZ_R1;
constexpr size_t WS_DIL = WS_H + (size_t)MTOK * 2048 * 2;
constexpr size_t WS_SSP = WS_DIL + (size_t)3 * MTOK * 512 * 2;
constexpr size_t WS_END = WS_SSP + (size_t)MTOK * 32 * 4;

struct Params {
    const float* x; const float* rel_bias; const float* norm_w; const float* final_norm_w; const float* ev_w_in; const float* cmp_pos;
    const float* cmp_w1; const float* cmp_w2; const float* ev_w_out; const float* od_w_in; const float* q_norm; const float* w_qb;
    const float* kv_norm; const float* w_kvb; const float* od_w_out;
    float* out; unsigned char* ws; int ph_lo, ph_hi; int dry, pad_;
};

DEVI float bf2f(bf16_t h) { return __uint_as_float((unsigned)h << 16); }
typedef __bf16 bf16v2_ __attribute__((ext_vector_type(2)));
typedef float f32v2_ __attribute__((ext_vector_type(2)));
DEVI unsigned pk2(float lo, float hi) { const f32v2_ v = {lo, hi}; return __builtin_bit_cast(unsigned, __builtin_convertvector(v, bf16v2_)); }
DEVI unsigned bfr_(float f) { const unsigned u = __float_as_uint(f); return (u + 0x7fffu + ((u >> 16) & 1u)) >> 16; }
DEVI unsigned pk2s(float lo, float hi) { return pk2(lo, hi); }
DEVI float lo2f(unsigned u) { return __uint_as_float(u << 16); }
DEVI float hi2f(unsigned u) { return __uint_as_float(u & 0xffff0000u); }
DEVI float fexp2(float x) { return __builtin_amdgcn_exp2f(x); }
DEVI float sigmoidf_(float x) { return 1.0f / (1.0f + __expf(-x)); }
DEVI float siluf_(float x) { return x / (1.0f + __expf(-x)); }
DEVI float wave_sum(float v) {
#pragma unroll
    for (int o = 32; o >= 1; o >>= 1) v += __shfl_xor(v, o);
    return v;
}
DEVI int pblock() { const int G = gridDim.x, b = blockIdx.x; return (G % 8 == 0) ? (b % 8) * (G / 8) + b / 8 : b; }
DEVI int grp_() { return __builtin_amdgcn_readfirstlane((int)(threadIdx.x >> 8)); }
DEVI int vgrid() { return (int)gridDim.x * 2; }
DEVI int vblock() { return pblock() * 2 + grp_(); }
template <int OFF> DEVI v2i trr(unsigned a) { v2i r; asm volatile("ds_read_b64_tr_b16 %0, %1 offset:%2" : "=v"(r) : "v"(a), "n"(OFF)); return r; }
DEVI f32x16 mfma32(bf16x8 a, bf16x8 b, f32x16 c) { return __builtin_amdgcn_mfma_f32_32x32x16_bf16(a, b, c, 0, 0, 0); }
DEVI int opq(int t) { asm volatile("" : "+v"(t)); return t; }
DEVI int opqs(int t) { asm volatile("" : "+s"(t)); return t; }
DEVI f32x16 zero16() { f32x16 z; for (int i = 0; i < 16; ++i) z[i] = 0.f; return z; }

template <int DM = 0, class AF, class EF>
DEVI void gemm_tile4(LDSA char* lds, int tid, AF af, const bf16_t* __restrict__ Bt, int ldb, int kt0, int nk, int row0, int col0, EF ef) {
    const int lane = tid & 63, wave = __builtin_amdgcn_readfirstlane(tid >> 6), wm = wave >> 1, wn = wave & 1, n32 = lane & 31, h = lane >> 5;
    f32x16 acc[4][2];
#pragma unroll
    for (int i = 0; i < 4; ++i)
#pragma unroll
        for (int j = 0; j < 2; ++j) acc[i][j] = zero16();
    u32x4 ra[8], rb[4];
    const int cr = tid >> 3, ckc = tid & 7;
#define GLOAD(kt) do { int cr_ = cr; asm volatile("" : "+v"(cr_));   \
        _Pragma("unroll") for (int u = 0; u < 8; ++u) ra[u] = *(const u32x4*)af(row0 + cr_ + 32 * u, (kt) * 64, ckc * 8); \
        _Pragma("unroll") for (int u = 0; u < 4; ++u) rb[u] = *(const u32x4*)(Bt + (size_t)(col0 + cr_ + 32 * u) * ldb + (kt) * 64 + ckc * 8); } while (0)
#define SSTORE() do { LDSA char* sb_ = lds + cr * 144 + ckc * 16; _Pragma("unroll") for (int u = 0; u < 8; ++u) *(LDSA u32x4*)(sb_ + u * 32 * 144) = ra[u]; \
        _Pragma("unroll") for (int u = 0; u < 4; ++u) *(LDSA u32x4*)(sb_ + 36864 + u * 32 * 144) = rb[u]; } while (0)
    GLOAD(kt0);
    LDSA char* As = lds + (wm * 128 + n32) * 144 + h * 16;
    LDSA char* Bs = lds + 36864 + (wn * 64 + n32) * 144 + h * 16;
    for (int i = 0; i < nk; ++i) {
        if (DM != 2 || i == 0) SSTORE();
        __syncthreads();
        if (DM != 2 && i + 1 < nk) GLOAD(kt0 + i + 1);
        if (DM != 1) {
#pragma unroll
            for (int ks = 0; ks < 4; ++ks) {
                const bf16x8 b0 = *(LDSA bf16x8*)(Bs + ks * 32), b1 = *(LDSA bf16x8*)(Bs + 32 * 144 + ks * 32);
#pragma unroll
                for (int ii = 0; ii < 4; ++ii) { const bf16x8 a = *(LDSA bf16x8*)(As + ii * 32 * 144 + ks * 32);
                    acc[ii][0] = mfma32(b0, a, acc[ii][0]); acc[ii][1] = mfma32(b1, a, acc[ii][1]); }
            }
        }
        __syncthreads();
    }
#undef GLOAD
#undef SSTORE
    ef(row0 + wm * 128 + n32, col0 + wn * 64 + 4 * h, acc);
}

struct AFPlain { const bf16_t* A; int lda; DEVI const bf16_t* operator()(int row, int kb, int kin) const { return A + (size_t)row * lda + kb + kin; } };
struct AFEvOut { const bf16_t* z; DEVI const bf16_t* operator()(int row, int kb, int kin) const { const int cb = kb < 1024 ? EC_GATEA + kb : EC_GATEB + (kb - 1024); return z + (size_t)row * LDZE + cb + kin; } };
struct AFCmp { const bf16_t* z; int colbase;
    DEVI const bf16_t* operator()(int R, int kb, int kin) const { const int k = kb + kin; const int b = R >> 7, g = (R >> 6) & 1, n = R & 63, l = k >> 7, d = k & 127;
        return z + (size_t)(b * SEQ + n * 64 + l) * LDZE + colbase + g * 128 + d; } };

struct EpiBf16 { bf16_t* C; int ldc;
    template <int NI> DEVI void operator()(int rbase, int cbase, f32x16 (&acc)[NI][2]) const {
#pragma unroll
        for (int i = 0; i < NI; ++i)
#pragma unroll
            for (int j = 0; j < 2; ++j)
#pragma unroll
                for (int g = 0; g < 4; ++g) { u32x2 w; w.x = pk2s(acc[i][j][4 * g], acc[i][j][4 * g + 1]); w.y = pk2s(acc[i][j][4 * g + 2], acc[i][j][4 * g + 3]);
                    *(u32x2*)(C + (size_t)(rbase + 32 * i) * ldc + cbase + 32 * j + 8 * g) = w; }
    } };
struct EpiResid { const float* xin; float* xout;
    template <int NI> DEVI void operator()(int rbase, int cbase, f32x16 (&acc)[NI][2]) const {
#pragma unroll
        for (int i = 0; i < NI; ++i)
#pragma unroll
            for (int j = 0; j < 2; ++j)
#pragma unroll
                for (int g = 0; g < 4; ++g) { const size_t off = (size_t)(rbase + 32 * i) * D_MODEL + cbase + 32 * j + 8 * g;
                    f32x4 v = *(const f32x4*)(xin + off); v[0] += acc[i][j][4 * g]; v[1] += acc[i][j][4 * g + 1]; v[2] += acc[i][j][4 * g + 2]; v[3] += acc[i][j][4 * g + 3];
                    *(f32x4*)(xout + off) = v; if (g == 3) asm volatile("" ::: "memory"); }
    } };
struct EpiProbe { float* C;
    template <int NI> DEVI void operator()(int rbase, int cbase, f32x16 (&acc)[NI][2]) const { float t = 0.f; for (int i = 0; i < NI; ++i) for (int j = 0; j < 2; ++j) for (int r = 0; r < 16; ++r) t += acc[i][j][r]; if (t == 123456.789f) C[rbase + cbase] = t; } };
struct EpiF32 { float* C; int ldc;
    template <int NI> DEVI void operator()(int rbase, int cbase, f32x16 (&acc)[NI][2]) const {
#pragma unroll
        for (int i = 0; i < NI; ++i)
#pragma unroll
            for (int j = 0; j < 2; ++j)
#pragma unroll
                for (int g = 0; g < 4; ++g) { f32x4 v; v[0] = acc[i][j][4 * g]; v[1] = acc[i][j][4 * g + 1]; v[2] = acc[i][j][4 * g + 2]; v[3] = acc[i][j][4 * g + 3];
                    *(f32x4*)(C + (size_t)(rbase + 32 * i) * ldc + cbase + 32 * j + 8 * g) = v; }
    } };
struct EpiQ { bf16_t* C; const float* cosT; const float* sinT;
    template <int NI> DEVI void operator()(int rbase, int cbase, f32x16 (&acc)[NI][2]) const {
        const int sub = (cbase & ~63) % 192;
        if (sub == 128) {
            const int hoff = cbase & 63;
#pragma unroll
            for (int i = 0; i < NI; ++i) { const int t = (rbase + 32 * i) & (SEQ - 1);
#pragma unroll
                for (int g = 0; g < 4; ++g) { const f32x4 c = *(const f32x4*)(cosT + t * 32 + hoff + 8 * g), s = *(const f32x4*)(sinT + t * 32 + hoff + 8 * g);
#pragma unroll
                    for (int e = 0; e < 4; ++e) { const float x1 = acc[i][0][4 * g + e], x2 = acc[i][1][4 * g + e];
                        acc[i][0][4 * g + e] = x1 * c[e] - x2 * s[e]; acc[i][1][4 * g + e] = x1 * s[e] + x2 * c[e]; }
                    asm volatile("" ::: "memory"); } }
        }
#pragma unroll
        for (int i = 0; i < NI; ++i)
#pragma unroll
            for (int j = 0; j < 2; ++j)
#pragma unroll
                for (int g = 0; g < 4; ++g) { u32x2 w; w.x = pk2(acc[i][j][4 * g] * MLA_SCALE2, acc[i][j][4 * g + 1] * MLA_SCALE2); w.y = pk2(acc[i][j][4 * g + 2] * MLA_SCALE2, acc[i][j][4 * g + 3] * MLA_SCALE2);
                    *(u32x2*)(C + (size_t)(rbase + 32 * i) * 3072 + cbase + 32 * j + 8 * g) = w; }
    } };

DEVI void tile_of(int L, int nM, int nN, int& pm, int& pn) { const int GM = 8, nig = GM * nN, gid = L / nig, fm = gid * GM; const int gsz = (nM - fm) < GM ? (nM - fm) : GM; pm = fm + (L % nig) % gsz; pn = (L % nig) / gsz; }

template <class AF, class EF>
DEVI void gemm_tile8(LDSA char* lds, int tid, AF af, const bf16_t* __restrict__ Bt, int ldb, int nk, int row0, int col0, EF ef) {
    const int lane = tid & 63, wave = __builtin_amdgcn_readfirstlane(tid >> 6), wm = wave >> 2, wn = wave & 3, n32 = lane & 31, h = lane >> 5;
    f32x16 acc[4][2];
#pragma unroll
    for (int i = 0; i < 4; ++i)
#pragma unroll
        for (int j = 0; j < 2; ++j) acc[i][j] = zero16();
    u32x4 ra[4], rb[4];
    const int cr = tid >> 3, ckc = tid & 7;
#define GLOAD(kt) do { int cr_ = cr; asm volatile("" : "+v"(cr_)); \
        _Pragma("unroll") for (int u = 0; u < 4; ++u) { ra[u] = *(const u32x4*)af(row0 + cr_ + 64 * u, (kt) * 64, ckc * 8); \
            rb[u] = *(const u32x4*)(Bt + (size_t)(col0 + cr_ + 64 * u) * ldb + (kt) * 64 + ckc * 8); } } while (0)
#define SSTORE(s) do { LDSA char* sb_ = lds + (s) * GRP_LDS + cr * 144 + ckc * 16; _Pragma("unroll") for (int u = 0; u < 4; ++u) { \
        *(LDSA u32x4*)(sb_ + u * 64 * 144) = ra[u]; *(LDSA u32x4*)(sb_ + 36864 + u * 64 * 144) = rb[u]; } } while (0)
    GLOAD(0); SSTORE(0);
    if (nk > 1) GLOAD(1);
    __syncthreads();
    for (int i = 0; i < nk; ++i) {
        LDSA char* As = lds + (i & 1) * GRP_LDS + (wm * 128 + n32) * 144 + h * 16;
        LDSA char* Bs = lds + (i & 1) * GRP_LDS + 36864 + (wn * 64 + n32) * 144 + h * 16;
#pragma unroll
        for (int ks = 0; ks < 4; ++ks) {
            const bf16x8 b0 = *(LDSA bf16x8*)(Bs + ks * 32), b1 = *(LDSA bf16x8*)(Bs + 32 * 144 + ks * 32);
#pragma unroll
            for (int ii = 0; ii < 4; ++ii) { const bf16x8 a = *(LDSA bf16x8*)(As + ii * 32 * 144 + ks * 32);
                acc[ii][0] = mfma32(b0, a, acc[ii][0]); acc[ii][1] = mfma32(b1, a, acc[ii][1]); }
        }
        if (i + 1 < nk) SSTORE((i + 1) & 1);
        if (i + 2 < nk) GLOAD(i + 2);
        __syncthreads();
    }
#undef GLOAD
#undef SSTORE
    ef(row0 + wm * 128 + n32, col0 + wn * 64 + 4 * h, acc);
}

template <class AF, class EF>
DEVI void gemm_phase(LDSA char* lds_phys, int tid_phys, AF af, const bf16_t* Bt, int ldb, int K, int M, int N, EF ef) {
    const int nM = M / 256, nN = N / 256, nt = nM * nN, G = gridDim.x, v = pblock();
    for (int L = v; L < nt; L += G) { int pm, pn; tile_of(L, nM, nN, pm, pn); gemm_tile8(lds_phys, tid_phys, af, Bt, ldb, K / 64, pm * 256, pn * 256, ef); }
}

namespace pg8 {
#define PG8_LAS __attribute__((address_space(3)))
typedef unsigned short bf16_t;
typedef short bf16x8 __attribute__((ext_vector_type(8)));
typedef float f32x4 __attribute__((ext_vector_type(4)));
typedef unsigned u32x4 __attribute__((ext_vector_type(4)));
constexpr int BM = 256, BK = 64, HALF = 128, HTB = HALF * BK * 2  , STAGE_BYTES = 8 * HTB, NXCD = 8, WGM = 4;

__host__ __device__ __forceinline__ int lds_byte(int r, int c) { const int st = (r >> 4) * 2 + (c >> 5), rr = r & 15, cc = c & 31, ob = rr * 64 + cc * 2; return st * 1024 + (ob ^ (((ob >> 9) & 1) << 5)); }
__host__ __device__ __forceinline__ void stage_rc(int b, int& R, int& C) { const int st = b / 1024, sb = b % 1024, swz = sb ^ (((sb >> 9) & 1) << 5); R = (st >> 1) * 16 + swz / 64; C = (st & 1) * 32 + (swz % 64) / 2; }
__host__ __device__ __forceinline__ int perm32(int rho) { const int n = rho >> 4, i = rho & 15; return 8 * (i >> 2) + 4 * n + (i & 3); }

struct Unit { int pm, pn; };
struct Gemm { const bf16_t* A; const bf16_t* Bt; int M, N, K, lda; };

struct StaticOrder {
    int nM, nN, nwg, G, c;
    __host__ __device__ void init(int M, int N, int G_, int c_) { nM = M / BM; nN = N / BM; nwg = nM * nN; G = G_; c = c_; }
    __host__ __device__ bool next(int i, Unit& u) const {
        const long L = (long)i * G + c; if (L >= nwg) return false;
        int wgid = (int)L; { const int q = nwg / NXCD, r = nwg % NXCD, xcd = wgid % NXCD, off = wgid / NXCD; wgid = (xcd < r ? xcd * (q + 1) : r * (q + 1) + (xcd - r) * q) + off; }
        const int nig = WGM * nN, gid = wgid / nig, fm = gid * WGM, gsz = (nM - fm) < WGM ? (nM - fm) : WGM;
        u.pm = fm + ((wgid % nig) % gsz); u.pn = (wgid % nig) / gsz; return true;
    }
    __device__ __forceinline__ void a_ready(const Unit&) const {}
    __device__ __forceinline__ void done(const Unit&) const {}
};
typedef float f32x4_ __attribute__((ext_vector_type(4)));
template <class Epi, class Sched, bool ALIGN_EPI = false, bool SP2 = false>
__device__ __forceinline__ void gemm_phase(PG8_LAS unsigned char* lds, const Gemm g, const Sched& S, const Epi& E) {
    const int tid = ::opq((int)threadIdx.x), wid = __builtin_amdgcn_readfirstlane(tid >> 6), lane = tid & 63, wr = wid >> 2, wc = wid & 3, fr = lane & 15, fq = lane >> 4;
    const int K = g.K, nt = K / BK;
    unsigned voffA[2], voffB[2];
#pragma unroll
    for (int i = 0; i < 2; ++i) { int R, C; stage_rc(tid * 16 + i * 8192, R, C); const int Rb = Epi::PERM ? ((R & ~31) + perm32(R & 31)) : R;
        voffA[i] = (unsigned)(R * g.lda + C) * 2u; voffB[i] = (unsigned)(Rb * K + C) * 2u; }
    const size_t kstep = (size_t)(BK * 2);
    const size_t hstepB = (size_t)HALF * K * 2, hstepA = (size_t)HALF * g.lda * 2;
    const size_t tstepB = 2 * hstepB, tstepA = 2 * hstepA;
    const unsigned ldsw = (unsigned)wid * 1024u;
    const int aoff = lds_byte(wr * 64 + fr, fq * 8), boff = lds_byte(wc * 32 + fr, fq * 8);
#define PG8_SA(b, h) (((b) * 2 + (h)) * HTB)
#define PG8_SB(b, h) ((4 + (b) * 2 + (h)) * HTB)
#define PG8_STAGE(bufoff, gbase, voff) do { _Pragma("unroll") for (int _i = 0; _i < 2; ++_i) \
        __builtin_amdgcn_global_load_lds((const unsigned*)((const char*)(gbase) + (voff)[_i]), (PG8_LAS unsigned*)(lds + (bufoff) + ldsw + _i * 8192), 16, 0, 0); } while (0)
#define PG8_LDA(dst, b, h) do { _Pragma("unroll") for (int m = 0; m < 4; ++m) _Pragma("unroll") for (int k = 0; k < 2; ++k) dst[m][k] = *(const PG8_LAS bf16x8*)(lds + PG8_SA(b, h) + aoff + m * 2048 + k * 1024); } while (0)
#define PG8_LDB(dst, b, h) do { _Pragma("unroll") for (int n = 0; n < 2; ++n) _Pragma("unroll") for (int k = 0; k < 2; ++k) dst[n][k] = *(const PG8_LAS bf16x8*)(lds + PG8_SB(b, h) + boff + n * 2048 + k * 1024); } while (0)
#define PG8_MMA(ai, bj, At, Bt) do { __builtin_amdgcn_s_setprio(1); _Pragma("unroll") for (int m = 0; m < 4; ++m) _Pragma("unroll") for (int n = 0; n < 2; ++n) _Pragma("unroll") for (int k = 0; k < 2; ++k) \
        acc[ai][bj][m][n] = __builtin_amdgcn_mfma_f32_16x16x32_bf16(Bt[n][k], At[m][k], acc[ai][bj][m][n], 0, 0, 0); __builtin_amdgcn_s_setprio(0); } while (0)
#define PG8_WAIT_V(n) asm volatile("s_waitcnt vmcnt(" #n ")" ::: "memory")
#define PG8_WAIT_L(n) asm volatile("s_waitcnt lgkmcnt(" #n ")" ::: "memory")
#define PG8_BAR __builtin_amdgcn_s_barrier()
#define PG8_SCHED __builtin_amdgcn_sched_barrier(0)
    Unit cur, nxt; int ui = 0;
    if (!S.next(0, cur)) return;
    f32x4 acc[2][2][4][2];
#pragma unroll
    for (int a = 0; a < 2; ++a)
#pragma unroll
        for (int b = 0; b < 2; ++b)
#pragma unroll
            for (int m = 0; m < 4; ++m)
#pragma unroll
                for (int n = 0; n < 2; ++n) acc[a][b][m][n] = (f32x4){0.f, 0.f, 0.f, 0.f};
    bf16x8 At[4][2], B0[2][2], B1[2][2];
    const char* cA = (const char*)g.A + (size_t)cur.pm * tstepA; const char* cB = (const char*)g.Bt + (size_t)cur.pn * tstepB;
    S.a_ready(cur);
    if constexpr (SP2) {
        PG8_STAGE(PG8_SB(0, 0), cB, voffB); PG8_STAGE(PG8_SB(0, 1), cB + hstepB, voffB); PG8_STAGE(PG8_SA(0, 0), cA, voffA); PG8_STAGE(PG8_SA(0, 1), cA + hstepA, voffA);
        if (wr == 1) PG8_BAR;
        PG8_WAIT_V(2); PG8_BAR;
        PG8_STAGE(PG8_SB(1, 0), cB + kstep, voffB); PG8_STAGE(PG8_SA(1, 0), cA + kstep, voffA); PG8_STAGE(PG8_SB(1, 1), cB + hstepB + kstep, voffB);
        PG8_WAIT_V(6); PG8_BAR;
    } else {
        PG8_STAGE(PG8_SB(0, 0), cB, voffB); PG8_STAGE(PG8_SA(0, 0), cA, voffA); PG8_STAGE(PG8_SB(0, 1), cB + hstepB, voffB); PG8_STAGE(PG8_SA(0, 1), cA + hstepA, voffA);
        if (wr == 1) PG8_BAR;
        PG8_WAIT_V(4); PG8_BAR;
        PG8_STAGE(PG8_SB(1, 0), cB + kstep, voffB); PG8_STAGE(PG8_SA(1, 0), cA + kstep, voffA); PG8_STAGE(PG8_SB(1, 1), cB + hstepB + kstep, voffB);
        PG8_WAIT_V(6); PG8_BAR;
    }
    for (;;) {
        const bool has_next = S.next(ui + 1, nxt);
        const char* nA = has_next ? (const char*)g.A + (size_t)nxt.pm * tstepA : cA; const char* nB = has_next ? (const char*)g.Bt + (size_t)nxt.pn * tstepB : cB;
        for (int t = 0; t < nt; t += 2) {
            const bool last = (t == nt - 2);
            const char* a1 = cA + (size_t)(t + 1) * kstep;
            const char* a2 = last ? nA : cA + (size_t)(t + 2) * kstep; const char* b2 = last ? nB : cB + (size_t)(t + 2) * kstep;
            const char* a3 = a2 + kstep; const char* b3 = b2 + kstep;
            if (last && has_next) S.a_ready(nxt);
            if constexpr (SP2) {
            PG8_LDB(B0, 0, 0); PG8_LDB(B1, 0, 1); PG8_SCHED; PG8_LDA(At, 0, 0); PG8_STAGE(PG8_SA(1, 1), a1 + hstepA, voffA);
            PG8_WAIT_V(8); PG8_WAIT_L(0); PG8_BAR; PG8_MMA(0, 0, At, B0); PG8_MMA(0, 1, At, B1); PG8_BAR; PG8_SCHED;
            PG8_LDA(At, 0, 1); PG8_STAGE(PG8_SB(0, 0), b2, voffB); PG8_STAGE(PG8_SB(0, 1), b2 + hstepB, voffB); PG8_STAGE(PG8_SA(0, 0), a2, voffA);
            PG8_WAIT_V(8); PG8_WAIT_L(0); PG8_BAR; PG8_MMA(1, 0, At, B0); PG8_MMA(1, 1, At, B1); PG8_BAR; PG8_SCHED;
            PG8_LDB(B0, 1, 0); PG8_LDB(B1, 1, 1); PG8_SCHED; PG8_LDA(At, 1, 0); PG8_STAGE(PG8_SA(0, 1), a2 + hstepA, voffA);
            PG8_WAIT_V(8); PG8_WAIT_L(0); PG8_BAR; PG8_MMA(0, 0, At, B0); PG8_MMA(0, 1, At, B1); PG8_BAR; PG8_SCHED;
            PG8_LDA(At, 1, 1); PG8_STAGE(PG8_SB(1, 0), b3, voffB); PG8_STAGE(PG8_SB(1, 1), b3 + hstepB, voffB); PG8_STAGE(PG8_SA(1, 0), a3, voffA);
            PG8_WAIT_V(8); PG8_WAIT_L(0); PG8_BAR; PG8_MMA(1, 0, At, B0); PG8_MMA(1, 1, At, B1); PG8_BAR; PG8_SCHED;
            } else {
            PG8_LDB(B0, 0, 0); PG8_SCHED; PG8_LDA(At, 0, 0); PG8_STAGE(PG8_SA(1, 1), a1 + hstepA, voffA);
            PG8_WAIT_L(8); PG8_BAR; PG8_WAIT_L(0); PG8_MMA(0, 0, At, B0); PG8_BAR; PG8_SCHED;
            PG8_LDB(B1, 0, 1); PG8_STAGE(PG8_SB(0, 0), b2, voffB);
            PG8_BAR; PG8_WAIT_L(0); PG8_MMA(0, 1, At, B1); PG8_BAR;
            PG8_LDA(At, 0, 1); PG8_STAGE(PG8_SA(0, 0), a2, voffA);
            PG8_BAR; PG8_WAIT_L(0); PG8_MMA(1, 0, At, B0); PG8_BAR; PG8_SCHED;
            PG8_STAGE(PG8_SB(0, 1), b2 + hstepB, voffB);
            PG8_WAIT_V(6); PG8_BAR; PG8_MMA(1, 1, At, B1); PG8_BAR;
            PG8_LDB(B0, 1, 0); PG8_SCHED; PG8_LDA(At, 1, 0); PG8_STAGE(PG8_SA(0, 1), a2 + hstepA, voffA);
            PG8_WAIT_L(8); PG8_BAR; PG8_WAIT_L(0); PG8_MMA(0, 0, At, B0); PG8_BAR; PG8_SCHED;
            PG8_LDB(B1, 1, 1); PG8_STAGE(PG8_SB(1, 0), b3, voffB);
            PG8_BAR; PG8_WAIT_L(0); PG8_MMA(0, 1, At, B1); PG8_BAR;
            PG8_LDA(At, 1, 1); PG8_STAGE(PG8_SA(1, 0), a3, voffA);
            PG8_BAR; PG8_WAIT_L(0); PG8_MMA(1, 0, At, B0); PG8_BAR; PG8_SCHED;
            PG8_STAGE(PG8_SB(1, 1), b3 + hstepB, voffB);
            PG8_WAIT_V(6); PG8_BAR; PG8_MMA(1, 1, At, B1); PG8_BAR;
            }
        }
        if constexpr (ALIGN_EPI) { if (wr == 0) PG8_BAR; }
        if constexpr (!Epi::AFTER_DRAIN) { E(acc, cur, wr, wc, fr, fq); S.done(cur); }
        if (!has_next) break;
#pragma unroll
        for (int a = 0; a < 2; ++a)
#pragma unroll
            for (int b = 0; b < 2; ++b)
#pragma unroll
                for (int m = 0; m < 4; ++m)
#pragma unroll
                    for (int n = 0; n < 2; ++n) acc[a][b][m][n] = (f32x4){0.f, 0.f, 0.f, 0.f};
        cur = nxt; cA = nA; cB = nB; ++ui;
        if constexpr (ALIGN_EPI) { if (wr == 1) PG8_BAR; }
    }
    PG8_WAIT_V(0);
    if constexpr (!ALIGN_EPI) { if (wr == 0) PG8_BAR; }
    PG8_BAR;
    if constexpr (Epi::AFTER_DRAIN) { E.fused(acc, cur, wr, wc, fr, fq, lds, wid, lane); S.done(cur); }
#undef PG8_SA
#undef PG8_SB
#undef PG8_STAGE
#undef PG8_LDA
#undef PG8_LDB
#undef PG8_MMA
#undef PG8_WAIT_V
#undef PG8_WAIT_L
#undef PG8_BAR
#undef PG8_SCHED
}
}

namespace pg8 {
struct PEpiBf16 { static constexpr bool PERM = true, AFTER_DRAIN = false; bf16_t* O; int ldc;
    __device__ __forceinline__ void operator()(const f32x4 (&acc)[2][2][4][2], const Unit& u, int wr, int wc, int fr, int fq) const {
        const int row0 = u.pm * BM + wr * 64 + fr, col0 = u.pn * BM + wc * 32 + 8 * fq;
#pragma unroll
        for (int ai = 0; ai < 2; ++ai)
#pragma unroll
            for (int m = 0; m < 4; ++m) { bf16_t* rowp = O + (size_t)(row0 + ai * HALF + m * 16) * ldc + col0;
#pragma unroll
                for (int bj = 0; bj < 2; ++bj) { const f32x4 v0 = acc[ai][bj][m][0], v1 = acc[ai][bj][m][1]; u32x4 w;
                    w.x = ::pk2s(v0[0], v0[1]); w.y = ::pk2s(v0[2], v0[3]); w.z = ::pk2s(v1[0], v1[1]); w.w = ::pk2s(v1[2], v1[3]);
                    *(u32x4*)(rowp + bj * HALF) = w; } }
    } };
struct PEpiResid { static constexpr bool PERM = false, AFTER_DRAIN = false; const float* xin; float* xout;
    __device__ __forceinline__ void operator()(const f32x4 (&acc)[2][2][4][2], const Unit& u, int wr, int wc, int fr, int fq) const {
        const int row0 = u.pm * BM + wr * 64 + fr, col0 = u.pn * BM + wc * 32 + 4 * fq;
#pragma unroll
        for (int ai = 0; ai < 2; ++ai)
#pragma unroll
            for (int m = 0; m < 4; ++m) { const size_t off = (size_t)(row0 + ai * HALF + m * 16) * D_MODEL + col0;
#pragma unroll
                for (int bj = 0; bj < 2; ++bj)
#pragma unroll
                    for (int n = 0; n < 2; ++n) { f32x4 v = *(const f32x4*)(xin + off + bj * HALF + n * 16); v += acc[ai][bj][m][n]; *(f32x4*)(xout + off + bj * HALF + n * 16) = v; }
                asm volatile("" ::: "memory"); }
    } };
struct PEpiBf16S { static constexpr bool PERM = true, AFTER_DRAIN = false; bf16_t* O; int ldc; const float* rstd;
    __device__ __forceinline__ void operator()(const f32x4 (&acc)[2][2][4][2], const Unit& u, int wr, int wc, int fr, int fq) const {
        const int row0 = u.pm * BM + wr * 64 + fr, col0 = u.pn * BM + wc * 32 + 8 * fq;
#pragma unroll
        for (int ai = 0; ai < 2; ++ai)
#pragma unroll
            for (int m = 0; m < 4; ++m) { const int row = row0 + ai * HALF + m * 16; const float rs = rstd[row]; bf16_t* rowp = O + (size_t)row * ldc + col0;
#pragma unroll
                for (int bj = 0; bj < 2; ++bj) { const f32x4 v0 = acc[ai][bj][m][0] * rs, v1 = acc[ai][bj][m][1] * rs; u32x4 w;
                    w.x = ::pk2(v0[0], v0[1]); w.y = ::pk2(v0[2], v0[3]); w.z = ::pk2(v1[0], v1[1]); w.w = ::pk2(v1[2], v1[3]);
                    *(u32x4*)(rowp + bj * HALF) = w; } }
    } };
struct PEpiResidX { static constexpr bool PERM = true, AFTER_DRAIN = false; const float* xin; float* xout; bf16_t* xb; float* ssp;
    __device__ __forceinline__ void operator()(const f32x4 (&acc)[2][2][4][2], const Unit& u, int wr, int wc, int fr, int fq) const {
        const int row0 = u.pm * BM + wr * 64 + fr, col0 = u.pn * BM + wc * 32 + 8 * fq;
#pragma unroll
        for (int ai = 0; ai < 2; ++ai)
#pragma unroll
            for (int m = 0; m < 4; ++m) { const int row = row0 + ai * HALF + m * 16; const size_t off = (size_t)row * D_MODEL + col0; float ss = 0.f;
#pragma unroll
                for (int bj = 0; bj < 2; ++bj) { f32x4 v0 = *(const f32x4*)(xin + off + bj * HALF), v1 = *(const f32x4*)(xin + off + bj * HALF + 4);
                    v0 += acc[ai][bj][m][0]; v1 += acc[ai][bj][m][1]; *(f32x4*)(xout + off + bj * HALF) = v0; *(f32x4*)(xout + off + bj * HALF + 4) = v1;
                    ss += ((v0[0] * v0[0] + v0[1] * v0[1]) + (v0[2] * v0[2] + v0[3] * v0[3])) + ((v1[0] * v1[0] + v1[1] * v1[1]) + (v1[2] * v1[2] + v1[3] * v1[3]));
                    u32x4 w; w.x = ::pk2(v0[0], v0[1]); w.y = ::pk2(v0[2], v0[3]); w.z = ::pk2(v1[0], v1[1]); w.w = ::pk2(v1[2], v1[3]); *(u32x4*)(xb + off + bj * HALF) = w; }
                ss += __shfl_xor(ss, 16); ss += __shfl_xor(ss, 32);
                if (fq == 0) ssp[(size_t)row * 32 + u.pn * 4 + wc] = ss;
                asm volatile("" ::: "memory"); }
    } };
template <class Epi> __device__ __forceinline__ void run(LDSA char* lds_phys, const bf16_t* A, int lda, const bf16_t* Bt, int M, int N, int K, const Epi& E) {
    Gemm g{A, Bt, M, N, K, lda}; StaticOrder S; S.init(M, N, (int)gridDim.x, (int)blockIdx.x);
    gemm_phase<Epi, StaticOrder, true, true>((PG8_LAS unsigned char*)lds_phys, g, S, E);
}
}

struct TileDesc { const bf16_t* kp; const bf16_t* vp; const bf16_t* k2p; int kidx0; };
constexpr int ATT_VOFF = 25600, ATT_BOFF = 46080, ATT_VSTR = 320;
constexpr int CMP_POFF = 37888, CMP_PSTR = 68, CMP_LOFF = CMP_POFF + 4 * 32 * CMP_PSTR * 4;

typedef short s16x4 __attribute__((ext_vector_type(4)));
DEVI bf16x8 vfrag(LDSA char* vp) {
    const s16x4 a = __builtin_amdgcn_ds_read_tr16_b64_v4i16((LDSA s16x4*)vp), b = __builtin_amdgcn_ds_read_tr16_b64_v4i16((LDSA s16x4*)(vp + 8 * ATT_VSTR));
    return (bf16x8){a[0], a[1], a[2], a[3], b[0], b[1], b[2], b[3]};
}
template <int C> DEVI void pv_step(LDSA char* vp, f32x16& o, const bf16x8 (&pk)[2][2]) {
    const bf16x8 f00 = vfrag(vp + 64 * C), f01 = vfrag(vp + 16 * ATT_VSTR + 64 * C), f10 = vfrag(vp + 32 * ATT_VSTR + 64 * C), f11 = vfrag(vp + 48 * ATT_VSTR + 64 * C);
    o = mfma32(f00, pk[0][0], o); o = mfma32(f01, pk[0][1], o); o = mfma32(f10, pk[1][0], o); o = mfma32(f11, pk[1][1], o);
}

template <int MODE, class TileFn, class EpiFn>
DEVI void attn_core(LDSA char* lds, int tid, const bf16_t* qrow, int qidx, int qidx0w, int ntiles, int nsync, int kst, int vst, int k2st, TileFn tilefn, const float* btab, int bmax,
                    unsigned long long selm, EpiFn epi) {
    constexpr int DQK = (MODE == 0) ? 192 : 128, KSTR = DQK * 2 + 16, KCH = DQK / 8, NKL = 64 * KCH / 256, NKS = DQK / 16;
    constexpr bool LBIAS = (MODE == 1 || MODE == 2 || MODE == 3);
    const int lane = tid & 63, wave = __builtin_amdgcn_readfirstlane(tid >> 6), n = lane & 31, h = lane >> 5;
    LDSA char* Ks = lds; LDSA char* Vs = lds + (MODE == 4 ? 17408 : ATT_VOFF); LDSA float* Bw = (LDSA float*)(lds + ATT_BOFF) + wave * 96;
    bf16x8 qf[NKS];
#pragma unroll
    for (int ks = 0; ks < NKS; ++ks) qf[ks] = *(const bf16x8*)(qrow + 16 * ks + 8 * h);
    if (MODE == 0) {
        const float* ct = btab + (size_t)qidx * 32 + 8 * h; const float* st = ct + 4096 * 32;
#pragma unroll
        for (int kk = 0; kk < 2; ++kk) { v4i a = __builtin_bit_cast(v4i, qf[8 + kk]), b2 = __builtin_bit_cast(v4i, qf[10 + kk]);
#pragma unroll
            for (int j = 0; j < 4; ++j) { const float c0 = ct[16 * kk + 2 * j], c1 = ct[16 * kk + 2 * j + 1], s0_ = st[16 * kk + 2 * j], s1_ = st[16 * kk + 2 * j + 1];
                const float x10 = lo2f((unsigned)a[j]), x11 = hi2f((unsigned)a[j]), x20 = lo2f((unsigned)b2[j]), x21 = hi2f((unsigned)b2[j]);
                a[j] = (int)pk2(x10 * c0 - x20 * s0_, x11 * c1 - x21 * s1_); b2[j] = (int)pk2(x10 * s0_ + x20 * c0, x11 * s1_ + x21 * c1); }
            qf[8 + kk] = __builtin_bit_cast(bf16x8, a); qf[10 + kk] = __builtin_bit_cast(bf16x8, b2); }
    }
    f32x16 o[4];
#pragma unroll
    for (int c = 0; c < 4; ++c) o[c] = zero16();
    float m = -INFINITY, l = 0.f;
    u32x4 kreg[4], vreg[4]; float breg0 = 0.f, breg1 = 0.f; int next_kidx0 = 0;
    LDSA char* const vp = Vs + (4 * h + ((lane & 15) >> 2)) * ATT_VSTR + (16 * ((lane >> 4) & 1) + 4 * (lane & 3)) * 2;
    const unsigned koff = (unsigned)(tid >> 4) * (unsigned)kst + (tid & 15) * 8, voff = (unsigned)(tid >> 4) * (unsigned)vst + (tid & 15) * 8;
    const unsigned k2off = (unsigned)(tid >> 3) * (unsigned)k2st + (tid & 7) * 8;
    u32x4 k2reg[2];
#define AISSUE(it) do { TileDesc td; tilefn((it), td); next_kidx0 = td.kidx0; \
        _Pragma("unroll") for (int u = 0; u < 4; ++u) kreg[u] = *(const u32x4*)(td.kp + (size_t)(16 * u) * kst + koff); \
        if (MODE == 0) { _Pragma("unroll") for (int u = 0; u < 2; ++u) k2reg[u] = *(const u32x4*)(td.k2p + (size_t)(32 * u) * k2st + k2off); } \
        _Pragma("unroll") for (int u = 0; u < 4; ++u) vreg[u] = *(const u32x4*)(td.vp + (size_t)(16 * u) * vst + voff); \
        if (LBIAS) { const int D0 = qidx0w - td.kidx0; int i0 = D0 + 31 - lane, i1 = D0 + 31 - (lane + 64); \
            breg0 = (i0 >= 0 && i0 <= bmax) ? btab[i0] : 0.f; breg1 = (lane < 32 && i1 >= 0 && i1 <= bmax) ? btab[i1] : 0.f; } } while (0)
    AISSUE(0);
    const int nloop = (MODE == 3) ? nsync : ntiles;
    for (int it = 0; it < nloop; ++it) {
        const int kidx0 = next_kidx0; const bool act = (MODE == 3) ? (it < ntiles) : true;
        __syncthreads();
        if (act) {
#pragma unroll
        for (int u = 0; u < 4; ++u) *(LDSA u32x4*)(Ks + (tid >> 4) * KSTR + (tid & 15) * 16 + u * 16 * KSTR) = kreg[u];
        if (MODE == 0) {
#pragma unroll
            for (int u = 0; u < 2; ++u) *(LDSA u32x4*)(Ks + (tid >> 3) * KSTR + 256 + (tid & 7) * 16 + u * 32 * KSTR) = k2reg[u]; }
#pragma unroll
        for (int u = 0; u < 4; ++u) *(LDSA u32x4*)(Vs + (tid >> 4) * ATT_VSTR + (tid & 15) * 16 + u * 16 * ATT_VSTR) = vreg[u];
        if (LBIAS) { Bw[lane] = breg0; if (lane < 32) Bw[lane + 64] = breg1; }
        }
        __syncthreads();
        if (it + 1 < ntiles) AISSUE(it + 1);
        __builtin_amdgcn_sched_barrier(0);
        const int dlo = qidx0w - (kidx0 + 63);
        const int dhi = qidx0w + 31 - kidx0;
        bool skip = false, full = false; bool selbit = true;
        if (MODE == 0) { skip = dhi < 0; full = dlo >= 0; }
        if (MODE == 1) { skip = dhi < 0 || dlo >= 512; full = dlo >= 0 && dhi < 512; }
        if (MODE == 2) { skip = dhi < 0 || dlo > 128; full = dlo >= 0 && dhi <= 128; }
        if (MODE == 3) { selbit = (selm >> (kidx0 >> 6)) & 1ull; skip = (__ballot(selbit) == 0ull) || dhi < 0; full = false; }
        if (MODE == 4) { skip = false; full = false; }
        if (act && !skip) {
            f32x16 s0 = zero16(), s1 = zero16();
            LDSA char* kb = Ks + n * KSTR + h * 16;
#pragma unroll
            for (int ks = 0; ks < NKS; ++ks) {
                const bf16x8 k0 = *(LDSA bf16x8*)(kb + ks * 32), k1 = *(LDSA bf16x8*)(kb + 32 * KSTR + ks * 32);
                s0 = mfma32(k0, qf[ks], s0); s1 = mfma32(k1, qf[ks], s1);
            }
            const float sc = (MODE == 0) ? 1.0f : NSA_SCALE2;
            int dbase = qidx - kidx0 - 4 * h;
            asm volatile("" : "+v"(dbase));
            float tmax = -INFINITY;
            if (MODE == 3 && dlo >= 0) {
                const float sel_off = selbit ? 0.f : -INFINITY;
#pragma unroll
                for (int mt = 0; mt < 2; ++mt)
#pragma unroll
                    for (int r = 0; r < 16; ++r) {
                        const int ko = 32 * mt + 8 * (r >> 2) + (r & 3);
                        float v = (mt ? s1[r] : s0[r]) * sc + Bw[(31 - n + 4 * h) + ko] + sel_off;
                        if (mt) s1[r] = v; else s0[r] = v;
                        tmax = fmaxf(tmax, v);
                    }
            } else
            if ((MODE == 0 || MODE == 1 || MODE == 2) && full) {
#pragma unroll
                for (int mt = 0; mt < 2; ++mt)
#pragma unroll
                    for (int r = 0; r < 16; ++r) {
                        const int ko = 32 * mt + 8 * (r >> 2) + (r & 3);
                        float v = (mt ? s1[r] : s0[r]) * sc;
                        if (LBIAS) v += Bw[(31 - n + 4 * h) + ko];
                        if (mt) s1[r] = v; else s0[r] = v;
                        tmax = fmaxf(tmax, v);
                    }
            } else {
#pragma unroll
            for (int mt = 0; mt < 2; ++mt)
#pragma unroll
                for (int r = 0; r < 16; ++r) {
                    const int ko = 32 * mt + 8 * (r >> 2) + (r & 3);
                    float v = (mt ? s1[r] : s0[r]) * sc;
                    if (LBIAS) v += Bw[(31 - n + 4 * h) + ko];
                    if (MODE == 4) { const int kidx = kidx0 + 4 * h + ko; const int nvalid = (qidx + 1) >> 6;
                        if (kidx < nvalid) v += btab[qidx - 64 * kidx - 63]; else v = -INFINITY; }
                    else if (!full) { const int dist = dbase - ko; bool ok = dist >= 0;
                        if (MODE == 1) ok = ok && dist < 512;
                        if (MODE == 2) ok = ok && dist <= 128;
                        if (MODE == 3) ok = ok && selbit;
                        if (!ok) v = -INFINITY; }
                    if (mt) s1[r] = v; else s0[r] = v;
                    tmax = fmaxf(tmax, v);
                }
                asm volatile("" ::: "memory");
            }
            tmax = fmaxf(tmax, __shfl_xor(tmax, 32));
            const float mnew = fmaxf(m, tmax), msafe = (mnew == -INFINITY) ? 0.f : mnew;
            const float alpha = fexp2(m - msafe);
            float ps = 0.f;
#pragma unroll
            for (int r = 0; r < 16; ++r) { s0[r] = fexp2(s0[r] - msafe); ps += s0[r]; }
#pragma unroll
            for (int r = 0; r < 16; ++r) { s1[r] = fexp2(s1[r] - msafe); ps += s1[r]; }
            l = l * alpha + ps; m = mnew;
            if (__ballot(alpha != 1.0f) != 0ull) {
#pragma unroll
                for (int c = 0; c < 4; ++c)
#pragma unroll
                    for (int r = 0; r < 16; ++r) o[c][r] *= alpha;
            }
            if (MODE == 4) {
                LDSA float* pb = (LDSA float*)(lds + CMP_POFF) + (wave * 32 + n) * CMP_PSTR + 4 * h;
#pragma unroll
                for (int mt = 0; mt < 2; ++mt)
#pragma unroll
                    for (int g = 0; g < 4; ++g) { f32x4 pv; for (int e = 0; e < 4; ++e) pv[e] = mt ? s1[4 * g + e] : s0[4 * g + e]; *(LDSA f32x4*)(pb + 32 * mt + 8 * g) = pv; }
            }
            bf16x8 pk[2][2];
#pragma unroll
            for (int j = 0; j < 2; ++j) {
                v4i a; a.x = (int)pk2(s0[8 * j], s0[8 * j + 1]); a.y = (int)pk2(s0[8 * j + 2], s0[8 * j + 3]); a.z = (int)pk2(s0[8 * j + 4], s0[8 * j + 5]); a.w = (int)pk2(s0[8 * j + 6], s0[8 * j + 7]);
                pk[0][j] = __builtin_bit_cast(bf16x8, a);
                v4i b; b.x = (int)pk2(s1[8 * j], s1[8 * j + 1]); b.y = (int)pk2(s1[8 * j + 2], s1[8 * j + 3]); b.z = (int)pk2(s1[8 * j + 4], s1[8 * j + 5]); b.w = (int)pk2(s1[8 * j + 6], s1[8 * j + 7]);
                pk[1][j] = __builtin_bit_cast(bf16x8, b);
            }
            pv_step<0>(vp, o[0], pk); pv_step<1>(vp, o[1], pk); pv_step<2>(vp, o[2], pk); pv_step<3>(vp, o[3], pk);
        }
    }
#undef AISSUE
    l += __shfl_xor(l, 32);
    epi(o, l, m);
    __syncthreads();
}

template <int MAP> DEVI int colmap(int n) {
    if (MAP == 1) { if (n < 2560) return n; if (n < 8704) return n + 24; if (n < 8728) return n - 8704 + 2560; return -1; }
    if (MAP == 2) { if (n < 2048) return n; if (n < 4096) return n + 64; if (n < 4160) return n - 4096 + 2048; return -1; }
    return n;
}
template <int MAP>
DEVI void transpose_job(LDSA char* lds, int tid, const float* __restrict__ src, int K, int Nsrc, bf16_t* __restrict__ dst, int Npad, float wscale = 1.0f, const float* __restrict__ kscale = nullptr) {
    LDSA float* T = (LDSA float*)lds;
    const int nKt = K / 64, nNt = Npad / 64, nt = nKt * nNt, G = vgrid();
    for (int t = vblock(); t < nt; t += G) {
        const int kt = t % nKt, ntile = t / nKt, k0 = kt * 64, n0 = ntile * 64;
        const int nl = tid & 63, sc = colmap<MAP>(n0 + nl);
#pragma unroll
        for (int u = 0; u < 16; ++u) { const int kl = (tid >> 6) + 4 * u; T[kl * 65 + nl] = (sc >= 0) ? src[(size_t)(k0 + kl) * Nsrc + sc] * (kscale ? kscale[k0 + kl] : wscale) : 0.f; }
        __syncthreads();
#pragma unroll
        for (int u = 0; u < 2; ++u) { const int c = tid + 256 * u, n2 = c >> 3, kc = c & 7; u32x4 w;
            w.x = pk2(T[(kc * 8 + 0) * 65 + n2], T[(kc * 8 + 1) * 65 + n2]); w.y = pk2(T[(kc * 8 + 2) * 65 + n2], T[(kc * 8 + 3) * 65 + n2]);
            w.z = pk2(T[(kc * 8 + 4) * 65 + n2], T[(kc * 8 + 5) * 65 + n2]); w.w = pk2(T[(kc * 8 + 6) * 65 + n2], T[(kc * 8 + 7) * 65 + n2]);
            *(u32x4*)(dst + (size_t)(n0 + n2) * K + k0 + kc * 8) = w; }
        __syncthreads();
    }
}
DEVI int t5_bucket(int d) { if (d < 16) return d; const float v = __builtin_log2f((float)d * 0.0625f) * (16.0f / 7.0f); int b = 16 + (int)v; return b > 31 ? 31 : b; }

DEVI void phase_prep(const Params& P, LDSA char* lds, int tid) {
    unsigned char* ws = P.ws;
    for (int i = 0; i < 2; ++i) {
        transpose_job<1>(lds, tid, P.ev_w_in + (size_t)i * 2048 * 8728, 2048, 8728, (bf16_t*)(ws + WS_WEVIN + i * SZ_WEVIN), LDZE, 1.0f, P.norm_w + (2 * i) * D_MODEL);
        transpose_job<0>(lds, tid, P.ev_w_out + (size_t)i * 1536 * 2048, 1536, 2048, (bf16_t*)(ws + WS_WEVOUT + i * SZ_WEVOUT), 2048);
        transpose_job<2>(lds, tid, P.od_w_in + (size_t)i * 2048 * 4160, 2048, 4160, (bf16_t*)(ws + WS_WODIN + i * SZ_WODIN), LDZO, 1.0f, P.norm_w + (2 * i + 1) * D_MODEL);
        transpose_job<0>(lds, tid, P.w_qb + (size_t)i * 1536 * 3072, 1536, 3072, (bf16_t*)(ws + WS_WQB + i * SZ_WQB), 3072, MLA_SCALE2);
        transpose_job<0>(lds, tid, P.w_kvb + (size_t)i * 512 * 4096, 512, 4096, (bf16_t*)(ws + WS_WKVB + i * SZ_WKVB), 4096);
        transpose_job<0>(lds, tid, P.od_w_out + (size_t)i * 2048 * 2048, 2048, 2048, (bf16_t*)(ws + WS_WODOUT + i * SZ_WODOUT), 2048);
        for (int kv = 0; kv < 2; ++kv)
            transpose_job<0>(lds, tid, P.cmp_w1 + (size_t)(i * 2 + kv) * 8192 * 128, 8192, 128, (bf16_t*)(ws + WS_W1 + (i * 2 + kv) * SZ_W1), 128);
    }
    const int G = vgrid(), gt = vblock() * GTHREADS + tid, GT = G * GTHREADS;
    float* biasT = (float*)(ws + WS_BIAST); float* biasD = (float*)(ws + WS_BIASD);
    for (int i = gt; i < 20 * 4096; i += GT) { const int hh = i >> 12, d = i & 4095; biasT[i] = P.rel_bias[t5_bucket(d) * 20 + hh] * LOG2E; }
    for (int i = gt; i < 12 * 132; i += GT) { const int gh = i / 132, j = i % 132, g = gh >> 2; const int dd = g == 0 ? 1 : (g == 1 ? 4 : 16);
        biasD[i] = (j <= 128) ? P.rel_bias[t5_bucket(j * dd) * 20 + 8 + gh] * LOG2E : 0.f; }
    float* cosT = (float*)(ws + WS_COS); float* sinT = (float*)(ws + WS_SIN);
    double dz; { int zz = 0; asm volatile("" : "+v"(zz)); dz = (double)zz; }
    for (int i = gt; i < 4096 * 32; i += GT) {
        const int t = i >> 5, fi = i & 31; double f = 1.0; for (int q = 0; q < fi; ++q) f *= 0.7498942093324559;
        const float ang = (float)t * (float)f; const double a = (double)ang; const double kq = __builtin_rint(a * 0.6366197723675814);
        const double r = a - kq * 1.5707963267948966, r2 = r * r;
        const double sn = r * (1.0 + r2 * ((dz - 1.0 / 6) + r2 * ((dz + 1.0 / 120) + r2 * ((dz - 1.0 / 5040) + r2 * ((dz + 1.0 / 362880) + r2 * ((dz - 1.0 / 39916800) + r2 * (dz + 1.0 / 6227020800.0)))))));
        const double cs = 1.0 + r2 * ((dz - 0.5) + r2 * ((dz + 1.0 / 24) + r2 * ((dz - 1.0 / 720) + r2 * ((dz + 1.0 / 40320) + r2 * ((dz - 1.0 / 3628800) + r2 * (dz + 1.0 / 479001600.0))))));
        const int qd = ((int)kq) & 3; double S = sn, C = cs; if (qd == 1) { S = cs; C = -sn; } else if (qd == 2) { S = -sn; C = -cs; } else if (qd == 3) { S = -cs; C = sn; }
        cosT[i] = (float)C; sinT[i] = (float)S;
    }
    float* posp = (float*)(ws + WS_POSP); LDSA float* red = (LDSA float*)lds;
    for (int it = (G == 512) ? (((vblock() & 30) == 0) ? (vblock() >> 5) * 2 + (vblock() & 1) : 32) : vblock(); it < 32; it += G) {
        const int lkv = it >> 3, part = it & 7, j = tid & 127, half = tid >> 7;
        const float* pos = P.cmp_pos + (size_t)lkv * 8192; const float* w1 = P.cmp_w1 + (size_t)lkv * 8192 * 128;
        float s = 0.f; const int kb = part * 1024 + half * 512;
        for (int k = 0; k < 512; ++k) s += pos[kb + k] * w1[(size_t)(kb + k) * 128 + j];
        __syncthreads(); if (half) red[j] = s; __syncthreads(); if (!half) posp[(lkv * 8 + part) * 128 + j] = s + red[j]; __syncthreads();
    }
}

template <bool OUTF32>
DEVI void phase_rms(const float* __restrict__ x, const float* __restrict__ w, void* outp, int tid) {
    const int lane = tid & 63, wave = __builtin_amdgcn_readfirstlane(tid >> 6), G = vgrid();
    for (int rb = vblock(); rb < MTOK / 4; rb += G) {
        const int row = rb * 4 + wave; const float* xr = x + (size_t)row * D_MODEL;
        f32x4 v[8]; float ss = 0.f;
#pragma unroll
        for (int u = 0; u < 8; ++u) { v[u] = *(const f32x4*)(xr + (u * 64 + lane) * 4); ss += v[u][0] * v[u][0] + v[u][1] * v[u][1] + v[u][2] * v[u][2] + v[u][3] * v[u][3]; }
        ss = wave_sum(ss); const float rstd = rsqrtf(ss * (1.0f / D_MODEL) + 1e-6f);
#pragma unroll
        for (int u = 0; u < 8; ++u) { const f32x4 ww = *(const f32x4*)(w + (u * 64 + lane) * 4); f32x4 y; for (int e = 0; e < 4; ++e) y[e] = v[u][e] * rstd * ww[e];
            if (OUTF32) *(f32x4*)((float*)outp + (size_t)row * D_MODEL + (u * 64 + lane) * 4) = y;
            else { u32x2 pk; pk.x = pk2(y[0], y[1]); pk.y = pk2(y[2], y[3]); *(u32x2*)((bf16_t*)outp + (size_t)row * D_MODEL + (u * 64 + lane) * 4) = pk; } }
    }
}

DEVI void phase_xb(const float* __restrict__ x, bf16_t* xb, float* rstd, int tid) {
    const int lane = tid & 63, wave = __builtin_amdgcn_readfirstlane(tid >> 6), G = vgrid();
    for (int rb = vblock(); rb < MTOK / 4; rb += G) {
        const int row = rb * 4 + wave; const float* xr = x + (size_t)row * D_MODEL;
        f32x4 v[8]; float ss = 0.f;
#pragma unroll
        for (int u = 0; u < 8; ++u) { v[u] = *(const f32x4*)(xr + (u * 64 + lane) * 4); ss += v[u][0] * v[u][0] + v[u][1] * v[u][1] + v[u][2] * v[u][2] + v[u][3] * v[u][3]; }
        ss = wave_sum(ss); if (lane == 0) rstd[row] = rsqrtf(ss * (1.0f / D_MODEL) + 1e-6f);
#pragma unroll
        for (int u = 0; u < 8; ++u) { u32x2 pk; pk.x = pk2(v[u][0], v[u][1]); pk.y = pk2(v[u][2], v[u][3]); *(u32x2*)(xb + (size_t)row * D_MODEL + (u * 64 + lane) * 4) = pk; }
    }
}
DEVI void phase_rstd(const float* __restrict__ ssp, float* rstd, int tid) {
    const int G = vgrid();
    for (int row = vblock() * GTHREADS + tid; row < MTOK; row += G * GTHREADS) {
        const f32x4* p = (const f32x4*)(ssp + (size_t)row * 32); float s = 0.f;
#pragma unroll
        for (int u = 0; u < 8; ++u) { const f32x4 a = p[u]; s += (a[0] + a[1]) + (a[2] + a[3]); }
        rstd[row] = rsqrtf(s * (1.0f / D_MODEL) + 1e-6f);
    }
}

DEVI void phase_norms(bf16_t* z, const float* __restrict__ qn, const float* __restrict__ kvn, const float* cosT, const float* sinT, int tid) {
    const int lane = tid & 63, wave = __builtin_amdgcn_readfirstlane(tid >> 6), G = vgrid();
    for (int rb = vblock(); rb < MTOK / 4; rb += G) {
        const int row = rb * 4 + wave; bf16_t* zr = z + (size_t)row * LDZO;
        u32x4 c[3]; float ss = 0.f;
#pragma unroll
        for (int u = 0; u < 3; ++u) { c[u] = *(const u32x4*)(zr + OC_CQ + (u * 64 + lane) * 8);
#pragma unroll
            for (int e = 0; e < 4; ++e) { const float a = lo2f(c[u][e]), b = hi2f(c[u][e]); ss += a * a + b * b; } }
        ss = wave_sum(ss); float rstd = rsqrtf(ss * (1.0f / 1536) + 1e-6f);
#pragma unroll
        for (int u = 0; u < 3; ++u) { const float* wp = qn + (u * 64 + lane) * 8; u32x4 o;
#pragma unroll
            for (int e = 0; e < 4; ++e) o[e] = pk2(lo2f(c[u][e]) * rstd * wp[2 * e], hi2f(c[u][e]) * rstd * wp[2 * e + 1]);
            *(u32x4*)(zr + OC_CQ + (u * 64 + lane) * 8) = o; }
        u32x4 k = *(const u32x4*)(zr + OC_CKV + lane * 8); ss = 0.f;
#pragma unroll
        for (int e = 0; e < 4; ++e) { const float a = lo2f(k[e]), b = hi2f(k[e]); ss += a * a + b * b; }
        ss = wave_sum(ss); rstd = rsqrtf(ss * (1.0f / 512) + 1e-6f);
        { const float* wp = kvn + lane * 8; u32x4 o;
#pragma unroll
            for (int e = 0; e < 4; ++e) o[e] = pk2(lo2f(k[e]) * rstd * wp[2 * e], hi2f(k[e]) * rstd * wp[2 * e + 1]);
            *(u32x4*)(zr + OC_CKV + lane * 8) = o; }
        const int t = row & (SEQ - 1), i = lane & 31;
        const float x1 = bf2f(zr[OC_KPE + i]), x2 = bf2f(zr[OC_KPE + 32 + i]); const float cs = cosT[t * 32 + i], sn = sinT[t * 32 + i];
        const float r = (lane < 32) ? (x1 * cs - x2 * sn) : (x1 * sn + x2 * cs);
        zr[OC_KPE + lane] = (bf16_t)(pk2(r, r) & 0xffff);
    }
}

DEVI void phase_cmp2(const Params& P, int layer_i, LDSA char* lds, int tid) {
    unsigned char* ws = P.ws; const int G = vgrid(); LDSA float* S = (LDSA float*)lds;
    const float* part = (const float*)(ws + WS_CMPP); const float* posp = (const float*)(ws + WS_POSP);
    for (int it = (G == 512) ? (((vblock() & 6) == 0) ? (vblock() >> 3) * 2 + (vblock() & 1) : 128) : vblock(); it < 128; it += G) {
        const int kv = it >> 6, r0 = (it & 63) * 16, lkv = layer_i * 2 + kv;
#pragma unroll
        for (int u = 0; u < 8; ++u) { const int e = tid + 256 * u, r = e >> 7, j = e & 127; float s = 0.f;
            for (int sp = 0; sp < 8; ++sp) s += part[((size_t)(kv * 8 + sp) * 1024 + r0 + r) * 128 + j] + posp[(lkv * 8 + sp) * 128 + j];
            S[e] = siluf_(s); }
        __syncthreads();
        const int j = tid & 127, rh = tid >> 7; const float* w2 = P.cmp_w2 + (size_t)lkv * 128 * 128; float acc[8];
#pragma unroll
        for (int r = 0; r < 8; ++r) acc[r] = 0.f;
        for (int k = 0; k < 128; ++k) { const float w = w2[k * 128 + j];
#pragma unroll
            for (int r = 0; r < 8; ++r) acc[r] += S[(rh * 8 + r) * 128 + k] * w; }
        bf16_t* dst = (bf16_t*)(ws + (kv ? WS_VCMP : WS_KCMP));
#pragma unroll
        for (int r = 0; r < 8; ++r) dst[(size_t)(r0 + rh * 8 + r) * 128 + j] = (bf16_t)(pk2(acc[r], acc[r]) & 0xffff);
        __syncthreads();
    }
}

DEVI void item_win(const Params& P, LDSA char* lds, int tid, int item) {
    const bf16_t* z = (const bf16_t*)(P.ws + WS_R1); bf16_t* owin = (bf16_t*)(P.ws + WS_H) + (size_t)MTOK * 1024;
    const int g = item & 1, ch = (item >> 1) & 127, b = item >> 8, t0 = ch * 32, lane = tid & 63, wave = __builtin_amdgcn_readfirstlane(tid >> 6), n = lane & 31, hg = g * 4 + wave;
    const int kfirst = (t0 - 511 > 0 ? t0 - 511 : 0) & ~63, klast = (t0 + 31) & ~63, ntiles = (klast - kfirst) / 64 + 1;
    const bf16_t* zb = z + (size_t)b * SEQ * LDZE;
    auto tilefn = [&](int it, TileDesc& td) { const int k0 = kfirst + it * 64; td.kp = zb + (size_t)k0 * LDZE + EC_KW + g * 128; td.vp = zb + (size_t)k0 * LDZE + EC_VW + g * 128;
        td.k2p = nullptr; td.kidx0 = k0; };
    const size_t row = (size_t)b * SEQ + t0 + n;
    auto epi = [&](f32x16 (&o)[4], float l, float) { const float inv = l > 0.f ? 1.0f / l : 0.f; const int h = lane >> 5;
#pragma unroll
        for (int c = 0; c < 4; ++c)
#pragma unroll
            for (int q = 0; q < 4; ++q) { u32x2 w; w.x = pk2(o[c][4 * q] * inv, o[c][4 * q + 1] * inv); w.y = pk2(o[c][4 * q + 2] * inv, o[c][4 * q + 3] * inv);
                *(u32x2*)(owin + row * 1024 + hg * 128 + 32 * c + 8 * q + 4 * h) = w; } };
    attn_core<1>(lds, tid, zb + (size_t)(t0 + n) * LDZE + EC_QA + hg * 128, t0 + n, t0, ntiles, ntiles, LDZE, LDZE, 0, tilefn, (const float*)(P.ws + WS_BIAST) + hg * 4096, 4095, 0ull, epi);
}

DEVI void item_dil(const Params& P, LDSA char* lds, int tid, int item) {
    const bf16_t* z = (const bf16_t*)(P.ws + WS_R1); bf16_t* dout = (bf16_t*)(P.ws + WS_DIL); float* lse = (float*)(P.ws + WS_LSE);
    const int sub = (item >> 1) & 31, gh = ((item >> 6) % 6) * 2 + (item & 1), b = item / (32 * 12), g = gh >> 2, hh = gh & 3, lane = tid & 63, wave = __builtin_amdgcn_readfirstlane(tid >> 6), n = lane & 31;
    const int dd = g == 0 ? 1 : (g == 1 ? 4 : 16), cpr = 32 / dd  , r = sub / cpr, i0 = (sub % cpr) * 128;
    const int kfirst = i0 >= 128 ? i0 - 128 : 0, ntiles = (i0 + 128 - kfirst) / 64;
    const bf16_t* zb = z + ((size_t)b * SEQ + r) * LDZE;
    const int st = dd * LDZE;
    auto tilefn = [&](int it, TileDesc& td) { const int k0 = kfirst + it * 64; td.kp = zb + (size_t)k0 * st + EC_KB + gh * 128; td.vp = zb + (size_t)k0 * st + EC_VB + gh * 128;
        td.k2p = nullptr; td.kidx0 = k0; };
    const int qi = i0 + 32 * wave + n; const size_t row = (size_t)b * SEQ + r + (size_t)dd * qi;
    auto epi = [&](f32x16 (&o)[4], float l, float m) { const float inv = l > 0.f ? 1.0f / l : 0.f; const int h = lane >> 5;
        bf16_t* op = dout + ((size_t)g * MTOK + row) * 512 + hh * 128;
#pragma unroll
        for (int c = 0; c < 4; ++c)
#pragma unroll
            for (int q = 0; q < 4; ++q) { u32x2 w; w.x = pk2(o[c][4 * q] * inv, o[c][4 * q + 1] * inv); w.y = pk2(o[c][4 * q + 2] * inv, o[c][4 * q + 3] * inv);
                *(u32x2*)(op + 32 * c + 8 * q + 4 * h) = w; }
        if (h == 0) lse[((size_t)g * MTOK + row) * 4 + hh] = m + __builtin_log2f(l); };
    attn_core<2>(lds, tid, zb + (size_t)qi * st + EC_QB + gh * 128, qi, i0 + 32 * wave, ntiles, ntiles, st, st, 0, tilefn, (const float*)(P.ws + WS_BIASD) + gh * 132, 128, 0ull, epi);
}

DEVI void item_cmp1(const Params& P, int layer_i, LDSA char* lds, int tid, int item) {
    const int sp = item & 7, pm = (item >> 3) & 3, kv = item >> 5;
    AFCmp af{(const bf16_t*)(P.ws + WS_R1), kv ? EC_VC : EC_KC};
    EpiF32 ef{(float*)(P.ws + WS_CMPP) + (size_t)(kv * 8 + sp) * 1024 * 128, 128};
    gemm_tile4(lds, tid, af, (const bf16_t*)(P.ws + WS_W1 + (layer_i * 2 + kv) * SZ_W1), 8192, sp * 16, 16, pm * 256, 0, ef);
}

DEVI void item_cmpatt(const Params& P, LDSA char* lds, int tid, int item) {
    const bf16_t* z = (const bf16_t*)(P.ws + WS_R1); bf16_t* ocmp = (bf16_t*)(P.ws + WS_H);
    const int g = item & 1, ch = (item >> 1) & 127, b = item >> 8, t0 = ch * 32, lane = tid & 63, wave = __builtin_amdgcn_readfirstlane(tid >> 6), n = lane & 31, hg = g * 4 + wave;
    const bf16_t* kc = (const bf16_t*)(P.ws + WS_KCMP) + (size_t)(b * 2 + g) * 64 * 128; const bf16_t* vc = (const bf16_t*)(P.ws + WS_VCMP) + (size_t)(b * 2 + g) * 64 * 128;
    auto tilefn = [&](int, TileDesc& td) { td.kp = kc; td.vp = vc; td.k2p = nullptr; td.kidx0 = 0; };
    const size_t row = (size_t)b * SEQ + t0 + n;
    auto epi = [&](f32x16 (&o)[4], float l, float) { const float inv = l > 0.f ? 1.0f / l : 0.f; const int h = lane >> 5;
#pragma unroll
        for (int c = 0; c < 4; ++c)
#pragma unroll
            for (int q = 0; q < 4; ++q) { u32x2 w; w.x = pk2(o[c][4 * q] * inv, o[c][4 * q + 1] * inv); w.y = pk2(o[c][4 * q + 2] * inv, o[c][4 * q + 3] * inv);
                *(u32x2*)(ocmp + row * 1024 + hg * 128 + 32 * c + 8 * q + 4 * h) = w; }
        if (h == 0) ((LDSA float*)(lds + CMP_LOFF))[wave * 32 + n] = inv; };
    attn_core<4>(lds, tid, z + ((size_t)b * SEQ + t0 + n) * LDZE + EC_QA + hg * 128, t0 + n, t0, 1, 1, 128, 128, 0, tilefn, (const float*)(P.ws + WS_BIAST) + hg * 4096, 4095, 0ull, epi);
    LDSA float* pb = (LDSA float*)(lds + CMP_POFF); LDSA float* linv = (LDSA float*)(lds + CMP_LOFF); LDSA float* imp = (LDSA float*)lds;
    const int qi = tid >> 3, part = tid & 7, t = t0 + qi, cur = t >> 6;
#pragma unroll
    for (int e = 0; e < 8; ++e) { const int j = part * 8 + e; float s = 0.f;
#pragma unroll
        for (int w = 0; w < 4; ++w) s += pb[(w * 32 + qi) * CMP_PSTR + j] * linv[w * 32 + qi];
        if (j == 0 || j == cur || j == cur - 1) s = INFINITY;
        imp[qi * 64 + j] = s; }
    __syncthreads();
    unsigned long long bits = 0ull;
#pragma unroll
    for (int e = 0; e < 8; ++e) { const int j = part * 8 + e; const float vj = imp[qi * 64 + j]; int cnt = 0;
        for (int i = 0; i <= cur; ++i) { const float vi = imp[qi * 64 + i]; cnt += (vi > vj || (vi == vj && i < j)) ? 1 : 0; }
        if (j <= cur && cnt < 16) bits |= 1ull << j; }
    bits |= __shfl_xor(bits, 1); bits |= __shfl_xor(bits, 2); bits |= __shfl_xor(bits, 4);
    if (part == 0) ((unsigned long long*)(P.ws + WS_SEL))[(size_t)(b * 2 + g) * SEQ + t] = bits;
    __syncthreads();
}

DEVI void item_slc(const Params& P, LDSA char* lds, int tid, int item) {
    bf16_t* z = (bf16_t*)(P.ws + WS_R1); const bf16_t* ocmp = (const bf16_t*)(P.ws + WS_H); const bf16_t* owin = ocmp + (size_t)MTOK * 1024;
    const int g = item & 1, ch = (item >> 1) & 127, b = item >> 8, t0 = ch * 32, lane = tid & 63, wave = __builtin_amdgcn_readfirstlane(tid >> 6), n = lane & 31, hg = g * 4 + wave;
    const unsigned long long selm = ((const unsigned long long*)(P.ws + WS_SEL))[(size_t)(b * 2 + g) * SEQ + t0 + n];
    unsigned long long U = selm;
#pragma unroll
    for (int o = 16; o >= 1; o >>= 1) U |= __shfl_xor(U, o);
    { const unsigned ulo = __builtin_amdgcn_readfirstlane((unsigned)U), uhi = __builtin_amdgcn_readfirstlane((unsigned)(U >> 32)); U = ((unsigned long long)uhi << 32) | ulo; }
    const int ntiles = __popcll(U); unsigned long long rem = U;
    LDSA int* xw = (LDSA int*)(lds - grp_() * GRP_LDS + LDS_BYTES - 64);
    if (tid == 0) xw[grp_()] = ntiles;
    __syncthreads();
    const int nsync = xw[0] > xw[1] ? xw[0] : xw[1];
    const bf16_t* zb = z + (size_t)b * SEQ * LDZE;
    auto tilefn = [&](int, TileDesc& td) { const int j = __ffsll((long long)rem) - 1; rem &= rem - 1; const int k0 = j * 64;
        td.kp = zb + (size_t)k0 * LDZE + EC_KS + g * 128; td.vp = zb + (size_t)k0 * LDZE + EC_VS + g * 128; td.k2p = nullptr; td.kidx0 = k0; };
    const size_t row = (size_t)b * SEQ + t0 + n;
    auto epi = [&](f32x16 (&o)[4], float l, float) { if (P.dry) return; const float inv = l > 0.f ? 1.0f / l : 0.f;
        const int tq = opq(tid), h = (tq >> 5) & 1, hg = g * 4 + (tq >> 6); const size_t row = (size_t)b * SEQ + t0 + (tq & 31);
        bf16_t* zr = z + row * LDZE;
        const float g0 = sigmoidf_(bf2f(zr[EC_G3 + hg * 3 + 0])), g1 = sigmoidf_(bf2f(zr[EC_G3 + hg * 3 + 1])) * inv, g2 = sigmoidf_(bf2f(zr[EC_G3 + hg * 3 + 2]));
#pragma unroll
        for (int c = 0; c < 4; ++c)
#pragma unroll
            for (int q = 0; q < 4; ++q) { const int dv = hg * 128 + 32 * c + 8 * q + 4 * h;
                const u32x2 oc = *(const u32x2*)(ocmp + row * 1024 + dv), ow = *(const u32x2*)(owin + row * 1024 + dv), gt = *(const u32x2*)(zr + EC_GATEA + dv);
                const float m0 = (g0 * lo2f(oc.x) + g1 * o[c][4 * q] + g2 * lo2f(ow.x)) * siluf_(lo2f(gt.x));
                const float m1 = (g0 * hi2f(oc.x) + g1 * o[c][4 * q + 1] + g2 * hi2f(ow.x)) * siluf_(hi2f(gt.x));
                const float m2 = (g0 * lo2f(oc.y) + g1 * o[c][4 * q + 2] + g2 * lo2f(ow.y)) * siluf_(lo2f(gt.y));
                const float m3 = (g0 * hi2f(oc.y) + g1 * o[c][4 * q + 3] + g2 * hi2f(ow.y)) * siluf_(hi2f(gt.y));
                u32x2 w; w.x = pk2(m0, m1); w.y = pk2(m2, m3); *(u32x2*)(zr + EC_GATEA + dv) = w;
                if (q & 1) { asm volatile("" ::: "memory"); __builtin_amdgcn_sched_barrier(0); } } };
    attn_core<3>(lds, tid, zb + (size_t)(t0 + n) * LDZE + EC_QA + hg * 128, t0 + n, t0, ntiles, nsync, LDZE, LDZE, 0, tilefn, (const float*)(P.ws + WS_BIAST) + hg * 4096, 4095, selm, epi);
}

DEVI void item_mixb(const Params& P, int tid, int item) {
    bf16_t* z = (bf16_t*)(P.ws + WS_R1); const bf16_t* dout = (const bf16_t*)(P.ws + WS_DIL); const float* lse = (const float*)(P.ws + WS_LSE);
    const int lane = tid & 63, wave = __builtin_amdgcn_readfirstlane(tid >> 6), hh = lane >> 4; const size_t row = (size_t)item * 4 + wave;
    const float l0 = lse[row * 4 + hh], l1 = lse[((size_t)MTOK + row) * 4 + hh], l2 = lse[((size_t)2 * MTOK + row) * 4 + hh];
    const float mx = fmaxf(l0, fmaxf(l1, l2)); float a0 = fexp2(l0 - mx), a1 = fexp2(l1 - mx), a2 = fexp2(l2 - mx); const float is = 1.0f / (a0 + a1 + a2); a0 *= is; a1 *= is; a2 *= is;
    const u32x4 o0 = *(const u32x4*)(dout + row * 512 + lane * 8), o1 = *(const u32x4*)(dout + ((size_t)MTOK + row) * 512 + lane * 8), o2 = *(const u32x4*)(dout + ((size_t)2 * MTOK + row) * 512 + lane * 8);
    const u32x4 gt = *(const u32x4*)(z + row * LDZE + EC_GATEB + lane * 8); bf16_t* gp = z + row * LDZE + EC_QB + lane * 8; u32x4 w;
#pragma unroll
    for (int e = 0; e < 4; ++e) { const float lo = (a0 * lo2f(o0[e]) + a1 * lo2f(o1[e]) + a2 * lo2f(o2[e])) * siluf_(lo2f(gt[e]));
        const float hi = (a0 * hi2f(o0[e]) + a1 * hi2f(o1[e]) + a2 * hi2f(o2[e])) * siluf_(hi2f(gt[e])); w[e] = pk2(lo, hi); }
    if (!P.dry) *(u32x4*)gp = w;
}

DEVI void item_mla(const Params& P, LDSA char* lds, int tid, int item) {
    bf16_t* z = (bf16_t*)(P.ws + WS_R1); const bf16_t* kvb = (const bf16_t*)(P.ws + WS_KV); const bf16_t* q = (const bf16_t*)(P.ws + WS_H);
    const int bh = 2 * ((item >> 3) & 63) + (item & 1), r_ = ((item >> 1) & 3) + 4 * (item >> 9), kk_ = r_ >> 2, j_ = r_ & 3;
    const int qb = 31 - ((kk_ & 1) ? 4 * kk_ + 3 - j_ : 4 * kk_ + j_), hd = bh & 15, b = bh >> 4, lane = tid & 63, wave = __builtin_amdgcn_readfirstlane(tid >> 6), n = lane & 31;
    const int q0 = qb * 128, ntiles = (q0 + 128) / 64;
    const bf16_t* kvr = kvb + (size_t)b * SEQ * 4096 + hd * 256; const bf16_t* zb = z + (size_t)b * SEQ * LDZO;
    auto tilefn = [&](int it, TileDesc& td) { const int k0 = it * 64; td.kp = kvr + (size_t)k0 * 4096; td.vp = kvr + (size_t)k0 * 4096 + 128;
        td.k2p = zb + (size_t)k0 * LDZO + OC_KPE; td.kidx0 = k0; };
    const int qi = q0 + 32 * wave + n; const size_t row = (size_t)b * SEQ + qi;
    auto epi = [&](f32x16 (&o)[4], float l, float) { if (P.dry) return; const float inv = l > 0.f ? 1.0f / l : 0.f; const int h = lane >> 5; bf16_t* gp = z + row * LDZO + OC_GATE + hd * 128;
#pragma unroll
        for (int c = 0; c < 4; ++c)
#pragma unroll
            for (int qq = 0; qq < 4; ++qq) { bf16_t* p = gp + 32 * c + 8 * qq + 4 * h; const u32x2 gt = *(const u32x2*)p; u32x2 w;
                w.x = pk2(o[c][4 * qq] * inv * siluf_(lo2f(gt.x)), o[c][4 * qq + 1] * inv * siluf_(hi2f(gt.x)));
                w.y = pk2(o[c][4 * qq + 2] * inv * siluf_(lo2f(gt.y)), o[c][4 * qq + 3] * inv * siluf_(hi2f(gt.y))); *(u32x2*)p = w; } };
    attn_core<0>(lds, tid, q + row * 3072 + hd * 192, qi, q0 + 32 * wave, ntiles, ntiles, 4096, 4096, LDZO, tilefn, (const float*)(P.ws + WS_COS), 0, 0ull, epi);
}


template <class EpiFn>
DEVI void mla_core8(LDSA char* lds, int tid, const bf16_t* qrow, int qidx, int qidx0w, int ntiles, const bf16_t* kvr  , const bf16_t* kpe  ,
                    const float* ctab, EpiFn epi) {
    constexpr int KSTR = 400, STG = 46080, NKS = 12;
    const int lane = tid & 63, n = lane & 31, h = lane >> 5;
    bf16x8 qf[NKS];
#pragma unroll
    for (int ks = 0; ks < NKS; ++ks) qf[ks] = *(const bf16x8*)(qrow + 16 * ks + 8 * h);
    {
        const float* ct = ctab + (size_t)qidx * 32 + 8 * h; const float* st = ct + 4096 * 32;
#pragma unroll
        for (int kk = 0; kk < 2; ++kk) { v4i a = __builtin_bit_cast(v4i, qf[8 + kk]), b2 = __builtin_bit_cast(v4i, qf[10 + kk]);
#pragma unroll
            for (int j = 0; j < 4; ++j) { const float c0 = ct[16 * kk + 2 * j], c1 = ct[16 * kk + 2 * j + 1], s0_ = st[16 * kk + 2 * j], s1_ = st[16 * kk + 2 * j + 1];
                const float x10 = lo2f((unsigned)a[j]), x11 = hi2f((unsigned)a[j]), x20 = lo2f((unsigned)b2[j]), x21 = hi2f((unsigned)b2[j]);
                a[j] = (int)pk2(x10 * c0 - x20 * s0_, x11 * c1 - x21 * s1_); b2[j] = (int)pk2(x10 * s0_ + x20 * c0, x11 * s1_ + x21 * c1); }
            qf[8 + kk] = __builtin_bit_cast(bf16x8, a); qf[10 + kk] = __builtin_bit_cast(bf16x8, b2); }
    }
    f32x16 o[4];
#pragma unroll
    for (int c = 0; c < 4; ++c) o[c] = zero16();
    float m = -INFINITY, l = 0.f;
    u32x4 kreg[2], k2reg, vreg[2];
    const unsigned koff = (unsigned)(tid >> 4) * 4096u + (tid & 15) * 8, k2off = (unsigned)(tid >> 3) * (unsigned)LDZO + (tid & 7) * 8;
    LDSA char* const vp0 = lds + 25600 + (4 * h + ((lane & 15) >> 2)) * ATT_VSTR + (16 * ((lane >> 4) & 1) + 4 * (lane & 3)) * 2;
#define MISSUE(it) do { const bf16_t* kp_ = kvr + (size_t)(it) * 64 * 4096; \
        _Pragma("unroll") for (int u = 0; u < 2; ++u) { kreg[u] = *(const u32x4*)(kp_ + (size_t)(32 * u) * 4096 + koff); vreg[u] = *(const u32x4*)(kp_ + 128 + (size_t)(32 * u) * 4096 + koff); } \
        k2reg = *(const u32x4*)(kpe + (size_t)(it) * 64 * LDZO + k2off); } while (0)
#define MSTORE(s) do { LDSA char* ks_ = lds + (s) * STG; \
        _Pragma("unroll") for (int u = 0; u < 2; ++u) { *(LDSA u32x4*)(ks_ + (tid >> 4) * KSTR + (tid & 15) * 16 + u * 32 * KSTR) = kreg[u]; \
            *(LDSA u32x4*)(ks_ + 25600 + (tid >> 4) * ATT_VSTR + (tid & 15) * 16 + u * 32 * ATT_VSTR) = vreg[u]; } \
        *(LDSA u32x4*)(ks_ + (tid >> 3) * KSTR + 256 + (tid & 7) * 16) = k2reg; } while (0)
    MISSUE(0); MSTORE(0);
    if (ntiles > 1) MISSUE(1);
    __syncthreads();
    for (int it = 0; it < ntiles; ++it) {
        const int kidx0 = it * 64, stg = (it & 1) * STG;
        const int dlo = qidx0w - (kidx0 + 63), dhi = qidx0w + 31 - kidx0;
        const bool skip = dhi < 0, full = dlo >= 0;
        if (!skip) {
            f32x16 s0 = zero16(), s1 = zero16();
            LDSA char* kb = lds + stg + n * KSTR + h * 16;
#pragma unroll
            for (int ks = 0; ks < NKS; ++ks) {
                const bf16x8 k0 = *(LDSA bf16x8*)(kb + ks * 32), k1 = *(LDSA bf16x8*)(kb + 32 * KSTR + ks * 32);
                s0 = mfma32(k0, qf[ks], s0); s1 = mfma32(k1, qf[ks], s1);
            }
            int dbase = qidx - kidx0 - 4 * h;
            asm volatile("" : "+v"(dbase));
            float tmax = -INFINITY;
            if (full) {
#pragma unroll
                for (int r = 0; r < 16; ++r) tmax = fmaxf(tmax, fmaxf(s0[r], s1[r]));
            } else {
#pragma unroll
                for (int mt = 0; mt < 2; ++mt)
#pragma unroll
                    for (int r = 0; r < 16; ++r) {
                        const int ko = 32 * mt + 8 * (r >> 2) + (r & 3);
                        float v = mt ? s1[r] : s0[r];
                        if (dbase - ko < 0) v = -INFINITY;
                        if (mt) s1[r] = v; else s0[r] = v;
                        tmax = fmaxf(tmax, v);
                    }
                asm volatile("" ::: "memory");
            }
            tmax = fmaxf(tmax, __shfl_xor(tmax, 32));
            const float mnew = fmaxf(m, tmax), msafe = (mnew == -INFINITY) ? 0.f : mnew;
            const float alpha = fexp2(m - msafe);
            float ps = 0.f;
#pragma unroll
            for (int r = 0; r < 16; ++r) { s0[r] = fexp2(s0[r] - msafe); ps += s0[r]; }
#pragma unroll
            for (int r = 0; r < 16; ++r) { s1[r] = fexp2(s1[r] - msafe); ps += s1[r]; }
            l = l * alpha + ps; m = mnew;
            if (__ballot(alpha != 1.0f) != 0ull) {
#pragma unroll
                for (int c = 0; c < 4; ++c)
#pragma unroll
                    for (int r = 0; r < 16; ++r) o[c][r] *= alpha;
            }
            bf16x8 pk[2][2];
#pragma unroll
            for (int j = 0; j < 2; ++j) {
                v4i a; a.x = (int)pk2(s0[8 * j], s0[8 * j + 1]); a.y = (int)pk2(s0[8 * j + 2], s0[8 * j + 3]); a.z = (int)pk2(s0[8 * j + 4], s0[8 * j + 5]); a.w = (int)pk2(s0[8 * j + 6], s0[8 * j + 7]);
                pk[0][j] = __builtin_bit_cast(bf16x8, a);
                v4i b; b.x = (int)pk2(s1[8 * j], s1[8 * j + 1]); b.y = (int)pk2(s1[8 * j + 2], s1[8 * j + 3]); b.z = (int)pk2(s1[8 * j + 4], s1[8 * j + 5]); b.w = (int)pk2(s1[8 * j + 6], s1[8 * j + 7]);
                pk[1][j] = __builtin_bit_cast(bf16x8, b);
            }
            LDSA char* const vp = vp0 + stg;
            pv_step<0>(vp, o[0], pk); pv_step<1>(vp, o[1], pk); pv_step<2>(vp, o[2], pk); pv_step<3>(vp, o[3], pk);
        }
        if (it + 1 < ntiles) MSTORE((it + 1) & 1);
        if (it + 2 < ntiles) MISSUE(it + 2);
        __syncthreads();
    }
#undef MISSUE
#undef MSTORE
    l += __shfl_xor(l, 32);
    epi(o, l, m);
}

DEVI void item_mla8(const Params& P, LDSA char* lds, int tid, int item) {
    bf16_t* z = (bf16_t*)(P.ws + WS_R1); const bf16_t* kvb = (const bf16_t*)(P.ws + WS_KV); const bf16_t* q = (const bf16_t*)(P.ws + WS_H);
    const int bh = (item >> 1) & 127, kk_ = item >> 8, j_ = item & 1, qb = 15 - ((kk_ & 1) ? 2 * kk_ + 1 - j_ : 2 * kk_ + j_), hd = bh & 15, b = bh >> 4;
    const int lane = tid & 63, wave = __builtin_amdgcn_readfirstlane(tid >> 6), n = lane & 31, q0 = qb * 256, ntiles = (q0 + 256) / 64;
    const bf16_t* kvr = kvb + (size_t)b * SEQ * 4096 + hd * 256; const bf16_t* kpe = z + (size_t)b * SEQ * LDZO + OC_KPE;
    const int qi = q0 + 32 * wave + n; const size_t row = (size_t)b * SEQ + qi;
    auto epi = [&](f32x16 (&o)[4], float l, float) { if (P.dry) return; const float inv = l > 0.f ? 1.0f / l : 0.f; const int h = lane >> 5; bf16_t* gp = z + row * LDZO + OC_GATE + hd * 128;
#pragma unroll
        for (int c = 0; c < 4; ++c)
#pragma unroll
            for (int qq = 0; qq < 4; ++qq) { bf16_t* p = gp + 32 * c + 8 * qq + 4 * h; const u32x2 gt = *(const u32x2*)p; u32x2 w;
                w.x = pk2(o[c][4 * qq] * inv * siluf_(lo2f(gt.x)), o[c][4 * qq + 1] * inv * siluf_(hi2f(gt.x)));
                w.y = pk2(o[c][4 * qq + 2] * inv * siluf_(lo2f(gt.y)), o[c][4 * qq + 3] * inv * siluf_(hi2f(gt.y))); *(u32x2*)p = w; } };
    mla_core8(lds, tid, q + row * 3072 + hd * 192, qi, q0 + 32 * wave, ntiles, kvr, kpe, (const float*)(P.ws + WS_COS), epi);
}

constexpr int N_PHASES = 28;
DEVI void run_phase(const Params& P, int ph, LDSA char* lds, int tid) {
    unsigned char* ws = P.ws; const int G = vgrid(), v = vblock();
    bf16_t* hbuf = (bf16_t*)(ws + WS_H); bf16_t* zbuf = (bf16_t*)(ws + WS_R1);
    if (ph == 0) { phase_prep(P, lds, opq(tid)); phase_xb(P.x, hbuf, (float*)(ws + WS_RSTD), opq(tid)); return; }
    if (ph == 27) { phase_rms<true>(P.out, P.final_norm_w, P.out, opq(tid)); return; }
    int layer, sub; { const int q = ph - 1; if (q < 7) { layer = 0; sub = q; } else if (q < 13) { layer = 1; sub = q - 7; } else if (q < 20) { layer = 2; sub = q - 13; } else { layer = 3; sub = q - 20; } }
    const int li = layer >> 1; const float* xin = (layer == 0) ? P.x : P.out;
#ifdef DBG_LAYERS
    if (!((DBG_LAYERS >> layer) & 1)) {
        if (layer == 0 && sub == 6) { for (size_t i = (size_t)blockIdx.x * NTHREADS + tid; i < (size_t)MTOK * D_MODEL / 4; i += (size_t)G * NTHREADS) ((f32x4*)P.out)[i] = ((const f32x4*)P.x)[i]; }
        return;
    }
#endif
#ifdef DBG_SKIP_SUB
    if ((DBG_SKIP_SUB >> sub) & 1) return;
#endif
    if (sub == 0) { if (layer != 0) phase_rstd((const float*)(ws + WS_SSP), (float*)(ws + WS_RSTD), opq(tid)); return; }
    if ((layer & 1) == 0) {
        if (sub == 1) {
            pg8::run(lds - grp_() * GRP_LDS, hbuf, 2048, (const bf16_t*)(ws + WS_WEVIN + li * SZ_WEVIN), MTOK, LDZE, 2048, pg8::PEpiBf16S{zbuf, LDZE, (const float*)(ws + WS_RSTD)}); return; }
        if (sub == 2) { const int nwin = 2048, ndil = 3072, ncmp = 64, nt = nwin + ndil + ncmp;
            (void)nt;
            if (G == 512) {
                const int cls = v & 14;
                const int kmax = cls == 0 ? 4 : 6;
                for (int k = 0; k < kmax; ++k) item_dil(P, lds, opq(tid), v + 512 * k);
                if (cls == 2) item_dil(P, lds, opq(tid), (v - 2) + 2048);
                if (cls == 4) item_dil(P, lds, opq(tid), (v - 4) + 2560);
                if (cls == 0) item_cmp1(P, li, lds, opq(tid), (v >> 4) * 2 + (v & 1));
            } else {
                for (int it = v; it < ndil; it += G) item_dil(P, lds, opq(tid), it);
                for (int it = v; it < ncmp; it += G) item_cmp1(P, li, lds, opq(tid), it);
            }
            (void)nwin;
            return; }
        if (sub == 3) { phase_cmp2(P, li, lds, opq(tid)); return; }
        if (sub == 4) return;
        if (sub == 5) {
            for (int it = v; it < 2048; it += G) { const int item = it ^ (((it >> 9) & 1) ? 0 : 254);
                item_cmpatt(P, lds, opq(tid), item); item_win(P, lds, opq(tid), item); item_slc(P, lds, opq(tid), item); }
            { int t_ = tid; asm volatile("" : "+v"(t_)); for (int it = v; it < MTOK / 4; it += G) item_mixb(P, t_, it); }
            return; }
        if (sub == 6) { pg8::run(lds - grp_() * GRP_LDS, zbuf + EC_GATEA, LDZE, (const bf16_t*)(ws + WS_WEVOUT + li * SZ_WEVOUT), MTOK, 2048, 1536, pg8::PEpiResidX{xin, P.out, hbuf, (float*)(ws + WS_SSP)}); return; }
    } else {
        if (sub == 1) { pg8::run(lds - grp_() * GRP_LDS, hbuf, 2048, (const bf16_t*)(ws + WS_WODIN + li * SZ_WODIN), MTOK, LDZO, 2048, pg8::PEpiBf16S{zbuf, LDZO, (const float*)(ws + WS_RSTD)}); return; }
        if (sub == 2) { phase_norms(zbuf, P.q_norm + li * 1536, P.kv_norm + li * 512, (const float*)(ws + WS_COS), (const float*)(ws + WS_SIN), opq(tid)); return; }
        if (sub == 3) {
            pg8::run(lds - grp_() * GRP_LDS, zbuf + OC_CQ, LDZO, (const bf16_t*)(ws + WS_WQB + li * SZ_WQB), MTOK, 3072, 1536, pg8::PEpiBf16{hbuf, 3072});
            pg8::run(lds - grp_() * GRP_LDS, zbuf + OC_CKV, LDZO, (const bf16_t*)(ws + WS_WKVB + li * SZ_WKVB), MTOK, 4096, 512, pg8::PEpiBf16{(bf16_t*)(ws + WS_KV), 4096}); return; }
        if (sub == 4) { for (int it = pblock(); it < 2048; it += (int)gridDim.x) item_mla8(P, lds - grp_() * GRP_LDS, opq((int)threadIdx.x), it); return; }
        if (sub == 5) { pg8::run(lds - grp_() * GRP_LDS, zbuf + OC_GATE, LDZO, (const bf16_t*)(ws + WS_WODOUT + li * SZ_WODOUT), MTOK, 2048, 2048, pg8::PEpiResidX{xin, P.out, hbuf, (float*)(ws + WS_SSP)}); return; }
    }
}

DEVI void grid_barrier(unsigned* bar, unsigned gen) {
    __syncthreads();
    if (threadIdx.x == 0) {
        const unsigned G = gridDim.x, x = blockIdx.x & 7u;
        unsigned* gcnt = bar + 32 * 8;
        __builtin_amdgcn_fence(__ATOMIC_RELEASE, "agent");
        if ((G & 7u) == 0u) {
            if (__hip_atomic_fetch_add(bar + 32 * x, 1u, __ATOMIC_ACQ_REL, __HIP_MEMORY_SCOPE_AGENT) + 1u == gen * (G >> 3)) {
                if (__hip_atomic_fetch_add(gcnt, 1u, __ATOMIC_ACQ_REL, __HIP_MEMORY_SCOPE_AGENT) + 1u == gen * 8u) {
#pragma unroll
                    for (int i = 0; i < 8; ++i) __hip_atomic_store(bar + 32 * (9 + i), gen, __ATOMIC_RELEASE, __HIP_MEMORY_SCOPE_AGENT);
                }
            }
            while (__hip_atomic_load(bar + 32 * (9 + x), __ATOMIC_RELAXED, __HIP_MEMORY_SCOPE_AGENT) < gen) __builtin_amdgcn_s_sleep(1);
        } else {
            __hip_atomic_fetch_add(gcnt, 1u, __ATOMIC_RELAXED, __HIP_MEMORY_SCOPE_AGENT);
            while (__hip_atomic_load(gcnt, __ATOMIC_RELAXED, __HIP_MEMORY_SCOPE_AGENT) < gen * G) __builtin_amdgcn_s_sleep(2);
        }
        __builtin_amdgcn_fence(__ATOMIC_ACQUIRE, "agent");
    }
    __syncthreads();
}

__global__ void __launch_bounds__(NTHREADS, 2) fwd_kernel(Params P) {
    extern __shared__ __attribute__((aligned(16))) unsigned char smem[];
    LDSA char* lds = (LDSA char*)smem;
    const int tid = threadIdx.x & (GTHREADS - 1);
    lds += grp_() * GRP_LDS;
    unsigned bar_gen = 0;
    for (int ph = P.ph_lo; ph < P.ph_hi; ++ph) {
        if (ph == 1 || ph == 5 || ph == 18) continue;
        if (ph > P.ph_lo) {
            if (P.ph_lo < 0) cg::this_grid().sync();
            grid_barrier((unsigned*)(P.ws + WS_BAR), ++bar_gen);
        }
        int tid_ = tid; asm volatile("" : "+v"(tid_));
        Params Q = P; { size_t z0 = 0, z1 = 0; asm volatile("" : "+s"(z0), "+s"(z1)); Q.ws = P.ws + z0; Q.out = P.out + z1; }
#ifdef DBG_DRY_PH
        if (ph == DBG_DRY_PH) { Params Q2 = Q; Q2.dry = 1; int t3_ = tid; asm volatile("" : "+v"(t3_)); run_phase(Q2, ph, lds, t3_); __syncthreads(); }
#endif
        run_phase(Q, ph, lds, tid_);
#ifdef DBG_REPEAT_PH
        if (ph == DBG_REPEAT_PH) { __syncthreads(); int t2_ = tid; asm volatile("" : "+v"(t2_)); run_phase(Q, ph, lds, t2_); }
#endif
    }
}

extern "C" void kernel_launch(void* const* d_in, const int* in_sizes, int n_in, void* d_out, int out_size, void* d_ws, size_t ws_size, hipStream_t stream) {
    static int grid = 0;
    if (grid == 0) {
        if (n_in != 15 || ws_size < WS_END) { fprintf(stderr, "kernel_launch: need 15 inputs and %zu bytes of workspace (got %d, %zu)\n", (size_t)WS_END, n_in, ws_size); grid = -1; return; }
        int dev = 0, cus = 0, per_cu = 0;
        hipGetDevice(&dev); hipDeviceGetAttribute(&cus, hipDeviceAttributeMultiprocessorCount, dev);
        if (hipFuncSetAttribute((const void*)fwd_kernel, hipFuncAttributeMaxDynamicSharedMemorySize, LDS_BYTES) != hipSuccess) { fprintf(stderr, "hipFuncSetAttribute failed\n"); grid = -1; return; }
        if (hipOccupancyMaxActiveBlocksPerMultiprocessor(&per_cu, (const void*)fwd_kernel, NTHREADS, LDS_BYTES) != hipSuccess || per_cu < 1) { fprintf(stderr, "occupancy query failed (%d)\n", per_cu); per_cu = 1; }
        if (per_cu > 1) per_cu = 1;
        grid = cus * per_cu;
        fprintf(stderr, "kernel_launch: grid %d (%d CUs x %d)\n", grid, cus, per_cu);
    }
    if (grid < 0) return;
    Params p{};
    p.x = (const float*)d_in[0]; p.rel_bias = (const float*)d_in[1]; p.norm_w = (const float*)d_in[2]; p.final_norm_w = (const float*)d_in[3]; p.ev_w_in = (const float*)d_in[4];
    p.cmp_pos = (const float*)d_in[5]; p.cmp_w1 = (const float*)d_in[6]; p.cmp_w2 = (const float*)d_in[7]; p.ev_w_out = (const float*)d_in[8]; p.od_w_in = (const float*)d_in[9];
    p.q_norm = (const float*)d_in[10]; p.w_qb = (const float*)d_in[11]; p.kv_norm = (const float*)d_in[12]; p.w_kvb = (const float*)d_in[13]; p.od_w_out = (const float*)d_in[14];
    p.out = (float*)d_out; p.ws = (unsigned char*)d_ws;
#if ONE_LAUNCH
    p.ph_lo = 0; p.ph_hi = N_PHASES;
    if (hipMemsetAsync((char*)d_ws + WS_BAR, 0, 4096, stream) != hipSuccess) { fprintf(stderr, "memset failed\n"); return; }
    void* args[] = {&p};
    hipError_t e = hipLaunchCooperativeKernel((const void*)fwd_kernel, dim3(grid), dim3(NTHREADS), args, LDS_BYTES, stream);
    if (e != hipSuccess) fprintf(stderr, "cooperative launch failed: %s (grid %d)\n", hipGetErrorString(e), grid);
#else
    for (int ph = 0; ph < N_PHASES; ++ph) { p.ph_lo = ph; p.ph_hi = ph + 1; hipLaunchKernelGGL(fwd_kernel, dim3(grid), dim3(NTHREADS), LDS_BYTES, stream, p); }
#endif
}
```
